# Optimizing an MI355X kernel written in HIP

```python
import math
import jax, jax.numpy as jnp
from jax import lax
import numpy as np

D_MODEL = 1024
BATCH = 8
SEQ = 4096
DEPTH = 1

N_ATTN_HEADS = 4
QK_DIM = 64
V_DIM = 2 * QK_DIM
ATTN_WIDTH = N_ATTN_HEADS * V_DIM
Q_COLS = N_ATTN_HEADS * 2 * QK_DIM
K_COLS = N_ATTN_HEADS * 2 * QK_DIM
V_COLS = N_ATTN_HEADS * V_DIM
CONV_WIDTH = D_MODEL // 2
CONV_GROUPS = 8
CONV_GROUP_DIM = CONV_WIDTH // CONV_GROUPS
CONV_K = 3
MIX_WIDTH = ATTN_WIDTH + CONV_WIDTH
IN_COLS = Q_COLS + K_COLS + V_COLS + 3 * CONV_WIDTH
D_FF = 2816
FFN_RESIDUAL_WEIGHT = 0.5
Q_BLOCK = 128
NORM_EPS = 1e-6

kernel_name = "hymba_diffattn_shortconv_macaron"


def rms_norm(x, g, eps=NORM_EPS):
    xf = x.astype(jnp.float32)
    y = xf * lax.rsqrt(jnp.mean(xf * xf, axis=-1, keepdims=True) + eps)
    return (y * g.astype(jnp.float32)).astype(x.dtype)


def swiglu_ffn(h, w_gate, w_up, w_down):
    return (jax.nn.silu(h @ w_gate) * (h @ w_up)) @ w_down


def alibi_slopes(n_heads):
    idx = jnp.arange(1, n_heads + 1, dtype=jnp.float32)
    return jnp.exp2(-8.0 * idx / n_heads)


def diff_attention(q, k, v, lam, slopes):
    b, s, h, _, dk = q.shape
    nb = s // Q_BLOCK
    scale = dk ** -0.5
    kf = k.astype(jnp.float32)
    pos_k = jnp.arange(s)
    q_blocks = (q.astype(jnp.float32) * scale).reshape(b, nb, Q_BLOCK, h, 2, dk).swapaxes(0, 1)

    def one_block(args):
        q_blk, start = args
        pos_q = start + jnp.arange(Q_BLOCK)
        dist = (pos_q[:, None] - pos_k[None, :]).astype(jnp.float32)
        scores = jnp.einsum('bqhmd,bkhmd->bhmqk', q_blk, kf)
        scores = scores - slopes[None, :, None, None, None] * dist
        scores = jnp.where(dist >= 0, scores, -jnp.inf)
        p = jax.nn.softmax(scores, axis=-1)
        w = p[:, :, 0] - lam * p[:, :, 1]
        return jnp.einsum('bhqk,bkhd->bqhd', w.astype(v.dtype), v)

    out = lax.map(one_block, (q_blocks, jnp.arange(nb) * Q_BLOCK))
    return out.swapaxes(0, 1).reshape(b, s, h, v.shape[-1])


def short_conv(u, w):
    c = u.shape[-1]
    return lax.conv_general_dilated(
        u, w[:, None, :].astype(u.dtype), window_strides=(1,),
        padding=[(CONV_K - 1, 0)], dimension_numbers=('NWC', 'WIO', 'NWC'),
        feature_group_count=c)


def setup_inputs(seed: int = 0) -> dict:
    key = jax.random.key(seed)
    ks = jax.random.split(key, 24)
    f32 = jnp.float32

    def nrm(k, shape, scale):
        return jax.random.normal(k, shape, f32) * scale

    def gain(k, shape):
        return 1.0 + 0.02 * jax.random.normal(k, shape, f32)

    L, D, F = DEPTH, D_MODEL, D_FF
    return {
        "x": jax.random.normal(ks[0], (BATCH, SEQ, D), f32),
        "ffn1_norm": gain(ks[1], (L, D)),
        "ffn1_w_gate": nrm(ks[2], (L, D, F), D ** -0.5),
        "ffn1_w_up": nrm(ks[3], (L, D, F), D ** -0.5),
        "ffn1_w_down": nrm(ks[4], (L, F, D), F ** -0.5),
        "mix_norm": gain(ks[5], (L, D)),
        "w_in": nrm(ks[6], (L, D, IN_COLS), D ** -0.5),
        "q_norm": gain(ks[7], (L, QK_DIM)),
        "k_norm": gain(ks[8], (L, QK_DIM)),
        "lambda_q1": nrm(ks[9], (L, QK_DIM), 0.1),
        "lambda_k1": nrm(ks[10], (L, QK_DIM), 0.1),
        "lambda_q2": nrm(ks[11], (L, QK_DIM), 0.1),
        "lambda_k2": nrm(ks[12], (L, QK_DIM), 0.1),
        "attn_subln": gain(ks[13], (L, V_DIM)),
        "conv_w": nrm(ks[14], (L, CONV_K, CONV_WIDTH), CONV_K ** -0.5),
        "conv_norm": gain(ks[15], (L, CONV_WIDTH)),
        "w_out": nrm(ks[16], (L, MIX_WIDTH, D), MIX_WIDTH ** -0.5),
        "ffn2_norm": gain(ks[17], (L, D)),
        "ffn2_w_gate": nrm(ks[18], (L, D, F), D ** -0.5),
        "ffn2_w_up": nrm(ks[19], (L, D, F), D ** -0.5),
        "ffn2_w_down": nrm(ks[20], (L, F, D), F ** -0.5),
        "final_norm": gain(ks[21], (L, D)),
    }


def reference(x, ffn1_norm, ffn1_w_gate, ffn1_w_up, ffn1_w_down, mix_norm, w_in,
              q_norm, k_norm, lambda_q1, lambda_k1, lambda_q2, lambda_k2, attn_subln,
              conv_w, conv_norm, w_out, ffn2_norm, ffn2_w_gate, ffn2_w_up, ffn2_w_down,
              final_norm):
    b, s, _ = x.shape
    slopes = alibi_slopes(N_ATTN_HEADS)
    splits = np.cumsum([Q_COLS, K_COLS, V_COLS, CONV_WIDTH, CONV_WIDTH]).tolist()
    for i in range(DEPTH):
        lam_init = 0.8 - 0.6 * math.exp(-0.3 * i)
        h = rms_norm(x, ffn1_norm[i])
        x = x + FFN_RESIDUAL_WEIGHT * swiglu_ffn(h, ffn1_w_gate[i], ffn1_w_up[i], ffn1_w_down[i])

        h = rms_norm(x, mix_norm[i])
        proj = h @ w_in[i]
        q, k, v, gate_b, gate_c, hc = jnp.split(proj, splits, axis=-1)

        q = rms_norm(q.reshape(b, s, N_ATTN_HEADS, 2, QK_DIM), q_norm[i])
        k = rms_norm(k.reshape(b, s, N_ATTN_HEADS, 2, QK_DIM), k_norm[i])
        v = v.reshape(b, s, N_ATTN_HEADS, V_DIM)
        lq1 = lambda_q1[i].astype(jnp.float32)
        lk1 = lambda_k1[i].astype(jnp.float32)
        lq2 = lambda_q2[i].astype(jnp.float32)
        lk2 = lambda_k2[i].astype(jnp.float32)
        lam = jnp.exp(jnp.sum(lq1 * lk1)) - jnp.exp(jnp.sum(lq2 * lk2)) + lam_init
        a = diff_attention(q, k, v, lam, slopes)
        a = (rms_norm(a, attn_subln[i]) * (1.0 - lam_init)).reshape(b, s, ATTN_WIDTH)

        c = gate_b * short_conv(gate_c * hc, conv_w[i])
        c = rms_norm(c.reshape(b, s, CONV_GROUPS, CONV_GROUP_DIM),
                     conv_norm[i].reshape(CONV_GROUPS, CONV_GROUP_DIM)).reshape(b, s, CONV_WIDTH)

        mixed = jnp.concatenate([a, c], axis=-1)
        x = x + mixed @ w_out[i]

        h = rms_norm(x, ffn2_norm[i])
        x = x + FFN_RESIDUAL_WEIGHT * swiglu_ffn(h, ffn2_w_gate[i], ffn2_w_up[i], ffn2_w_down[i])

        x = rms_norm(x, final_norm[i])
    return x
```

```cpp
#include <hip/hip_runtime.h>
#include <cstdio>
#include <cstdint>
namespace pg8 {
#define PG8_LAS __attribute__((address_space(3)))
typedef unsigned short bf16_t;
typedef short bf16x8 __attribute__((ext_vector_type(8)));
typedef float f32x4 __attribute__((ext_vector_type(4)));
typedef unsigned u32x4 __attribute__((ext_vector_type(4)));
constexpr int BM = 256, BK = 64, HALF = 128, HTB = HALF * BK * 2  , STAGE_BYTES = 8 * HTB, NXCD = 8, WGM = 8;

__host__ __device__ __forceinline__ int lds_byte(int r, int c) { const int st = (r >> 4) * 2 + (c >> 5), rr = r & 15, cc = c & 31, ob = rr * 64 + cc * 2; return st * 1024 + (ob ^ (((ob >> 9) & 1) << 5)); }
__host__ __device__ __forceinline__ void stage_rc(int b, int& R, int& C) { const int st = b / 1024, sb = b % 1024, swz = sb ^ (((sb >> 9) & 1) << 5); R = (st >> 1) * 16 + swz / 64; C = (st & 1) * 32 + (swz % 64) / 2; }
__host__ __device__ __forceinline__ int perm32(int rho) { const int n = rho >> 4, i = rho & 15; return 8 * (i >> 2) + 4 * n + (i & 3); }

struct Unit { int pm, pn; };
struct Gemm { const bf16_t* A; const bf16_t* Bt; int M, N, K; };

struct StaticOrder {
    int nM, nN, nwg, G, c;
    __host__ __device__ void init(int M, int N, int G_, int c_) { nM = M / BM; nN = N / BM; nwg = nM * nN; G = G_; c = c_; }
    __host__ __device__ bool next(int i, Unit& u) const {
        const long L = (long)i * G + c; if (L >= nwg) return false;
        int wgid = (int)L; { const int q = nwg / NXCD, r = nwg % NXCD, xcd = wgid % NXCD, off = wgid / NXCD; wgid = (xcd < r ? xcd * (q + 1) : r * (q + 1) + (xcd - r) * q) + off; }
        const int nig = WGM * nN, gid = wgid / nig, fm = gid * WGM, gsz = (nM - fm) < WGM ? (nM - fm) : WGM;
        u.pm = fm + ((wgid % nig) % gsz); u.pn = (wgid % nig) / gsz; return true;
    }
    __device__ __forceinline__ void a_ready(const Unit&) const {}
    __device__ __forceinline__ void done(const Unit&) const {}
};

__device__ __forceinline__ unsigned cvt_pk_bf16(float lo, float hi) { unsigned r; asm volatile("v_cvt_pk_bf16_f32 %0, %1, %2" : "=v"(r) : "v"(lo), "v"(hi)); return r; }
typedef float f32x2 __attribute__((ext_vector_type(2)));
typedef unsigned u32x2 __attribute__((ext_vector_type(2)));
constexpr float NORM_EPS = 1e-6f;
__device__ __forceinline__ float silu_mul(float g, float u) {
    const float e = __builtin_amdgcn_exp2f(g * -1.4426950408889634f);
    return g * u * __builtin_amdgcn_rcpf(1.0f + e);
}
struct EpiSwiGLU {
    static constexpr bool PERM = true, AFTER_DRAIN = false;
    bf16_t* Hout; int ldh; const float* ss; float inv_k;
    __device__ __forceinline__ void operator()(const f32x4 (&acc)[2][2][4][2], const Unit& u, int wr, int wc, int fr, int fq) const {
        const int row0 = u.pm * BM + wr * 64 + fr, col0 = u.pn * HALF + wc * 32 + 8 * fq;
#pragma unroll
        for (int ai = 0; ai < 2; ++ai)
#pragma unroll
            for (int m = 0; m < 4; ++m) {
                const int row = row0 + ai * HALF + m * 16;
                const float rs = __builtin_amdgcn_rsqf(ss[row] * inv_k + NORM_EPS);
                const f32x4 g0 = acc[ai][0][m][0] * rs, g1 = acc[ai][0][m][1] * rs, u0 = acc[ai][1][m][0] * rs, u1 = acc[ai][1][m][1] * rs;
                u32x4 w;
                w.x = cvt_pk_bf16(silu_mul(g0[0], u0[0]), silu_mul(g0[1], u0[1]));
                w.y = cvt_pk_bf16(silu_mul(g0[2], u0[2]), silu_mul(g0[3], u0[3]));
                w.z = cvt_pk_bf16(silu_mul(g1[0], u1[0]), silu_mul(g1[1], u1[1]));
                w.w = cvt_pk_bf16(silu_mul(g1[2], u1[2]), silu_mul(g1[3], u1[3]));
                *(u32x4*)(Hout + (size_t)row * ldh + col0) = w;
            }
    }
};
struct EpiRes {
    static constexpr bool PERM = false, AFTER_DRAIN = false;
    const float* res; float* out; bf16_t* outb; float* ssacc; float scale;
    __device__ __forceinline__ void operator()(const f32x4 (&acc)[2][2][4][2], const Unit& u, int wr, int wc, int fr, int fq) const {
        const int row0 = u.pm * BM + wr * 64 + fr, col0 = u.pn * BM + wc * 32 + 4 * fq;
#pragma unroll
        for (int ai = 0; ai < 2; ++ai) {
            float srow[4];
#pragma unroll
            for (int m = 0; m < 4; ++m) {
                const size_t off = (size_t)(row0 + ai * HALF + m * 16) * 1024 + col0;
                float s = 0.f;
#pragma unroll
                for (int bj = 0; bj < 2; ++bj)
#pragma unroll
                    for (int n = 0; n < 2; ++n) {
                        const f32x4 r4 = *(const f32x4*)(res + off + bj * HALF + n * 16);
                        const f32x4 o = r4 + acc[ai][bj][m][n] * scale;
                        *(f32x4*)(out + off + bj * HALF + n * 16) = o;
                        if (outb) { u32x2 w; w.x = cvt_pk_bf16(o[0], o[1]); w.y = cvt_pk_bf16(o[2], o[3]); *(u32x2*)(outb + off + bj * HALF + n * 16) = w; }
                        s += (o[0] * o[0] + o[1] * o[1]) + (o[2] * o[2] + o[3] * o[3]);
                    }
                s += __shfl_xor(s, 16); s += __shfl_xor(s, 32);
                srow[m] = s;
                asm volatile("" ::: "memory");
            }
            if (ssacc) {
                const float v = fq == 0 ? srow[0] : fq == 1 ? srow[1] : fq == 2 ? srow[2] : srow[3];
                atomicAdd(ssacc + u.pm * BM + ai * HALF + wr * 64 + fq * 16 + fr, v);
            }
        }
    }
};
struct EpiIn {
    static constexpr bool PERM = true, AFTER_DRAIN = false;
    bf16_t *Q, *K, *V, *GB, *U;
    const float* ss; const float* qg; const float* kg; float qscale;
    __device__ __forceinline__ void operator()(const f32x4 (&acc)[2][2][4][2], const Unit& u, int wr, int wc, int fr, int fq) const {
        const int row0 = u.pm * BM + wr * 64 + fr; const int pn = u.pn;
        if (pn < 4) {
            bf16_t* dst = (pn < 2 ? Q : K) + (size_t)(64 * (4 * (pn & 1) + wc)) + 8 * fq;
            const float* gp = (pn < 2 ? qg : kg) + 8 * fq; const float sc = pn < 2 ? qscale : 1.0f;
            f32x4 gv[2][2];
#pragma unroll
            for (int bj = 0; bj < 2; ++bj)
#pragma unroll
                for (int n = 0; n < 2; ++n) gv[bj][n] = *(const f32x4*)(gp + 32 * bj + 4 * n) * sc;
#pragma unroll
            for (int ai = 0; ai < 2; ++ai)
#pragma unroll
                for (int m = 0; m < 4; ++m) {
                    const int row = row0 + ai * HALF + m * 16;
                    const float rs = __builtin_amdgcn_rsqf(ss[row] * (1.0f / 1024.0f) + NORM_EPS);
                    f32x4 t[2][2]; float s = 0.f;
#pragma unroll
                    for (int bj = 0; bj < 2; ++bj)
#pragma unroll
                        for (int n = 0; n < 2; ++n) { t[bj][n] = acc[ai][bj][m][n] * rs; const f32x4 x = t[bj][n]; s += (x[0] * x[0] + x[1] * x[1]) + (x[2] * x[2] + x[3] * x[3]); }
                    s += __shfl_xor(s, 16); s += __shfl_xor(s, 32);
                    const float rn = __builtin_amdgcn_rsqf(s * (1.0f / 64.0f) + NORM_EPS);
#pragma unroll
                    for (int bj = 0; bj < 2; ++bj) {
                        const f32x4 a = t[bj][0] * rn * gv[bj][0], b = t[bj][1] * rn * gv[bj][1];
                        u32x4 w; w.x = cvt_pk_bf16(a[0], a[1]); w.y = cvt_pk_bf16(a[2], a[3]); w.z = cvt_pk_bf16(b[0], b[1]); w.w = cvt_pk_bf16(b[2], b[3]);
                        *(u32x4*)(dst + (size_t)row * 512 + 32 * bj) = w;
                    }
                }
        } else if (pn < 8) {
            bf16_t* dst = (pn < 6 ? V : GB) + (size_t)(256 * (pn & 1) + wc * 32 + 8 * fq);
#pragma unroll
            for (int ai = 0; ai < 2; ++ai)
#pragma unroll
                for (int m = 0; m < 4; ++m) {
                    const int row = row0 + ai * HALF + m * 16;
                    const float rs = __builtin_amdgcn_rsqf(ss[row] * (1.0f / 1024.0f) + NORM_EPS);
#pragma unroll
                    for (int bj = 0; bj < 2; ++bj) {
                        const f32x4 a = acc[ai][bj][m][0] * rs, b = acc[ai][bj][m][1] * rs;
                        u32x4 w; w.x = cvt_pk_bf16(a[0], a[1]); w.y = cvt_pk_bf16(a[2], a[3]); w.z = cvt_pk_bf16(b[0], b[1]); w.w = cvt_pk_bf16(b[2], b[3]);
                        *(u32x4*)(dst + (size_t)row * 512 + HALF * bj) = w;
                    }
                }
        } else {
            bf16_t* dst = U + (size_t)(128 * (pn - 8) + wc * 32 + 8 * fq);
#pragma unroll
            for (int ai = 0; ai < 2; ++ai)
#pragma unroll
                for (int m = 0; m < 4; ++m) {
                    const int row = row0 + ai * HALF + m * 16;
                    const float rs = __builtin_amdgcn_rsqf(ss[row] * (1.0f / 1024.0f) + NORM_EPS); const float rs2 = rs * rs;
                    const f32x4 a = acc[ai][0][m][0] * acc[ai][1][m][0] * rs2, b = acc[ai][0][m][1] * acc[ai][1][m][1] * rs2;
                    u32x4 w; w.x = cvt_pk_bf16(a[0], a[1]); w.y = cvt_pk_bf16(a[2], a[3]); w.z = cvt_pk_bf16(b[0], b[1]); w.w = cvt_pk_bf16(b[2], b[3]);
                    *(u32x4*)(dst + (size_t)row * 512) = w;
                }
        }
    }
};

template <class Epi, class Sched, bool ALIGN_EPI = false, bool SP2 = false>
__device__ __forceinline__ void gemm_phase(PG8_LAS unsigned char* lds, const Gemm g, const Sched& S, const Epi& E) {
    const int tid = threadIdx.x, wid = __builtin_amdgcn_readfirstlane(tid >> 6), lane = tid & 63, wr = wid >> 2, wc = wid & 3, fr = lane & 15, fq = lane >> 4;
    const int K = g.K, nt = K / BK;
    unsigned voffA[2], voffB[2];
#pragma unroll
    for (int i = 0; i < 2; ++i) { int R, C; stage_rc(tid * 16 + i * 8192, R, C); const int Rb = Epi::PERM ? ((R & ~31) + perm32(R & 31)) : R;
        voffA[i] = (unsigned)(R * K + C) * 2u; voffB[i] = (unsigned)(Rb * K + C) * 2u; }
    const size_t kstep = (size_t)(BK * 2);
    const size_t hstep = (size_t)HALF * K * 2;
    const size_t tstep = 2 * hstep;
    const unsigned ldsw = (unsigned)wid * 1024u;
    const int aoff = lds_byte(wr * 64 + fr, fq * 8), boff = lds_byte(wc * 32 + fr, fq * 8);
#define PG8_SA(b, h) (((b) * 2 + (h)) * HTB)
#define PG8_SB(b, h) ((4 + (b) * 2 + (h)) * HTB)
#define PG8_STAGE(bufoff, gbase, voff) do { _Pragma("unroll") for (int _i = 0; _i < 2; ++_i) \
        __builtin_amdgcn_global_load_lds((const unsigned*)((const char*)(gbase) + (voff)[_i]), (PG8_LAS unsigned*)(lds + (bufoff) + ldsw + _i * 8192), 16, 0, 0); } while (0)
#define PG8_LDA(dst, b, h) do { _Pragma("unroll") for (int m = 0; m < 4; ++m) _Pragma("unroll") for (int k = 0; k < 2; ++k) dst[m][k] = *(const PG8_LAS bf16x8*)(lds + PG8_SA(b, h) + aoff + m * 2048 + k * 1024); } while (0)
#define PG8_LDB(dst, b, h) do { _Pragma("unroll") for (int n = 0; n < 2; ++n) _Pragma("unroll") for (int k = 0; k < 2; ++k) dst[n][k] = *(const PG8_LAS bf16x8*)(lds + PG8_SB(b, h) + boff + n * 2048 + k * 1024); } while (0)
#define PG8_MMA(ai, bj, At, Bt) do { __builtin_amdgcn_s_setprio(1); _Pragma("unroll") for (int m = 0; m < 4; ++m) _Pragma("unroll") for (int n = 0; n < 2; ++n) _Pragma("unroll") for (int k = 0; k < 2; ++k) \
        acc[ai][bj][m][n] = __builtin_amdgcn_mfma_f32_16x16x32_bf16(Bt[n][k], At[m][k], acc[ai][bj][m][n], 0, 0, 0); __builtin_amdgcn_s_setprio(0); } while (0)
#define PG8_WAIT_V(n) asm volatile("s_waitcnt vmcnt(" #n ")" ::: "memory")
#define PG8_WAIT_L(n) asm volatile("s_waitcnt lgkmcnt(" #n ")" ::: "memory")
#define PG8_BAR __builtin_amdgcn_s_barrier()
#define PG8_SCHED __builtin_amdgcn_sched_barrier(0)
    Unit cur, nxt; int ui = 0;
    if (!S.next(0, cur)) return;
    f32x4 acc[2][2][4][2];
#pragma unroll
    for (int a = 0; a < 2; ++a)
#pragma unroll
        for (int b = 0; b < 2; ++b)
#pragma unroll
            for (int m = 0; m < 4; ++m)
#pragma unroll
                for (int n = 0; n < 2; ++n) acc[a][b][m][n] = (f32x4){0.f, 0.f, 0.f, 0.f};
    bf16x8 At[4][2], B0[2][2], B1[2][2];
    const char* cA = (const char*)g.A + (size_t)cur.pm * tstep; const char* cB = (const char*)g.Bt + (size_t)cur.pn * tstep;
    S.a_ready(cur);
    if constexpr (SP2) {
        PG8_STAGE(PG8_SB(0, 0), cB, voffB); PG8_STAGE(PG8_SB(0, 1), cB + hstep, voffB); PG8_STAGE(PG8_SA(0, 0), cA, voffA); PG8_STAGE(PG8_SA(0, 1), cA + hstep, voffA);
        if (wr == 1) PG8_BAR;
        PG8_WAIT_V(2); PG8_BAR;
        PG8_STAGE(PG8_SB(1, 0), cB + kstep, voffB); PG8_STAGE(PG8_SA(1, 0), cA + kstep, voffA); PG8_STAGE(PG8_SB(1, 1), cB + hstep + kstep, voffB);
        PG8_WAIT_V(6); PG8_BAR;
    } else {
        PG8_STAGE(PG8_SB(0, 0), cB, voffB); PG8_STAGE(PG8_SA(0, 0), cA, voffA); PG8_STAGE(PG8_SB(0, 1), cB + hstep, voffB); PG8_STAGE(PG8_SA(0, 1), cA + hstep, voffA);
        if (wr == 1) PG8_BAR;
        PG8_WAIT_V(4); PG8_BAR;
        PG8_STAGE(PG8_SB(1, 0), cB + kstep, voffB); PG8_STAGE(PG8_SA(1, 0), cA + kstep, voffA); PG8_STAGE(PG8_SB(1, 1), cB + hstep + kstep, voffB);
        PG8_WAIT_V(6); PG8_BAR;
    }
    for (;;) {
        const bool has_next = S.next(ui + 1, nxt);
        const char* nA = has_next ? (const char*)g.A + (size_t)nxt.pm * tstep : cA; const char* nB = has_next ? (const char*)g.Bt + (size_t)nxt.pn * tstep : cB;
        for (int t = 0; t < nt; t += 2) {
            const bool last = (t == nt - 2);
            const char* a1 = cA + (size_t)(t + 1) * kstep;
            const char* a2 = last ? nA : cA + (size_t)(t + 2) * kstep; const char* b2 = last ? nB : cB + (size_t)(t + 2) * kstep;
            const char* a3 = a2 + kstep; const char* b3 = b2 + kstep;
            if (last && has_next) S.a_ready(nxt);
            if constexpr (SP2) {
            PG8_LDB(B0, 0, 0); PG8_LDB(B1, 0, 1); PG8_SCHED; PG8_LDA(At, 0, 0); PG8_STAGE(PG8_SA(1, 1), a1 + hstep, voffA);
            PG8_WAIT_V(8); PG8_WAIT_L(0); PG8_BAR; PG8_MMA(0, 0, At, B0); PG8_MMA(0, 1, At, B1); PG8_BAR; PG8_SCHED;
            PG8_LDA(At, 0, 1); PG8_STAGE(PG8_SB(0, 0), b2, voffB); PG8_STAGE(PG8_SB(0, 1), b2 + hstep, voffB); PG8_STAGE(PG8_SA(0, 0), a2, voffA);
            PG8_WAIT_V(8); PG8_WAIT_L(0); PG8_BAR; PG8_MMA(1, 0, At, B0); PG8_MMA(1, 1, At, B1); PG8_BAR; PG8_SCHED;
            PG8_LDB(B0, 1, 0); PG8_LDB(B1, 1, 1); PG8_SCHED; PG8_LDA(At, 1, 0); PG8_STAGE(PG8_SA(0, 1), a2 + hstep, voffA);
            PG8_WAIT_V(8); PG8_WAIT_L(0); PG8_BAR; PG8_MMA(0, 0, At, B0); PG8_MMA(0, 1, At, B1); PG8_BAR; PG8_SCHED;
            PG8_LDA(At, 1, 1); PG8_STAGE(PG8_SB(1, 0), b3, voffB); PG8_STAGE(PG8_SB(1, 1), b3 + hstep, voffB); PG8_STAGE(PG8_SA(1, 0), a3, voffA);
            PG8_WAIT_V(8); PG8_WAIT_L(0); PG8_BAR; PG8_MMA(1, 0, At, B0); PG8_MMA(1, 1, At, B1); PG8_BAR; PG8_SCHED;
            } else {
            PG8_LDB(B0, 0, 0); PG8_SCHED; PG8_LDA(At, 0, 0); PG8_STAGE(PG8_SA(1, 1), a1 + hstep, voffA);
            PG8_WAIT_L(8); PG8_BAR; PG8_WAIT_L(0); PG8_MMA(0, 0, At, B0); PG8_BAR; PG8_SCHED;
            PG8_LDB(B1, 0, 1); PG8_STAGE(PG8_SB(0, 0), b2, voffB);
            PG8_BAR; PG8_WAIT_L(0); PG8_MMA(0, 1, At, B1); PG8_BAR;
            PG8_LDA(At, 0, 1); PG8_STAGE(PG8_SA(0, 0), a2, voffA);
            PG8_BAR; PG8_WAIT_L(0); PG8_MMA(1, 0, At, B0); PG8_BAR; PG8_SCHED;
            PG8_STAGE(PG8_SB(0, 1), b2 + hstep, voffB);
            PG8_WAIT_V(6); PG8_BAR; PG8_MMA(1, 1, At, B1); PG8_BAR;
            PG8_LDB(B0, 1, 0); PG8_SCHED; PG8_LDA(At, 1, 0); PG8_STAGE(PG8_SA(0, 1), a2 + hstep, voffA);
            PG8_WAIT_L(8); PG8_BAR; PG8_WAIT_L(0); PG8_MMA(0, 0, At, B0); PG8_BAR; PG8_SCHED;
            PG8_LDB(B1, 1, 1); PG8_STAGE(PG8_SB(1, 0), b3, voffB);
            PG8_BAR; PG8_WAIT_L(0); PG8_MMA(0, 1, At, B1); PG8_BAR;
            PG8_LDA(At, 1, 1); PG8_STAGE(PG8_SA(1, 0), a3, voffA);
            PG8_BAR; PG8_WAIT_L(0); PG8_MMA(1, 0, At, B0); PG8_BAR; PG8_SCHED;
            PG8_STAGE(PG8_SB(1, 1), b3 + hstep, voffB);
            PG8_WAIT_V(6); PG8_BAR; PG8_MMA(1, 1, At, B1); PG8_BAR;
            }
        }
        if constexpr (ALIGN_EPI) { if (wr == 0) PG8_BAR; }
        if constexpr (!Epi::AFTER_DRAIN) { E(acc, cur, wr, wc, fr, fq); S.done(cur); }
        if (!has_next) break;
#pragma unroll
        for (int a = 0; a < 2; ++a)
#pragma unroll
            for (int b = 0; b < 2; ++b)
#pragma unroll
                for (int m = 0; m < 4; ++m)
#pragma unroll
                    for (int n = 0; n < 2; ++n) acc[a][b][m][n] = (f32x4){0.f, 0.f, 0.f, 0.f};
        cur = nxt; cA = nA; cB = nB; ++ui;
        if constexpr (ALIGN_EPI) { if (wr == 1) PG8_BAR; }
    }
    PG8_WAIT_V(0);
    if constexpr (!ALIGN_EPI) { if (wr == 0) PG8_BAR; }
    PG8_BAR;
    if constexpr (Epi::AFTER_DRAIN) { E.fused(acc, cur, wr, wc, fr, fq, lds, wid, lane); S.done(cur); }
#undef PG8_SA
#undef PG8_SB
#undef PG8_STAGE
#undef PG8_LDA
#undef PG8_LDB
#undef PG8_MMA
#undef PG8_WAIT_V
#undef PG8_WAIT_L
#undef PG8_BAR
#undef PG8_SCHED
}
}

#ifndef PG8_SP2
#define PG8_SP2 true
#endif
#ifndef PG8_ALIGN
#define PG8_ALIGN true
#endif
#define GAS __attribute__((address_space(1)))
#define LAS __attribute__((address_space(3)))
typedef unsigned short bf16;
typedef unsigned v4u __attribute__((ext_vector_type(4)));
typedef float f32x4 __attribute__((ext_vector_type(4)));
typedef short bf16x8 __attribute__((ext_vector_type(8)));
typedef GAS unsigned gu32;
typedef GAS unsigned long long gu64;
#define RLX_AGENT __ATOMIC_RELAXED, __HIP_MEMORY_SCOPE_AGENT
#define LDS_WAIT() asm volatile("s_waitcnt lgkmcnt(0)" ::: "memory")
#define VM_WAIT() asm volatile("s_waitcnt vmcnt(0)" ::: "memory")
__device__ __forceinline__ unsigned long long rt() { return __builtin_amdgcn_s_memrealtime(); }
__device__ __forceinline__ unsigned f2bf(float f) { unsigned u = __builtin_bit_cast(unsigned, f); return (u + 0x7fffu + ((u >> 16) & 1u)) >> 16; }
__device__ __forceinline__ unsigned pk2(float lo, float hi) { return f2bf(lo) | (f2bf(hi) << 16); }

#define XB_TMO      128
#define XB_XCNT(j)  (256  + 64 * (j))
#define XB_XSUB(j)  (1280 + 64 * (j))
#define XB_XGEN(j)  (2304 + 64 * (j))
#define XB_TOP      3328
#define XB_TOPGEN   3392
#define XCD_BAR_WORDS 3456
#define XB_SPIN_CAP (1u << 18)

__device__ __forceinline__ unsigned xb_ld(unsigned* p)              { return __hip_atomic_load(p, __ATOMIC_RELAXED, __HIP_MEMORY_SCOPE_AGENT); }
__device__ __forceinline__ unsigned xb_add(unsigned* p, unsigned v) { return __hip_atomic_fetch_add(p, v, __ATOMIC_RELAXED, __HIP_MEMORY_SCOPE_AGENT); }
__device__ __forceinline__ unsigned xb_xcc_id() { return (unsigned)__builtin_amdgcn_s_getreg((3 << 11) | 20) & 0xFu; }
#define XB_SPIN(cond, bar) do { unsigned _sp = 0; while (cond) { __builtin_amdgcn_s_sleep(1); \
    if ((++_sp & 255u) == 0u) { if (xb_ld(&(bar)[XB_TMO])) break; if (_sp > XB_SPIN_CAP) { atomicAdd(&(bar)[XB_TMO], 1u); break; } } } } while (0)

struct XcdBarrier {
    unsigned* bar; unsigned x;
    volatile LAS unsigned* st;
};

__device__ __forceinline__ XcdBarrier xcd_barrier_post(unsigned* bar, volatile LAS unsigned* st) {
    XcdBarrier b; b.bar = bar; b.x = xb_xcc_id(); b.st = st;
    if (threadIdx.x == 0) (void)xb_add(&bar[XB_XCNT(b.x)], 1u);
    return b;
}
__device__ __forceinline__ void xcd_barrier_complete(unsigned* bar, unsigned x, unsigned& nloc, unsigned& nx) {
    const unsigned G = gridDim.x * gridDim.y * gridDim.z;
    unsigned sum, cnt, mine, sp = 0u;
    for (;;) {
        sum = 0u; cnt = 0u; mine = 0u;
#pragma unroll
        for (unsigned j = 0; j < 16; ++j) { const unsigned c = xb_ld(&bar[XB_XCNT(j)]); sum += c; cnt += (c > 0u) ? 1u : 0u; mine = (j == x) ? c : mine; }
        if (sum == G) break;
        __builtin_amdgcn_s_sleep(1);
        if ((++sp & 255u) == 0u) { if (xb_ld(&bar[XB_TMO])) break; if (sp > XB_SPIN_CAP) { atomicAdd(&bar[XB_TMO], 1u); break; } }
    }
    nloc = mine > 0u ? mine : 1u; nx = cnt > 0u ? cnt : 1u;
}

__device__ __forceinline__ void xcd_barrier(const XcdBarrier& b) {
    asm volatile("s_waitcnt vmcnt(0)" ::: "memory");
    __syncthreads();
    if (threadIdx.x == 0) {
        unsigned* bar = b.bar;
        __builtin_amdgcn_s_waitcnt(0);
        unsigned nloc = b.st[0], nx = b.st[1];
        if (nloc == 0u) { xcd_barrier_complete(bar, b.x, nloc, nx); b.st[0] = nloc; b.st[1] = nx; }
        const unsigned old = xb_add(&bar[XB_XSUB(b.x)], 1u);
        const unsigned gen = old / nloc;
        if (old + 1u == (gen + 1u) * nloc) {
            __builtin_amdgcn_fence(__ATOMIC_RELEASE, "agent");
            asm volatile("s_waitcnt vmcnt(0)" ::: "memory");
            const unsigned og = xb_add(&bar[XB_TOP], 1u);
            const unsigned tg = og / nx;
            if (og + 1u == (tg + 1u) * nx) xb_add(&bar[XB_TOPGEN], 1u);
            else XB_SPIN(xb_ld(&bar[XB_TOPGEN]) == tg, bar);
            __builtin_amdgcn_fence(__ATOMIC_ACQUIRE, "agent");
            xb_add(&bar[XB_XGEN(b.x)], 1u);
            asm volatile("s_waitcnt vmcnt(0)" ::: "memory");
        } else {
            XB_SPIN(xb_ld(&bar[XB_XGEN(b.x)]) == gen, bar);
            __builtin_amdgcn_fence(__ATOMIC_ACQUIRE, "agent");
            asm volatile("s_waitcnt vmcnt(0)" ::: "memory");
        }
    }
    __syncthreads();
}

constexpr int NWAVES = 8;
constexpr int BATCH = 8, SEQ = 4096, D = 1024, FF = 2816, NIN = 3072, NH = 4;
constexpr int M = BATCH * SEQ;
constexpr float EPS = 1e-6f;
constexpr float LAM_INIT = 0.2f;
constexpr float LOG2E = 1.4426950408889634f;

constexpr size_t MiB = 1u << 20;
constexpr size_t WS_CTL = 0, CTL_ZERO_BYTES = 1 * MiB;
constexpr size_t WS_SS = 1 * MiB;
constexpr size_t WS_WGU1 = 2 * MiB, WS_WD1 = 13 * MiB, WS_WIN = 19 * MiB, WS_WOUT = 25 * MiB, WS_WGU2 = 27 * MiB, WS_WD2 = 38 * MiB;
constexpr size_t WS_XB = 48 * MiB;
constexpr size_t WS_H = 112 * MiB;
constexpr size_t WS_Q = WS_H, WS_K = WS_H + 32 * MiB, WS_V = WS_H + 64 * MiB, WS_GB = WS_H + 96 * MiB, WS_U = WS_H + 128 * MiB;
constexpr size_t WS_MIX = 288 * MiB;
constexpr size_t WS_O = 352 * MiB;
constexpr size_t WS_END = 416 * MiB;
static_assert(WS_WD2 + (size_t)D * FF * 2 <= WS_XB && WS_U + (size_t)M * 512 * 2 <= WS_H + (size_t)M * FF * 2 && WS_H + (size_t)M * FF * 2 <= WS_MIX, "d_ws map");
constexpr int CW_TMO = 0, CW_CODE = 1, CW_BAR = 4096;

constexpr int RING_OFF = 0, RING_BYTES = 131072;
constexpr int LDSCTL_OFF = RING_BYTES, MISC_OFF = LDSCTL_OFF + 320;
constexpr int LDS_BYTES = 147456;
static_assert(MISC_OFF + 128 <= LDS_BYTES, "LDS map");

typedef unsigned u32x4 __attribute__((ext_vector_type(4)));
typedef float f32x16 __attribute__((ext_vector_type(16)));
typedef short s16x4 __attribute__((ext_vector_type(4)));

struct Frame {
    LAS unsigned char* lds;
    volatile LAS unsigned* MISC;
    gu32* ctl;
    int tid, lane, wave, vcu, G;
};

__device__ __forceinline__ float wave_sum(float v) {
#pragma unroll
    for (int o = 1; o < 64; o <<= 1) v += __shfl_xor(v, o);
    return v;
}

__device__ __forceinline__ void transpose_item(const float* W, int srcN, int s0, int k0, const float* gain, bf16* WT, int K, int n0, LAS float* scr, int lane) {
#pragma unroll 8
    for (int i = 0; i < 32; ++i) { const int kk = 2 * i + (lane >> 5); float v = W[(size_t)(k0 + kk) * srcN + s0 + (lane & 31)]; if (gain) v *= gain[k0 + kk]; scr[kk * 33 + (lane & 31)] = v; }
    LDS_WAIT(); asm volatile("" ::: "memory");
    const int c = lane & 7;
#pragma unroll
    for (int j = 0; j < 4; ++j) { const int n = (lane >> 3) + 8 * j; const LAS float* s = scr + (8 * c) * 33 + n;
        v4u o; o.x = pk2(s[0 * 33], s[1 * 33]); o.y = pk2(s[2 * 33], s[3 * 33]); o.z = pk2(s[4 * 33], s[5 * 33]); o.w = pk2(s[6 * 33], s[7 * 33]);
        *(GAS v4u*)(WT + (size_t)(n0 + n) * K + k0 + 8 * c) = o; }
    LDS_WAIT(); asm volatile("" ::: "memory");
}
struct Args { const float* in[22]; float* out; unsigned char* ws; int ph_lo, ph_hi; };

__device__ __forceinline__ void p0_prologue(Frame& F, const Args& A) {
    LAS float* scr = (LAS float*)(F.lds + RING_OFF + F.wave * 16384);
    const int gw = F.vcu * NWAVES + F.wave, NGW = F.G * NWAVES;
    unsigned char* ws = A.ws;
    constexpr int I_GU = (D / 64) * (2 * FF / 32), I_DN = (FF / 64) * (D / 32), I_IN = (D / 64) * (NIN / 32), I_OUT = (D / 64) * (D / 32);
    constexpr int NITEMS = 2 * I_GU + 2 * I_DN + I_IN + I_OUT;
    for (int it = gw; it < NITEMS; it += NGW) {
        int r = it;
        if (r < 2 * I_GU) {
            const int l = r >= I_GU; if (l) r -= I_GU;
            constexpr int nblk = 2 * FF / 32; const int kb = r / nblk, nb = r % nblk, n0 = 32 * nb;
            const int pn = n0 >> 8, half = (n0 >> 7) & 1, j = n0 & 127;
            const float* W = A.in[l ? (half ? 19 : 18) : (half ? 3 : 2)];
            transpose_item(W, FF, 128 * pn + j, 64 * kb, A.in[l ? 17 : 1], (bf16*)(ws + (l ? WS_WGU2 : WS_WGU1)), D, n0, scr, F.lane);
            continue;
        }
        r -= 2 * I_GU;
        if (r < 2 * I_DN) {
            const int l = r >= I_DN; if (l) r -= I_DN;
            constexpr int nblk = D / 32; const int kb = r / nblk, nb = r % nblk;
            transpose_item(A.in[l ? 20 : 4], D, 32 * nb, 64 * kb, nullptr, (bf16*)(ws + (l ? WS_WD2 : WS_WD1)), FF, 32 * nb, scr, F.lane);
            continue;
        }
        r -= 2 * I_DN;
        if (r < I_IN) {
            constexpr int nblk = NIN / 32; const int kb = r / nblk, nb = r % nblk, n0 = 32 * nb;
            const int pn = n0 >> 8, half = (n0 >> 7) & 1, j = n0 & 127;
            int s0;
            if (pn < 4) s0 = (pn >> 1) * 512 + 64 * (4 * (pn & 1) + (j >> 5)) + 32 * half;
            else if (pn < 8) s0 = n0;
            else s0 = (half ? 2560 : 2048) + 128 * (pn - 8) + j;
            transpose_item(A.in[6], NIN, s0, 64 * kb, A.in[5], (bf16*)(ws + WS_WIN), D, n0, scr, F.lane);
            continue;
        }
        r -= I_IN;
        { constexpr int nblk = D / 32; const int kb = r / nblk, nb = r % nblk;
          transpose_item(A.in[16], D, 32 * nb, 64 * kb, nullptr, (bf16*)(ws + WS_WOUT), D, 32 * nb, scr, F.lane); }
    }
    const float* x = A.in[0]; bf16* xb = (bf16*)(ws + WS_XB); float* ss = (float*)(ws + WS_SS);
    for (int m = gw; m < M; m += NGW) {
        const GAS f32x4* xr = (const GAS f32x4*)(x + (size_t)m * D) + F.lane;
        f32x4 v[4]; float s = 0.f;
#pragma unroll
        for (int j = 0; j < 4; ++j) { v[j] = xr[64 * j]; s += (v[j].x * v[j].x + v[j].y * v[j].y) + (v[j].z * v[j].z + v[j].w * v[j].w); }
        s = wave_sum(s);
        GAS unsigned long long* o8 = (GAS unsigned long long*)(xb + (size_t)m * D) + F.lane;
#pragma unroll
        for (int j = 0; j < 4; ++j) o8[64 * j] = (unsigned long long)pk2(v[j].x, v[j].y) | ((unsigned long long)pk2(v[j].z, v[j].w) << 32);
        if (F.lane == 0) { ss[m] = s; ss[M + m] = 0.f; ss[2 * M + m] = 0.f; }
    }
}

namespace att {
constexpr int L_K0 = 0, L_K1 = 8192, L_V = 16384, L_WS = 32768, L_Q = 36864, L_END = L_Q + 65536;
static_assert(L_END <= RING_BYTES, "attention LDS");
__device__ __forceinline__ int crow(int r, int hi) { return (r & 3) + 8 * (r >> 2) + 4 * hi; }
typedef __bf16 bf16x2_t __attribute__((ext_vector_type(2))); typedef float f32x2_t __attribute__((ext_vector_type(2)));
__device__ __forceinline__ unsigned cvtpk(float lo, float hi) { f32x2_t v = {lo, hi}; bf16x2_t b = __builtin_convertvector(v, bf16x2_t); return __builtin_bit_cast(unsigned, b); }
typedef short v4i16_t __attribute__((ext_vector_type(4)));
__device__ __forceinline__ s16x4 vtr(LAS const unsigned char* p) { return __builtin_bit_cast(s16x4, __builtin_amdgcn_ds_read_tr16_b64_v4i16((LAS v4i16_t*)p)); }

__device__ __forceinline__ void tile_step(f32x16 (&o)[4], float& mrun, float& lrun, LAS const unsigned char* Kt, LAS const unsigned char* Vt, LAS const unsigned char* Qf, LAS float* wsf,
                                          int kbase  , int irel, float sl2, int lane, int r32, int hi) {
    f32x16 p0, p1;
#pragma unroll
    for (int r = 0; r < 16; ++r) { p0[r] = 0.f; p1[r] = 0.f; }
    LAS const unsigned char* kb = Kt + hi * 1024 + r32 * 16;
#pragma unroll
    for (int d0 = 0; d0 < 4; ++d0) {
        const bf16x8 qf = *(LAS const bf16x8*)(Qf + d0 * 1024 + lane * 16);
        const bf16x8 b0 = *(LAS const bf16x8*)(kb + d0 * 2048), b1 = *(LAS const bf16x8*)(kb + d0 * 2048 + 512);
        p0 = __builtin_amdgcn_mfma_f32_32x32x16_bf16(b0, qf, p0, 0, 0, 0);
        p1 = __builtin_amdgcn_mfma_f32_32x32x16_bf16(b1, qf, p1, 0, 0, 0);
    }
    float rm = -INFINITY;
#pragma unroll
    for (int r = 0; r < 16; ++r) {
        const int kv = kbase + (r & 3) + 8 * (r >> 2);
        const float b = sl2 * (float)(kv - irel);
        p0[r] = (kv > irel) ? -INFINITY : p0[r] + b;
        p1[r] = (kv + 32 > irel) ? -INFINITY : p1[r] + (b + 32.0f * sl2);
        rm = fmaxf(rm, fmaxf(p0[r], p1[r]));
    }
    rm = fmaxf(rm, __shfl_xor(rm, 32));
    const float mnew = fmaxf(mrun, rm);
    const float alpha = __builtin_amdgcn_exp2f(mrun - mnew);
    float s = 0.f;
#pragma unroll
    for (int r = 0; r < 16; ++r) { p0[r] = __builtin_amdgcn_exp2f(p0[r] - mnew); p1[r] = __builtin_amdgcn_exp2f(p1[r] - mnew); s += p0[r] + p1[r]; }
    lrun = lrun * alpha + s; mrun = mnew;
    if (hi == 0) wsf[r32] = alpha;
    LDS_WAIT(); asm volatile("" ::: "memory");
#pragma unroll
    for (int r = 0; r < 16; ++r) { const float f = wsf[crow(r, hi)];
#pragma unroll
        for (int d = 0; d < 4; ++d) o[d][r] *= f; }
    u32x4 pw[4];
    pw[0] = (u32x4){cvtpk(p0[0], p0[1]), cvtpk(p0[2], p0[3]), cvtpk(p0[4], p0[5]), cvtpk(p0[6], p0[7])};
    pw[1] = (u32x4){cvtpk(p0[8], p0[9]), cvtpk(p0[10], p0[11]), cvtpk(p0[12], p0[13]), cvtpk(p0[14], p0[15])};
    pw[2] = (u32x4){cvtpk(p1[0], p1[1]), cvtpk(p1[2], p1[3]), cvtpk(p1[4], p1[5]), cvtpk(p1[6], p1[7])};
    pw[3] = (u32x4){cvtpk(p1[8], p1[9]), cvtpk(p1[10], p1[11]), cvtpk(p1[12], p1[13]), cvtpk(p1[14], p1[15])};
    LAS const unsigned char* vb = Vt + ((lane >> 4) & 1) * 32 + (lane & 3) * 8 + (4 * hi + ((lane & 15) >> 2)) * 64;
#pragma unroll
    for (int d0 = 0; d0 < 4; ++d0)
#pragma unroll
        for (int ks = 0; ks < 4; ++ks) {
            const s16x4 lo = vtr(vb + d0 * 4096 + ks * 1024), h8 = vtr(vb + d0 * 4096 + ks * 1024 + 512);
            const bf16x8 vf = (bf16x8){lo[0], lo[1], lo[2], lo[3], h8[0], h8[1], h8[2], h8[3]};
            o[d0] = __builtin_amdgcn_mfma_f32_32x32x16_bf16(__builtin_bit_cast(bf16x8, pw[ks]), vf, o[d0], 0, 0, 0);
        }
    LDS_WAIT(); asm volatile("" ::: "memory");
}

__device__ __forceinline__ void attn_unit(int b, int h, int mc, int qb, const bf16* Qg, const bf16* Kg, const bf16* Vg, bf16* OB, LAS unsigned char* shm) {
    const int tid = threadIdx.x, lane = tid & 63, r32 = lane & 31, hi = lane >> 5; const int wid = __builtin_amdgcn_readfirstlane(tid >> 6);
    const size_t rowbase = (size_t)b * SEQ; const int q0 = qb * 256;
    const float sl2 = LOG2E * __builtin_amdgcn_exp2f(-2.0f * (float)(h + 1));
    LAS float* wsf = (LAS float*)(shm + L_WS) + wid * 128;
    LAS unsigned char* Qf = shm + L_Q + wid * 8192;
    __syncthreads();
    {
        const bf16* qp = Qg + (rowbase + q0 + wid * 32 + r32) * 512 + h * 128 + mc * 64 + hi * 8;
#pragma unroll
        for (int d0 = 0; d0 < 4; ++d0) *(LAS u32x4*)(Qf + d0 * 1024 + lane * 16) = *(const GAS u32x4*)(qp + d0 * 16);
    }
    f32x16 o0[4];
#pragma unroll
    for (int d = 0; d < 4; ++d)
#pragma unroll
        for (int r = 0; r < 16; ++r) o0[d][r] = 0.f;
    float m0 = -INFINITY, l0 = 0.f;
    const int NT = (q0 + 256) / 64; const int irel = wid * 32 + r32;
    for (int t = 0; t < NT; ++t) {
        const int j0 = 64 * t;
        __syncthreads();
        {
            const int row = tid >> 3, ch = tid & 7;
            const u32x4 k0v = *(const GAS u32x4*)(Kg + (rowbase + j0 + row) * 512 + h * 128 + mc * 64 + ch * 8);
            u32x4 vv[2];
#pragma unroll
            for (int i = 0; i < 2; ++i) { const int idx = tid + 512 * i, vr = idx >> 4, c16 = idx & 15; vv[i] = *(const GAS u32x4*)(Vg + (rowbase + j0 + vr) * 512 + h * 128 + c16 * 8); }
            *(LAS u32x4*)(shm + L_K0 + ch * 1024 + row * 16) = k0v;
#pragma unroll
            for (int i = 0; i < 2; ++i) { const int idx = tid + 512 * i, vr = idx >> 4, c16 = idx & 15; *(LAS u32x4*)(shm + L_V + (c16 >> 2) * 4096 + vr * 64 + (c16 & 3) * 16) = vv[i]; }
        }
        __syncthreads();
        const int kbase = j0 - q0 + 4 * hi;
        tile_step(o0, m0, l0, shm + L_K0, shm + L_V, Qf, wsf, kbase, irel, sl2, lane, r32, hi);
    }
    l0 += __shfl_xor(l0, 32);
    if (hi == 0) wsf[r32] = 1.0f / l0;
    LDS_WAIT(); asm volatile("" ::: "memory");
    bf16* op = OB + (rowbase + q0 + wid * 32) * 1024 + h * 256 + mc * 128 + r32;
#pragma unroll
    for (int r = 0; r < 16; ++r) {
        const int cr = crow(r, hi); const float f0 = wsf[cr];
#pragma unroll
        for (int d = 0; d < 4; ++d) op[(size_t)cr * 1024 + 32 * d] = (bf16)f2bf(o0[d][r] * f0);
    }
    LDS_WAIT(); asm volatile("" ::: "memory");
}
}

__device__ __forceinline__ void conv_phase(Frame& F, const bf16* U, const bf16* GB, const float* cw, const float* cn, bf16* MIX) {
    const int gw = F.vcu * NWAVES + F.wave, NGW = F.G * NWAVES; const int ch0 = F.lane * 8;
    float w0[8], w1[8], w2[8], gn[8];
#pragma unroll
    for (int i = 0; i < 8; ++i) { w0[i] = cw[ch0 + i]; w1[i] = cw[512 + ch0 + i]; w2[i] = cw[1024 + ch0 + i]; gn[i] = cn[ch0 + i]; }
    for (int g = gw; g < M / 16; g += NGW) {
        const int t0 = 16 * g;
        float um2[8], um1[8];
        if ((t0 & (SEQ - 1)) == 0) {
#pragma unroll
            for (int i = 0; i < 8; ++i) { um2[i] = 0.f; um1[i] = 0.f; }
        } else {
            const v4u a = *(const GAS v4u*)(U + (size_t)(t0 - 2) * 512 + ch0), b = *(const GAS v4u*)(U + (size_t)(t0 - 1) * 512 + ch0);
#pragma unroll
            for (int i = 0; i < 4; ++i) { um2[2 * i] = __uint_as_float(a[i] << 16); um2[2 * i + 1] = __uint_as_float(a[i] & 0xffff0000u); um1[2 * i] = __uint_as_float(b[i] << 16); um1[2 * i + 1] = __uint_as_float(b[i] & 0xffff0000u); }
        }
        for (int t = t0; t < t0 + 16; ++t) {
            const v4u a = *(const GAS v4u*)(U + (size_t)t * 512 + ch0), b = *(const GAS v4u*)(GB + (size_t)t * 512 + ch0);
            float ut[8], gb[8], c[8]; float s = 0.f;
#pragma unroll
            for (int i = 0; i < 4; ++i) { ut[2 * i] = __uint_as_float(a[i] << 16); ut[2 * i + 1] = __uint_as_float(a[i] & 0xffff0000u); gb[2 * i] = __uint_as_float(b[i] << 16); gb[2 * i + 1] = __uint_as_float(b[i] & 0xffff0000u); }
#pragma unroll
            for (int i = 0; i < 8; ++i) { c[i] = gb[i] * (w0[i] * um2[i] + w1[i] * um1[i] + w2[i] * ut[i]); s += c[i] * c[i]; um2[i] = um1[i]; um1[i] = ut[i]; }
            s += __shfl_xor(s, 1); s += __shfl_xor(s, 2); s += __shfl_xor(s, 4);
            const float rn = __builtin_amdgcn_rsqf(s * (1.0f / 64.0f) + EPS);
            v4u o;
#pragma unroll
            for (int i = 0; i < 4; ++i) o[i] = pk2(c[2 * i] * rn * gn[2 * i], c[2 * i + 1] * rn * gn[2 * i + 1]);
            *(GAS v4u*)(MIX + (size_t)t * 1024 + 512 + ch0) = o;
        }
    }
}

__device__ __forceinline__ void combine_phase(Frame& F, const bf16* OB, const float* subln, float lam, bf16* MIX) {
    const int gw = F.vcu * NWAVES + F.wave, NGW = F.G * NWAVES; const int hh = F.lane >> 4, d0 = 8 * (F.lane & 15);
    float gn[8];
#pragma unroll
    for (int i = 0; i < 8; ++i) gn[i] = subln[d0 + i] * (1.0f - LAM_INIT);
    for (int t = gw; t < M; t += NGW) {
        const v4u a = *(const GAS v4u*)(OB + (size_t)t * 1024 + hh * 256 + d0), b = *(const GAS v4u*)(OB + (size_t)t * 1024 + hh * 256 + 128 + d0);
        float c[8]; float s = 0.f;
#pragma unroll
        for (int i = 0; i < 4; ++i) { c[2 * i] = __uint_as_float(a[i] << 16) - lam * __uint_as_float(b[i] << 16); c[2 * i + 1] = __uint_as_float(a[i] & 0xffff0000u) - lam * __uint_as_float(b[i] & 0xffff0000u); }
#pragma unroll
        for (int i = 0; i < 8; ++i) s += c[i] * c[i];
        s += __shfl_xor(s, 1); s += __shfl_xor(s, 2); s += __shfl_xor(s, 4); s += __shfl_xor(s, 8);
        const float rn = __builtin_amdgcn_rsqf(s * (1.0f / 128.0f) + EPS);
        v4u o;
#pragma unroll
        for (int i = 0; i < 4; ++i) o[i] = pk2(c[2 * i] * rn * gn[2 * i], c[2 * i + 1] * rn * gn[2 * i + 1]);
        *(GAS v4u*)(MIX + (size_t)t * 1024 + hh * 128 + d0) = o;
    }
}

__device__ __forceinline__ void final_norm_phase(Frame& F, float* out, const float* gain) {
    const int gw = F.vcu * NWAVES + F.wave, NGW = F.G * NWAVES;
    f32x4 gv[4];
#pragma unroll
    for (int j = 0; j < 4; ++j) gv[j] = *((const GAS f32x4*)gain + F.lane + 64 * j);
    for (int m = gw; m < M; m += NGW) {
        GAS f32x4* xr = (GAS f32x4*)(out + (size_t)m * D) + F.lane;
        f32x4 v[4]; float s = 0.f;
#pragma unroll
        for (int j = 0; j < 4; ++j) { v[j] = xr[64 * j]; s += (v[j].x * v[j].x + v[j].y * v[j].y) + (v[j].z * v[j].z + v[j].w * v[j].w); }
        s = wave_sum(s);
        const float r = __builtin_amdgcn_rsqf(s * (1.0f / D) + EPS);
#pragma unroll
        for (int j = 0; j < 4; ++j) xr[64 * j] = v[j] * r * gv[j];
    }
}

constexpr int N_PHASES = 10;
__global__ void __launch_bounds__(NWAVES * 64, 2) fwd_kernel(Args args) {
    extern __shared__ __attribute__((aligned(16))) unsigned char lds[];
    Frame F;
    F.lds = (LAS unsigned char*)lds;
    F.MISC = (volatile LAS unsigned*)(F.lds + MISC_OFF);
    F.tid = threadIdx.x; F.lane = F.tid & 63; F.wave = __builtin_amdgcn_readfirstlane(F.tid >> 6);
    F.G = gridDim.x; { const int bx = blockIdx.x; F.vcu = (F.G % 8 == 0) ? (bx % 8) * (F.G / 8) + bx / 8 : bx; }
    unsigned char* ws = args.ws;
    F.ctl = (gu32*)(ws + WS_CTL);
    for (int u = F.tid; u < (LDS_BYTES - LDSCTL_OFF) / 4; u += NWAVES * 64) ((LAS unsigned*)(F.lds + LDSCTL_OFF))[u] = 0u;
    __syncthreads();
    const int lo = args.ph_lo, hi = args.ph_hi;
    const bool one_launch = (hi - lo) > 1;
    XcdBarrier bar; bar.bar = (unsigned*)(F.ctl + CW_BAR); bar.x = 0; bar.st = nullptr;
    if (one_launch) bar = xcd_barrier_post((unsigned*)(F.ctl + CW_BAR), F.MISC + 8);
#ifndef PHASE_MASK
#define PHASE_MASK 0x3ff
#endif
#define IN(k) (((PHASE_MASK >> (k)) & 1) && lo <= (k) && (k) < hi)
#define SEAM(k) do { if (IN(k) && IN((k) + 1)) xcd_barrier(bar); } while (0)

    float* ss = (float*)(ws + WS_SS);
    bf16* XB = (bf16*)(ws + WS_XB); bf16* HB = (bf16*)(ws + WS_H); bf16* MIX = (bf16*)(ws + WS_MIX);
    bf16 *QB_ = (bf16*)(ws + WS_Q), *KB_ = (bf16*)(ws + WS_K), *VB_ = (bf16*)(ws + WS_V), *GBB = (bf16*)(ws + WS_GB), *UB = (bf16*)(ws + WS_U), *OBB = (bf16*)(ws + WS_O);

    if (IN(0)) { p0_prologue(F, args); } SEAM(0);
    if (IN(1)) {
        pg8::Gemm g{XB, (const bf16*)(ws + WS_WGU1), M, 2 * FF, D}; pg8::StaticOrder S; S.init(M, 2 * FF, F.G, (int)blockIdx.x);
        pg8::EpiSwiGLU E{HB, FF, ss, 1.0f / D};
        pg8::gemm_phase<pg8::EpiSwiGLU, pg8::StaticOrder, PG8_ALIGN, PG8_SP2>(F.lds + RING_OFF, g, S, E);
    } SEAM(1);
    if (IN(2)) {
        pg8::Gemm g{HB, (const bf16*)(ws + WS_WD1), M, D, FF}; pg8::StaticOrder S; S.init(M, D, F.G, (int)blockIdx.x);
        pg8::EpiRes E{args.in[0], args.out, XB, ss + M, 0.5f};
        pg8::gemm_phase<pg8::EpiRes, pg8::StaticOrder, PG8_ALIGN, PG8_SP2>(F.lds + RING_OFF, g, S, E);
    } SEAM(2);
    if (IN(3)) {
        pg8::Gemm g{XB, (const bf16*)(ws + WS_WIN), M, NIN, D}; pg8::StaticOrder S; S.init(M, NIN, F.G, (int)blockIdx.x);
        pg8::EpiIn E{QB_, KB_, VB_, GBB, UB, ss + M, args.in[7], args.in[8], 0.125f * LOG2E};
        pg8::gemm_phase<pg8::EpiIn, pg8::StaticOrder, PG8_ALIGN, PG8_SP2>(F.lds + RING_OFF, g, S, E);
    } SEAM(3);
    if (IN(4)) {
        conv_phase(F, UB, GBB, args.in[14], args.in[15], MIX);
        const int nun = BATCH * NH * 32;
        for (int i = 0; ; ++i) {
            const int L = i * F.G + F.vcu; if (L >= nun) break;
            const int round = L / 256, w = L % 256, bh = w >> 3, s = w & 7; const int qb = (round & 1) ? 15 - s : s, mc = round >> 1;
            att::attn_unit(bh >> 2, bh & 3, mc, qb, QB_, KB_, VB_, OBB, F.lds + RING_OFF);
        }
    } SEAM(4);
    if (IN(5)) {
        float lam;
        { const float a = args.in[9][F.lane] * args.in[10][F.lane], b2 = args.in[11][F.lane] * args.in[12][F.lane];
          lam = expf(wave_sum(a)) - expf(wave_sum(b2)) + LAM_INIT; }
        combine_phase(F, OBB, args.in[13], lam, MIX);
    } SEAM(5);
    if (IN(6)) {
        pg8::Gemm g{MIX, (const bf16*)(ws + WS_WOUT), M, D, D}; pg8::StaticOrder S; S.init(M, D, F.G, (int)blockIdx.x);
        pg8::EpiRes E{args.out, args.out, XB, ss + 2 * M, 1.0f};
        pg8::gemm_phase<pg8::EpiRes, pg8::StaticOrder, PG8_ALIGN, PG8_SP2>(F.lds + RING_OFF, g, S, E);
    } SEAM(6);
    if (IN(7)) {
        pg8::Gemm g{XB, (const bf16*)(ws + WS_WGU2), M, 2 * FF, D}; pg8::StaticOrder S; S.init(M, 2 * FF, F.G, (int)blockIdx.x);
        pg8::EpiSwiGLU E{HB, FF, ss + 2 * M, 1.0f / D};
        pg8::gemm_phase<pg8::EpiSwiGLU, pg8::StaticOrder, PG8_ALIGN, PG8_SP2>(F.lds + RING_OFF, g, S, E);
    } SEAM(7);
    if (IN(8)) {
        pg8::Gemm g{HB, (const bf16*)(ws + WS_WD2), M, D, FF}; pg8::StaticOrder S; S.init(M, D, F.G, (int)blockIdx.x);
        pg8::EpiRes E{args.out, args.out, nullptr, nullptr, 0.5f};
        pg8::gemm_phase<pg8::EpiRes, pg8::StaticOrder, PG8_ALIGN, PG8_SP2>(F.lds + RING_OFF, g, S, E);
    } SEAM(8);
    if (IN(9)) final_norm_phase(F, args.out, args.in[21]);
#undef IN
#undef SEAM
}

#ifndef MK_N_LAUNCHES
#define MK_N_LAUNCHES 10
#endif
extern "C" void kernel_launch(void* const* d_in, const int* in_sizes, int n_in, void* d_out, int out_size, void* d_ws, size_t ws_size, hipStream_t stream) {
    static int grid = 0;
    if (grid == 0) {
        if (n_in != 22 || in_sizes[0] != M * D || out_size != M * D || ws_size < WS_END) { fprintf(stderr, "kernel_launch: unexpected shapes (n_in %d, in0 %d, out %d, ws %zu); nothing launched\n", n_in, n_in > 0 ? in_sizes[0] : -1, out_size, ws_size); grid = -1; return; }
        int dev = 0, cus = 0;
        if (hipGetDevice(&dev) != hipSuccess || hipDeviceGetAttribute(&cus, hipDeviceAttributeMultiprocessorCount, dev) != hipSuccess) { grid = -1; return; }
        if (hipFuncSetAttribute((const void*)fwd_kernel, hipFuncAttributeMaxDynamicSharedMemorySize, LDS_BYTES) != hipSuccess) { fprintf(stderr, "kernel_launch: hipFuncSetAttribute failed\n"); grid = -1; return; }
        (void)hipGetLastError();
        grid = cus;
    }
    if (grid < 0) return;
    if (hipMemsetAsync((char*)d_ws + WS_CTL, 0, CTL_ZERO_BYTES, stream) != hipSuccess) return;
    Args a{};
    for (int i = 0; i < 22; ++i) a.in[i] = (const float*)d_in[i];
    a.out = (float*)d_out; a.ws = (unsigned char*)d_ws;
    if (MK_N_LAUNCHES == 1) { a.ph_lo = 0; a.ph_hi = N_PHASES; hipLaunchKernelGGL(fwd_kernel, dim3(grid), dim3(NWAVES * 64), LDS_BYTES, stream, a); }
    else for (int p = 0; p < N_PHASES; ++p) { a.ph_lo = p; a.ph_hi = p + 1; hipLaunchKernelGGL(fwd_kernel, dim3(grid), dim3(NWAVES * 64), LDS_BYTES, stream, a); }
}
```

```cpp
#include <hip/hip_runtime.h>
#include <cstdio>
#include <cstdint>
namespace pg8 {
#define PG8_LAS __attribute__((address_space(3)))
typedef unsigned short bf16_t;
typedef short bf16x8 __attribute__((ext_vector_type(8)));
typedef float f32x4 __attribute__((ext_vector_type(4)));
typedef unsigned u32x4 __attribute__((ext_vector_type(4)));
constexpr int BM = 256, BK = 64, HALF = 128, HTB = HALF * BK * 2  , STAGE_BYTES = 8 * HTB, NXCD = 8, WGM = 8;

__host__ __device__ __forceinline__ int lds_byte(int r, int c) { const int st = (r >> 4) * 2 + (c >> 5), rr = r & 15, cc = c & 31, ob = rr * 64 + cc * 2; return st * 1024 + (ob ^ (((ob >> 9) & 1) << 5)); }
__host__ __device__ __forceinline__ void stage_rc(int b, int& R, int& C) { const int st = b / 1024, sb = b % 1024, swz = sb ^ (((sb >> 9) & 1) << 5); R = (st >> 1) * 16 + swz / 64; C = (st & 1) * 32 + (swz % 64) / 2; }
__host__ __device__ __forceinline__ int perm32(int rho) { const int n = rho >> 4, i = rho & 15; return 8 * (i >> 2) + 4 * n + (i & 3); }

struct Unit { int pm, pn; };
struct Gemm { const bf16_t* A; const bf16_t* Bt; int M, N, K; };

struct StaticOrder {
    int nM, nN, nwg, G, c;
    __host__ __device__ void init(int M, int N, int G_, int c_) { nM = M / BM; nN = N / BM; nwg = nM * nN; G = G_; c = c_; }
    __host__ __device__ bool next(int i, Unit& u) const {
        const long L = (long)i * G + c; if (L >= nwg) return false;
        int wgid = (int)L; { const int q = nwg / NXCD, r = nwg % NXCD, xcd = wgid % NXCD, off = wgid / NXCD; wgid = (xcd < r ? xcd * (q + 1) : r * (q + 1) + (xcd - r) * q) + off; }
        const int nig = WGM * nN, gid = wgid / nig, fm = gid * WGM, gsz = (nM - fm) < WGM ? (nM - fm) : WGM;
        u.pm = fm + ((wgid % nig) % gsz); u.pn = (wgid % nig) / gsz; return true;
    }
    __device__ __forceinline__ void a_ready(const Unit&) const {}
    __device__ __forceinline__ void done(const Unit&) const {}
};

__device__ __forceinline__ unsigned cvt_pk_bf16(float lo, float hi) { unsigned r; asm volatile("v_cvt_pk_bf16_f32 %0, %1, %2" : "=v"(r) : "v"(lo), "v"(hi)); return r; }
typedef float f32x2 __attribute__((ext_vector_type(2)));
typedef unsigned u32x2 __attribute__((ext_vector_type(2)));
constexpr float NORM_EPS = 1e-6f;
__device__ __forceinline__ float silu_mul(float g, float u) {
    const float e = __builtin_amdgcn_exp2f(g * -1.4426950408889634f);
    return g * u * __builtin_amdgcn_rcpf(1.0f + e);
}
struct EpiSwiGLU {
    static constexpr bool PERM = true, AFTER_DRAIN = false;
    bf16_t* Hout; int ldh; const float* ss; float inv_k;
    __device__ __forceinline__ void operator()(const f32x4 (&acc)[2][2][4][2], const Unit& u, int wr, int wc, int fr, int fq) const {
        const int row0 = u.pm * BM + wr * 64 + fr, col0 = u.pn * HALF + wc * 32 + 8 * fq;
#pragma unroll
        for (int ai = 0; ai < 2; ++ai)
#pragma unroll
            for (int m = 0; m < 4; ++m) {
                const int row = row0 + ai * HALF + m * 16;
                const float rs = __builtin_amdgcn_rsqf(ss[row] * inv_k + NORM_EPS);
                const f32x4 g0 = acc[ai][0][m][0] * rs, g1 = acc[ai][0][m][1] * rs, u0 = acc[ai][1][m][0] * rs, u1 = acc[ai][1][m][1] * rs;
                u32x4 w;
                w.x = cvt_pk_bf16(silu_mul(g0[0], u0[0]), silu_mul(g0[1], u0[1]));
                w.y = cvt_pk_bf16(silu_mul(g0[2], u0[2]), silu_mul(g0[3], u0[3]));
                w.z = cvt_pk_bf16(silu_mul(g1[0], u1[0]), silu_mul(g1[1], u1[1]));
                w.w = cvt_pk_bf16(silu_mul(g1[2], u1[2]), silu_mul(g1[3], u1[3]));
                *(u32x4*)(Hout + (size_t)row * ldh + col0) = w;
            }
    }
};
struct EpiRes {
    static constexpr bool PERM = false, AFTER_DRAIN = false;
    const float* res; float* out; bf16_t* outb; float* ssacc; float scale;
    __device__ __forceinline__ void operator()(const f32x4 (&acc)[2][2][4][2], const Unit& u, int wr, int wc, int fr, int fq) const {
        const int row0 = u.pm * BM + wr * 64 + fr, col0 = u.pn * BM + wc * 32 + 4 * fq;
#pragma unroll
        for (int ai = 0; ai < 2; ++ai) {
            float srow[4];
#pragma unroll
            for (int m = 0; m < 4; ++m) {
                const size_t off = (size_t)(row0 + ai * HALF + m * 16) * 1024 + col0;
                float s = 0.f;
#pragma unroll
                for (int bj = 0; bj < 2; ++bj)
#pragma unroll
                    for (int n = 0; n < 2; ++n) {
                        const f32x4 r4 = *(const f32x4*)(res + off + bj * HALF + n * 16);
                        const f32x4 o = r4 + acc[ai][bj][m][n] * scale;
                        *(f32x4*)(out + off + bj * HALF + n * 16) = o;
                        if (outb) { u32x2 w; w.x = cvt_pk_bf16(o[0], o[1]); w.y = cvt_pk_bf16(o[2], o[3]); *(u32x2*)(outb + off + bj * HALF + n * 16) = w; }
                        s += (o[0] * o[0] + o[1] * o[1]) + (o[2] * o[2] + o[3] * o[3]);
                    }
                s += __shfl_xor(s, 16); s += __shfl_xor(s, 32);
                srow[m] = s;
                asm volatile("" ::: "memory");
            }
            if (ssacc) {
                const float v = fq == 0 ? srow[0] : fq == 1 ? srow[1] : fq == 2 ? srow[2] : srow[3];
                atomicAdd(ssacc + u.pm * BM + ai * HALF + wr * 64 + fq * 16 + fr, v);
            }
        }
    }
};
struct EpiIn {
    static constexpr bool PERM = true, AFTER_DRAIN = false;
    bf16_t *Q, *K, *V, *GB, *U;
    const float* ss; const float* qg; const float* kg; float qscale;
    __device__ __forceinline__ void operator()(const f32x4 (&acc)[2][2][4][2], const Unit& u, int wr, int wc, int fr, int fq) const {
        const int row0 = u.pm * BM + wr * 64 + fr; const int pn = u.pn;
        if (pn < 4) {
            bf16_t* dst = (pn < 2 ? Q : K) + (size_t)(64 * (4 * (pn & 1) + wc)) + 8 * fq;
            const float* gp = (pn < 2 ? qg : kg) + 8 * fq; const float sc = pn < 2 ? qscale : 1.0f;
            f32x4 gv[2][2];
#pragma unroll
            for (int bj = 0; bj < 2; ++bj)
#pragma unroll
                for (int n = 0; n < 2; ++n) gv[bj][n] = *(const f32x4*)(gp + 32 * bj + 4 * n) * sc;
#pragma unroll
            for (int ai = 0; ai < 2; ++ai)
#pragma unroll
                for (int m = 0; m < 4; ++m) {
                    const int row = row0 + ai * HALF + m * 16;
                    const float rs = __builtin_amdgcn_rsqf(ss[row] * (1.0f / 1024.0f) + NORM_EPS);
                    f32x4 t[2][2]; float s = 0.f;
#pragma unroll
                    for (int bj = 0; bj < 2; ++bj)
#pragma unroll
                        for (int n = 0; n < 2; ++n) { t[bj][n] = acc[ai][bj][m][n] * rs; const f32x4 x = t[bj][n]; s += (x[0] * x[0] + x[1] * x[1]) + (x[2] * x[2] + x[3] * x[3]); }
                    s += __shfl_xor(s, 16); s += __shfl_xor(s, 32);
                    const float rn = __builtin_amdgcn_rsqf(s * (1.0f / 64.0f) + NORM_EPS);
#pragma unroll
                    for (int bj = 0; bj < 2; ++bj) {
                        const f32x4 a = t[bj][0] * rn * gv[bj][0], b = t[bj][1] * rn * gv[bj][1];
                        u32x4 w; w.x = cvt_pk_bf16(a[0], a[1]); w.y = cvt_pk_bf16(a[2], a[3]); w.z = cvt_pk_bf16(b[0], b[1]); w.w = cvt_pk_bf16(b[2], b[3]);
                        *(u32x4*)(dst + (size_t)row * 512 + 32 * bj) = w;
                    }
                }
        } else if (pn < 8) {
            bf16_t* dst = (pn < 6 ? V : GB) + (size_t)(256 * (pn & 1) + wc * 32 + 8 * fq);
#pragma unroll
            for (int ai = 0; ai < 2; ++ai)
#pragma unroll
                for (int m = 0; m < 4; ++m) {
                    const int row = row0 + ai * HALF + m * 16;
                    const float rs = __builtin_amdgcn_rsqf(ss[row] * (1.0f / 1024.0f) + NORM_EPS);
#pragma unroll
                    for (int bj = 0; bj < 2; ++bj) {
                        const f32x4 a = acc[ai][bj][m][0] * rs, b = acc[ai][bj][m][1] * rs;
                        u32x4 w; w.x = cvt_pk_bf16(a[0], a[1]); w.y = cvt_pk_bf16(a[2], a[3]); w.z = cvt_pk_bf16(b[0], b[1]); w.w = cvt_pk_bf16(b[2], b[3]);
                        *(u32x4*)(dst + (size_t)row * 512 + HALF * bj) = w;
                    }
                }
        } else {
            bf16_t* dst = U + (size_t)(128 * (pn - 8) + wc * 32 + 8 * fq);
#pragma unroll
            for (int ai = 0; ai < 2; ++ai)
#pragma unroll
                for (int m = 0; m < 4; ++m) {
                    const int row = row0 + ai * HALF + m * 16;
                    const float rs = __builtin_amdgcn_rsqf(ss[row] * (1.0f / 1024.0f) + NORM_EPS); const float rs2 = rs * rs;
                    const f32x4 a = acc[ai][0][m][0] * acc[ai][1][m][0] * rs2, b = acc[ai][0][m][1] * acc[ai][1][m][1] * rs2;
                    u32x4 w; w.x = cvt_pk_bf16(a[0], a[1]); w.y = cvt_pk_bf16(a[2], a[3]); w.z = cvt_pk_bf16(b[0], b[1]); w.w = cvt_pk_bf16(b[2], b[3]);
                    *(u32x4*)(dst + (size_t)row * 512) = w;
                }
        }
    }
};

template <class Epi, class Sched, bool ALIGN_EPI = false, bool SP2 = false>
__device__ __forceinline__ void gemm_phase(PG8_LAS unsigned char* lds, const Gemm g, const Sched& S, const Epi& E) {
    const int tid = threadIdx.x, wid = __builtin_amdgcn_readfirstlane(tid >> 6), lane = tid & 63, wr = wid >> 2, wc = wid & 3, fr = lane & 15, fq = lane >> 4;
    const int K = g.K, nt = K / BK;
    unsigned voffA[2], voffB[2];
#pragma unroll
    for (int i = 0; i < 2; ++i) { int R, C; stage_rc(tid * 16 + i * 8192, R, C); const int Rb = Epi::PERM ? ((R & ~31) + perm32(R & 31)) : R;
        voffA[i] = (unsigned)(R * K + C) * 2u; voffB[i] = (unsigned)(Rb * K + C) * 2u; }
    const size_t kstep = (size_t)(BK * 2);
    const size_t hstep = (size_t)HALF * K * 2;
    const size_t tstep = 2 * hstep;
    const unsigned ldsw = (unsigned)wid * 1024u;
    const int aoff = lds_byte(wr * 64 + fr, fq * 8), boff = lds_byte(wc * 32 + fr, fq * 8);
#define PG8_SA(b, h) (((b) * 2 + (h)) * HTB)
#define PG8_SB(b, h) ((4 + (b) * 2 + (h)) * HTB)
#define PG8_STAGE(bufoff, gbase, voff) do { _Pragma("unroll") for (int _i = 0; _i < 2; ++_i) \
        __builtin_amdgcn_global_load_lds((const unsigned*)((const char*)(gbase) + (voff)[_i]), (PG8_LAS unsigned*)(lds + (bufoff) + ldsw + _i * 8192), 16, 0, 0); } while (0)
#define PG8_LDA(dst, b, h) do { _Pragma("unroll") for (int m = 0; m < 4; ++m) _Pragma("unroll") for (int k = 0; k < 2; ++k) dst[m][k] = *(const PG8_LAS bf16x8*)(lds + PG8_SA(b, h) + aoff + m * 2048 + k * 1024); } while (0)
#define PG8_LDB(dst, b, h) do { _Pragma("unroll") for (int n = 0; n < 2; ++n) _Pragma("unroll") for (int k = 0; k < 2; ++k) dst[n][k] = *(const PG8_LAS bf16x8*)(lds + PG8_SB(b, h) + boff + n * 2048 + k * 1024); } while (0)
#define PG8_MMA(ai, bj, At, Bt) do { __builtin_amdgcn_s_setprio(1); _Pragma("unroll") for (int m = 0; m < 4; ++m) _Pragma("unroll") for (int n = 0; n < 2; ++n) _Pragma("unroll") for (int k = 0; k < 2; ++k) \
        acc[ai][bj][m][n] = __builtin_amdgcn_mfma_f32_16x16x32_bf16(Bt[n][k], At[m][k], acc[ai][bj][m][n], 0, 0, 0); __builtin_amdgcn_s_setprio(0); } while (0)
#define PG8_WAIT_V(n) asm volatile("s_waitcnt vmcnt(" #n ")" ::: "memory")
#define PG8_WAIT_L(n) asm volatile("s_waitcnt lgkmcnt(" #n ")" ::: "memory")
#define PG8_BAR __builtin_amdgcn_s_barrier()
#define PG8_SCHED __builtin_amdgcn_sched_barrier(0)
    Unit cur, nxt; int ui = 0;
    if (!S.next(0, cur)) return;
    f32x4 acc[2][2][4][2];
#pragma unroll
    for (int a = 0; a < 2; ++a)
#pragma unroll
        for (int b = 0; b < 2; ++b)
#pragma unroll
            for (int m = 0; m < 4; ++m)
#pragma unroll
                for (int n = 0; n < 2; ++n) acc[a][b][m][n] = (f32x4){0.f, 0.f, 0.f, 0.f};
    bf16x8 At[4][2], B0[2][2], B1[2][2];
    const char* cA = (const char*)g.A + (size_t)cur.pm * tstep; const char* cB = (const char*)g.Bt + (size_t)cur.pn * tstep;
    S.a_ready(cur);
    if constexpr (SP2) {
        PG8_STAGE(PG8_SB(0, 0), cB, voffB); PG8_STAGE(PG8_SB(0, 1), cB + hstep, voffB); PG8_STAGE(PG8_SA(0, 0), cA, voffA); PG8_STAGE(PG8_SA(0, 1), cA + hstep, voffA);
        if (wr == 1) PG8_BAR;
        PG8_WAIT_V(2); PG8_BAR;
        PG8_STAGE(PG8_SB(1, 0), cB + kstep, voffB); PG8_STAGE(PG8_SA(1, 0), cA + kstep, voffA); PG8_STAGE(PG8_SB(1, 1), cB + hstep + kstep, voffB);
        PG8_WAIT_V(6); PG8_BAR;
    } else {
        PG8_STAGE(PG8_SB(0, 0), cB, voffB); PG8_STAGE(PG8_SA(0, 0), cA, voffA); PG8_STAGE(PG8_SB(0, 1), cB + hstep, voffB); PG8_STAGE(PG8_SA(0, 1), cA + hstep, voffA);
        if (wr == 1) PG8_BAR;
        PG8_WAIT_V(4); PG8_BAR;
        PG8_STAGE(PG8_SB(1, 0), cB + kstep, voffB); PG8_STAGE(PG8_SA(1, 0), cA + kstep, voffA); PG8_STAGE(PG8_SB(1, 1), cB + hstep + kstep, voffB);
        PG8_WAIT_V(6); PG8_BAR;
    }
    for (;;) {
        const bool has_next = S.next(ui + 1, nxt);
        const char* nA = has_next ? (const char*)g.A + (size_t)nxt.pm * tstep : cA; const char* nB = has_next ? (const char*)g.Bt + (size_t)nxt.pn * tstep : cB;
        for (int t = 0; t < nt; t += 2) {
            const bool last = (t == nt - 2);
            const char* a1 = cA + (size_t)(t + 1) * kstep;
            const char* a2 = last ? nA : cA + (size_t)(t + 2) * kstep; const char* b2 = last ? nB : cB + (size_t)(t + 2) * kstep;
            const char* a3 = a2 + kstep; const char* b3 = b2 + kstep;
            if (last && has_next) S.a_ready(nxt);
            if constexpr (SP2) {
            PG8_LDB(B0, 0, 0); PG8_LDB(B1, 0, 1); PG8_SCHED; PG8_LDA(At, 0, 0); PG8_STAGE(PG8_SA(1, 1), a1 + hstep, voffA);
            PG8_WAIT_V(8); PG8_WAIT_L(0); PG8_BAR; PG8_MMA(0, 0, At, B0); PG8_MMA(0, 1, At, B1); PG8_BAR; PG8_SCHED;
            PG8_LDA(At, 0, 1); PG8_STAGE(PG8_SB(0, 0), b2, voffB); PG8_STAGE(PG8_SB(0, 1), b2 + hstep, voffB); PG8_STAGE(PG8_SA(0, 0), a2, voffA);
            PG8_WAIT_V(8); PG8_WAIT_L(0); PG8_BAR; PG8_MMA(1, 0, At, B0); PG8_MMA(1, 1, At, B1); PG8_BAR; PG8_SCHED;
            PG8_LDB(B0, 1, 0); PG8_LDB(B1, 1, 1); PG8_SCHED; PG8_LDA(At, 1, 0); PG8_STAGE(PG8_SA(0, 1), a2 + hstep, voffA);
            PG8_WAIT_V(8); PG8_WAIT_L(0); PG8_BAR; PG8_MMA(0, 0, At, B0); PG8_MMA(0, 1, At, B1); PG8_BAR; PG8_SCHED;
            PG8_LDA(At, 1, 1); PG8_STAGE(PG8_SB(1, 0), b3, voffB); PG8_STAGE(PG8_SB(1, 1), b3 + hstep, voffB); PG8_STAGE(PG8_SA(1, 0), a3, voffA);
            PG8_WAIT_V(8); PG8_WAIT_L(0); PG8_BAR; PG8_MMA(1, 0, At, B0); PG8_MMA(1, 1, At, B1); PG8_BAR; PG8_SCHED;
            } else {
            PG8_LDB(B0, 0, 0); PG8_SCHED; PG8_LDA(At, 0, 0); PG8_STAGE(PG8_SA(1, 1), a1 + hstep, voffA);
            PG8_WAIT_L(8); PG8_BAR; PG8_WAIT_L(0); PG8_MMA(0, 0, At, B0); PG8_BAR; PG8_SCHED;
            PG8_LDB(B1, 0, 1); PG8_STAGE(PG8_SB(0, 0), b2, voffB);
            PG8_BAR; PG8_WAIT_L(0); PG8_MMA(0, 1, At, B1); PG8_BAR;
            PG8_LDA(At, 0, 1); PG8_STAGE(PG8_SA(0, 0), a2, voffA);
            PG8_BAR; PG8_WAIT_L(0); PG8_MMA(1, 0, At, B0); PG8_BAR; PG8_SCHED;
            PG8_STAGE(PG8_SB(0, 1), b2 + hstep, voffB);
            PG8_WAIT_V(6); PG8_BAR; PG8_MMA(1, 1, At, B1); PG8_BAR;
            PG8_LDB(B0, 1, 0); PG8_SCHED; PG8_LDA(At, 1, 0); PG8_STAGE(PG8_SA(0, 1), a2 + hstep, voffA);
            PG8_WAIT_L(8); PG8_BAR; PG8_WAIT_L(0); PG8_MMA(0, 0, At, B0); PG8_BAR; PG8_SCHED;
            PG8_LDB(B1, 1, 1); PG8_STAGE(PG8_SB(1, 0), b3, voffB);
            PG8_BAR; PG8_WAIT_L(0); PG8_MMA(0, 1, At, B1); PG8_BAR;
            PG8_LDA(At, 1, 1); PG8_STAGE(PG8_SA(1, 0), a3, voffA);
            PG8_BAR; PG8_WAIT_L(0); PG8_MMA(1, 0, At, B0); PG8_BAR; PG8_SCHED;
            PG8_STAGE(PG8_SB(1, 1), b3 + hstep, voffB);
            PG8_WAIT_V(6); PG8_BAR; PG8_MMA(1, 1, At, B1); PG8_BAR;
            }
        }
        if constexpr (ALIGN_EPI) { if (wr == 0) PG8_BAR; }
        if constexpr (!Epi::AFTER_DRAIN) { E(acc, cur, wr, wc, fr, fq); S.done(cur); }
        if (!has_next) break;
#pragma unroll
        for (int a = 0; a < 2; ++a)
#pragma unroll
            for (int b = 0; b < 2; ++b)
#pragma unroll
                for (int m = 0; m < 4; ++m)
#pragma unroll
                    for (int n = 0; n < 2; ++n) acc[a][b][m][n] = (f32x4){0.f, 0.f, 0.f, 0.f};
        cur = nxt; cA = nA; cB = nB; ++ui;
        if constexpr (ALIGN_EPI) { if (wr == 1) PG8_BAR; }
    }
    PG8_WAIT_V(0);
    if constexpr (!ALIGN_EPI) { if (wr == 0) PG8_BAR; }
    PG8_BAR;
    if constexpr (Epi::AFTER_DRAIN) { E.fused(acc, cur, wr, wc, fr, fq, lds, wid, lane); S.done(cur); }
#undef PG8_SA
#undef PG8_SB
#undef PG8_STAGE
#undef PG8_LDA
#undef PG8_LDB
#undef PG8_MMA
#undef PG8_WAIT_V
#undef PG8_WAIT_L
#undef PG8_BAR
#undef PG8_SCHED
}
}

#ifndef PG8_SP2
#define PG8_SP2 true
#endif
#ifndef PG8_ALIGN
#define PG8_ALIGN true
#endif
#define GAS __attribute__((address_space(1)))
#define LAS __attribute__((address_space(3)))
typedef unsigned short bf16;
typedef unsigned v4u __attribute__((ext_vector_type(4)));
typedef float f32x4 __attribute__((ext_vector_type(4)));
typedef short bf16x8 __attribute__((ext_vector_type(8)));
typedef GAS unsigned gu32;
typedef GAS unsigned long long gu64;
#define RLX_AGENT __ATOMIC_RELAXED, __HIP_MEMORY_SCOPE_AGENT
#define LDS_WAIT() asm volatile("s_waitcnt lgkmcnt(0)" ::: "memory")
#define VM_WAIT() asm volatile("s_waitcnt vmcnt(0)" ::: "memory")
__device__ __forceinline__ unsigned long long rt() { return __builtin_amdgcn_s_memrealtime(); }
__device__ __forceinline__ unsigned f2bf(float f) { unsigned u = __builtin_bit_cast(unsigned, f); return (u + 0x7fffu + ((u >> 16) & 1u)) >> 16; }
__device__ __forceinline__ unsigned pk2(float lo, float hi) { return f2bf(lo) | (f2bf(hi) << 16); }

#define XB_TMO      128
#define XB_XCNT(j)  (256  + 64 * (j))
#define XB_XSUB(j)  (1280 + 64 * (j))
#define XB_XGEN(j)  (2304 + 64 * (j))
#define XB_TOP      3328
#define XB_TOPGEN   3392
#define XCD_BAR_WORDS 3456
#define XB_SPIN_CAP (1u << 18)

__device__ __forceinline__ unsigned xb_ld(unsigned* p)              { return __hip_atomic_load(p, __ATOMIC_RELAXED, __HIP_MEMORY_SCOPE_AGENT); }
__device__ __forceinline__ unsigned xb_add(unsigned* p, unsigned v) { return __hip_atomic_fetch_add(p, v, __ATOMIC_RELAXED, __HIP_MEMORY_SCOPE_AGENT); }
__device__ __forceinline__ unsigned xb_xcc_id() { return (unsigned)__builtin_amdgcn_s_getreg((3 << 11) | 20) & 0xFu; }
#define XB_SPIN(cond, bar) do { unsigned _sp = 0; while (cond) { __builtin_amdgcn_s_sleep(1); \
    if ((++_sp & 255u) == 0u) { if (xb_ld(&(bar)[XB_TMO])) break; if (_sp > XB_SPIN_CAP) { atomicAdd(&(bar)[XB_TMO], 1u); break; } } } } while (0)

struct XcdBarrier {
    unsigned* bar; unsigned x;
    volatile LAS unsigned* st;
};

__device__ __forceinline__ XcdBarrier xcd_barrier_post(unsigned* bar, volatile LAS unsigned* st) {
    XcdBarrier b; b.bar = bar; b.x = xb_xcc_id(); b.st = st;
    if (threadIdx.x == 0) (void)xb_add(&bar[XB_XCNT(b.x)], 1u);
    return b;
}
__device__ __forceinline__ void xcd_barrier_complete(unsigned* bar, unsigned x, unsigned& nloc, unsigned& nx) {
    const unsigned G = gridDim.x * gridDim.y * gridDim.z;
    unsigned sum, cnt, mine, sp = 0u;
    for (;;) {
        sum = 0u; cnt = 0u; mine = 0u;
#pragma unroll
        for (unsigned j = 0; j < 16; ++j) { const unsigned c = xb_ld(&bar[XB_XCNT(j)]); sum += c; cnt += (c > 0u) ? 1u : 0u; mine = (j == x) ? c : mine; }
        if (sum == G) break;
        __builtin_amdgcn_s_sleep(1);
        if ((++sp & 255u) == 0u) { if (xb_ld(&bar[XB_TMO])) break; if (sp > XB_SPIN_CAP) { atomicAdd(&bar[XB_TMO], 1u); break; } }
    }
    nloc = mine > 0u ? mine : 1u; nx = cnt > 0u ? cnt : 1u;
}

__device__ __forceinline__ void xcd_barrier(const XcdBarrier& b) {
    asm volatile("s_waitcnt vmcnt(0)" ::: "memory");
    __syncthreads();
    if (threadIdx.x == 0) {
        unsigned* bar = b.bar;
        __builtin_amdgcn_s_waitcnt(0);
        unsigned nloc = b.st[0], nx = b.st[1];
        if (nloc == 0u) { xcd_barrier_complete(bar, b.x, nloc, nx); b.st[0] = nloc; b.st[1] = nx; }
        const unsigned old = xb_add(&bar[XB_XSUB(b.x)], 1u);
        const unsigned gen = old / nloc;
        if (old + 1u == (gen + 1u) * nloc) {
            __builtin_amdgcn_fence(__ATOMIC_RELEASE, "agent");
            asm volatile("s_waitcnt vmcnt(0)" ::: "memory");
            const unsigned og = xb_add(&bar[XB_TOP], 1u);
            const unsigned tg = og / nx;
            if (og + 1u == (tg + 1u) * nx) xb_add(&bar[XB_TOPGEN], 1u);
            else XB_SPIN(xb_ld(&bar[XB_TOPGEN]) == tg, bar);
            __builtin_amdgcn_fence(__ATOMIC_ACQUIRE, "agent");
            xb_add(&bar[XB_XGEN(b.x)], 1u);
            asm volatile("s_waitcnt vmcnt(0)" ::: "memory");
        } else {
            XB_SPIN(xb_ld(&bar[XB_XGEN(b.x)]) == gen, bar);
            __builtin_amdgcn_fence(__ATOMIC_ACQUIRE, "agent");
            asm volatile("s_waitcnt vmcnt(0)" ::: "memory");
        }
    }
    __syncthreads();
}

constexpr int NWAVES = 8;
constexpr int BATCH = 8, SEQ = 4096, D = 1024, FF = 2816, NIN = 3072, NH = 4;
constexpr int M = BATCH * SEQ;
constexpr float EPS = 1e-6f;
constexpr float LAM_INIT = 0.2f;
constexpr float LOG2E = 1.4426950408889634f;

constexpr size_t MiB = 1u << 20;
constexpr size_t WS_CTL = 0, CTL_ZERO_BYTES = 1 * MiB;
constexpr size_t WS_SS = 1 * MiB;
constexpr size_t WS_WGU1 = 2 * MiB, WS_WD1 = 13 * MiB, WS_WIN = 19 * MiB, WS_WOUT = 25 * MiB, WS_WGU2 = 27 * MiB, WS_WD2 = 38 * MiB;
constexpr size_t WS_XB = 48 * MiB;
constexpr size_t WS_H = 112 * MiB;
constexpr size_t WS_Q = WS_H, WS_K = WS_H + 32 * MiB, WS_V = WS_H + 64 * MiB, WS_GB = WS_H + 96 * MiB, WS_U = WS_H + 128 * MiB;
constexpr size_t WS_MIX = 288 * MiB;
constexpr size_t WS_O = 352 * MiB;
constexpr size_t WS_END = 416 * MiB;
static_assert(WS_WD2 + (size_t)D * FF * 2 <= WS_XB && WS_U + (size_t)M * 512 * 2 <= WS_H + (size_t)M * FF * 2 && WS_H + (size_t)M * FF * 2 <= WS_MIX, "d_ws map");
constexpr int CW_TMO = 0, CW_CODE = 1, CW_BAR = 4096;

constexpr int RING_OFF = 0, RING_BYTES = 131072;
constexpr int LDSCTL_OFF = RING_BYTES, MISC_OFF = LDSCTL_OFF + 320;
constexpr int LDS_BYTES = 147456;
static_assert(MISC_OFF + 128 <= LDS_BYTES, "LDS map");

typedef unsigned u32x4 __attribute__((ext_vector_type(4)));
typedef float f32x16 __attribute__((ext_vector_type(16)));
typedef short s16x4 __attribute__((ext_vector_type(4)));

struct Frame {
    LAS unsigned char* lds;
    volatile LAS unsigned* MISC;
    gu32* ctl;
    int tid, lane, wave, vcu, G;
};

__device__ __forceinline__ float wave_sum(float v) {
#pragma unroll
    for (int o = 1; o < 64; o <<= 1) v += __shfl_xor(v, o);
    return v;
}

__device__ __forceinline__ void transpose_item(const float* W, int srcN, int s0, int k0, const float* gain, bf16* WT, int K, int n0, LAS float* scr, int lane) {
#pragma unroll 8
    for (int i = 0; i < 32; ++i) { const int kk = 2 * i + (lane >> 5); float v = W[(size_t)(k0 + kk) * srcN + s0 + (lane & 31)]; if (gain) v *= gain[k0 + kk]; scr[kk * 33 + (lane & 31)] = v; }
    LDS_WAIT(); asm volatile("" ::: "memory");
    const int c = lane & 7;
#pragma unroll
    for (int j = 0; j < 4; ++j) { const int n = (lane >> 3) + 8 * j; const LAS float* s = scr + (8 * c) * 33 + n;
        v4u o; o.x = pk2(s[0 * 33], s[1 * 33]); o.y = pk2(s[2 * 33], s[3 * 33]); o.z = pk2(s[4 * 33], s[5 * 33]); o.w = pk2(s[6 * 33], s[7 * 33]);
        *(GAS v4u*)(WT + (size_t)(n0 + n) * K + k0 + 8 * c) = o; }
    LDS_WAIT(); asm volatile("" ::: "memory");
}
struct Args { const float* in[22]; float* out; unsigned char* ws; int ph_lo, ph_hi; };

__device__ __forceinline__ void p0_prologue(Frame& F, const Args& A) {
    LAS float* scr = (LAS float*)(F.lds + RING_OFF + F.wave * 16384);
    const int gw = F.vcu * NWAVES + F.wave, NGW = F.G * NWAVES;
    unsigned char* ws = A.ws;
    constexpr int I_GU = (D / 64) * (2 * FF / 32), I_DN = (FF / 64) * (D / 32), I_IN = (D / 64) * (NIN / 32), I_OUT = (D / 64) * (D / 32);
    constexpr int NITEMS = 2 * I_GU + 2 * I_DN + I_IN + I_OUT;
    for (int it = gw; it < NITEMS; it += NGW) {
        int r = it;
        if (r < 2 * I_GU) {
            const int l = r >= I_GU; if (l) r -= I_GU;
            constexpr int nblk = 2 * FF / 32; const int kb = r / nblk, nb = r % nblk, n0 = 32 * nb;
            const int pn = n0 >> 8, half = (n0 >> 7) & 1, j = n0 & 127;
            const float* W = A.in[l ? (half ? 19 : 18) : (half ? 3 : 2)];
            transpose_item(W, FF, 128 * pn + j, 64 * kb, A.in[l ? 17 : 1], (bf16*)(ws + (l ? WS_WGU2 : WS_WGU1)), D, n0, scr, F.lane);
            continue;
        }
        r -= 2 * I_GU;
        if (r < 2 * I_DN) {
            const int l = r >= I_DN; if (l) r -= I_DN;
            constexpr int nblk = D / 32; const int kb = r / nblk, nb = r % nblk;
            transpose_item(A.in[l ? 20 : 4], D, 32 * nb, 64 * kb, nullptr, (bf16*)(ws + (l ? WS_WD2 : WS_WD1)), FF, 32 * nb, scr, F.lane);
            continue;
        }
        r -= 2 * I_DN;
        if (r < I_IN) {
            constexpr int nblk = NIN / 32; const int kb = r / nblk, nb = r % nblk, n0 = 32 * nb;
            const int pn = n0 >> 8, half = (n0 >> 7) & 1, j = n0 & 127;
            int s0;
            if (pn < 4) s0 = (pn >> 1) * 512 + 64 * (4 * (pn & 1) + (j >> 5)) + 32 * half;
            else if (pn < 8) s0 = n0;
            else s0 = (half ? 2560 : 2048) + 128 * (pn - 8) + j;
            transpose_item(A.in[6], NIN, s0, 64 * kb, A.in[5], (bf16*)(ws + WS_WIN), D, n0, scr, F.lane);
            continue;
        }
        r -= I_IN;
        { constexpr int nblk = D / 32; const int kb = r / nblk, nb = r % nblk;
          transpose_item(A.in[16], D, 32 * nb, 64 * kb, nullptr, (bf16*)(ws + WS_WOUT), D, 32 * nb, scr, F.lane); }
    }
    const float* x = A.in[0]; bf16* xb = (bf16*)(ws + WS_XB); float* ss = (float*)(ws + WS_SS);
    for (int m = gw; m < M; m += NGW) {
        const GAS f32x4* xr = (const GAS f32x4*)(x + (size_t)m * D) + F.lane;
        f32x4 v[4]; float s = 0.f;
#pragma unroll
        for (int j = 0; j < 4; ++j) { v[j] = xr[64 * j]; s += (v[j].x * v[j].x + v[j].y * v[j].y) + (v[j].z * v[j].z + v[j].w * v[j].w); }
        s = wave_sum(s);
        GAS unsigned long long* o8 = (GAS unsigned long long*)(xb + (size_t)m * D) + F.lane;
#pragma unroll
        for (int j = 0; j < 4; ++j) o8[64 * j] = (unsigned long long)pk2(v[j].x, v[j].y) | ((unsigned long long)pk2(v[j].z, v[j].w) << 32);
        if (F.lane == 0) { ss[m] = s; ss[M + m] = 0.f; ss[2 * M + m] = 0.f; }
    }
}

namespace att {
constexpr int L_K0 = 0, L_K1 = 8192, L_V = 16384, L_WS = 32768, L_Q = 36864, L_END = L_Q + 65536;
static_assert(L_END <= RING_BYTES, "attention LDS");
__device__ __forceinline__ int crow(int r, int hi) { return (r & 3) + 8 * (r >> 2) + 4 * hi; }
typedef __bf16 bf16x2_t __attribute__((ext_vector_type(2))); typedef float f32x2_t __attribute__((ext_vector_type(2)));
__device__ __forceinline__ unsigned cvtpk(float lo, float hi) { f32x2_t v = {lo, hi}; bf16x2_t b = __builtin_convertvector(v, bf16x2_t); return __builtin_bit_cast(unsigned, b); }
typedef short v4i16_t __attribute__((ext_vector_type(4)));
__device__ __forceinline__ s16x4 vtr(LAS const unsigned char* p) { return __builtin_bit_cast(s16x4, __builtin_amdgcn_ds_read_tr16_b64_v4i16((LAS v4i16_t*)p)); }

__device__ __forceinline__ void tile_step(f32x16 (&o)[4], float& mrun, float& lrun, LAS const unsigned char* Kt, LAS const unsigned char* Vt, LAS const unsigned char* Qf, LAS float* wsf,
                                          int kbase  , int irel, float sl2, int lane, int r32, int hi) {
    f32x16 p0, p1;
#pragma unroll
    for (int r = 0; r < 16; ++r) { p0[r] = 0.f; p1[r] = 0.f; }
    LAS const unsigned char* kb = Kt + hi * 1024 + r32 * 16;
#pragma unroll
    for (int d0 = 0; d0 < 4; ++d0) {
        const bf16x8 qf = *(LAS const bf16x8*)(Qf + d0 * 1024 + lane * 16);
        const bf16x8 b0 = *(LAS const bf16x8*)(kb + d0 * 2048), b1 = *(LAS const bf16x8*)(kb + d0 * 2048 + 512);
        p0 = __builtin_amdgcn_mfma_f32_32x32x16_bf16(b0, qf, p0, 0, 0, 0);
        p1 = __builtin_amdgcn_mfma_f32_32x32x16_bf16(b1, qf, p1, 0, 0, 0);
    }
    float rm = -INFINITY;
#pragma unroll
    for (int r = 0; r < 16; ++r) {
        const int kv = kbase + (r & 3) + 8 * (r >> 2);
        const float b = sl2 * (float)(kv - irel);
        p0[r] = (kv > irel) ? -INFINITY : p0[r] + b;
        p1[r] = (kv + 32 > irel) ? -INFINITY : p1[r] + (b + 32.0f * sl2);
        rm = fmaxf(rm, fmaxf(p0[r], p1[r]));
    }
    rm = fmaxf(rm, __shfl_xor(rm, 32));
    const float mnew = fmaxf(mrun, rm);
    const float alpha = __builtin_amdgcn_exp2f(mrun - mnew);
    float s = 0.f;
#pragma unroll
    for (int r = 0; r < 16; ++r) { p0[r] = __builtin_amdgcn_exp2f(p0[r] - mnew); p1[r] = __builtin_amdgcn_exp2f(p1[r] - mnew); s += p0[r] + p1[r]; }
    lrun = lrun * alpha + s; mrun = mnew;
    if (hi == 0) wsf[r32] = alpha;
    LDS_WAIT(); asm volatile("" ::: "memory");
#pragma unroll
    for (int r = 0; r < 16; ++r) { const float f = wsf[crow(r, hi)];
#pragma unroll
        for (int d = 0; d < 4; ++d) o[d][r] *= f; }
    u32x4 pw[4];
    pw[0] = (u32x4){cvtpk(p0[0], p0[1]), cvtpk(p0[2], p0[3]), cvtpk(p0[4], p0[5]), cvtpk(p0[6], p0[7])};
    pw[1] = (u32x4){cvtpk(p0[8], p0[9]), cvtpk(p0[10], p0[11]), cvtpk(p0[12], p0[13]), cvtpk(p0[14], p0[15])};
    pw[2] = (u32x4){cvtpk(p1[0], p1[1]), cvtpk(p1[2], p1[3]), cvtpk(p1[4], p1[5]), cvtpk(p1[6], p1[7])};
    pw[3] = (u32x4){cvtpk(p1[8], p1[9]), cvtpk(p1[10], p1[11]), cvtpk(p1[12], p1[13]), cvtpk(p1[14], p1[15])};
    LAS const unsigned char* vb = Vt + ((lane >> 4) & 1) * 32 + (lane & 3) * 8 + (4 * hi + ((lane & 15) >> 2)) * 64;
#pragma unroll
    for (int d0 = 0; d0 < 4; ++d0)
#pragma unroll
        for (int ks = 0; ks < 4; ++ks) {
            const s16x4 lo = vtr(vb + d0 * 4096 + ks * 1024), h8 = vtr(vb + d0 * 4096 + ks * 1024 + 512);
            const bf16x8 vf = (bf16x8){lo[0], lo[1], lo[2], lo[3], h8[0], h8[1], h8[2], h8[3]};
            o[d0] = __builtin_amdgcn_mfma_f32_32x32x16_bf16(__builtin_bit_cast(bf16x8, pw[ks]), vf, o[d0], 0, 0, 0);
        }
    LDS_WAIT(); asm volatile("" ::: "memory");
}

__device__ __forceinline__ void attn_unit(int b, int h, int mc, int qb, const bf16* Qg, const bf16* Kg, const bf16* Vg, bf16* OB, LAS unsigned char* shm) {
    const int tid = threadIdx.x, lane = tid & 63, r32 = lane & 31, hi = lane >> 5; const int wid = __builtin_amdgcn_readfirstlane(tid >> 6);
    const size_t rowbase = (size_t)b * SEQ; const int q0 = qb * 256;
    const float sl2 = LOG2E * __builtin_amdgcn_exp2f(-2.0f * (float)(h + 1));
    LAS float* wsf = (LAS float*)(shm + L_WS) + wid * 128;
    LAS unsigned char* Qf = shm + L_Q + wid * 8192;
    __syncthreads();
    {
        const bf16* qp = Qg + (rowbase + q0 + wid * 32 + r32) * 512 + h * 128 + mc * 64 + hi * 8;
#pragma unroll
        for (int d0 = 0; d0 < 4; ++d0) *(LAS u32x4*)(Qf + d0 * 1024 + lane * 16) = *(const GAS u32x4*)(qp + d0 * 16);
    }
    f32x16 o0[4];
#pragma unroll
    for (int d = 0; d < 4; ++d)
#pragma unroll
        for (int r = 0; r < 16; ++r) o0[d][r] = 0.f;
    float m0 = -INFINITY, l0 = 0.f;
    const int NT = (q0 + 256) / 64; const int irel = wid * 32 + r32;
    for (int t = 0; t < NT; ++t) {
        const int j0 = 64 * t;
        __syncthreads();
        {
            const int row = tid >> 3, ch = tid & 7;
            const u32x4 k0v = *(const GAS u32x4*)(Kg + (rowbase + j0 + row) * 512 + h * 128 + mc * 64 + ch * 8);
            u32x4 vv[2];
#pragma unroll
            for (int i = 0; i < 2; ++i) { const int idx = tid + 512 * i, vr = idx >> 4, c16 = idx & 15; vv[i] = *(const GAS u32x4*)(Vg + (rowbase + j0 + vr) * 512 + h * 128 + c16 * 8); }
            *(LAS u32x4*)(shm + L_K0 + ch * 1024 + row * 16) = k0v;
#pragma unroll
            for (int i = 0; i < 2; ++i) { const int idx = tid + 512 * i, vr = idx >> 4, c16 = idx & 15; *(LAS u32x4*)(shm + L_V + (c16 >> 2) * 4096 + vr * 64 + (c16 & 3) * 16) = vv[i]; }
        }
        __syncthreads();
        const int kbase = j0 - q0 + 4 * hi;
        tile_step(o0, m0, l0, shm + L_K0, shm + L_V, Qf, wsf, kbase, irel, sl2, lane, r32, hi);
    }
    l0 += __shfl_xor(l0, 32);
    if (hi == 0) wsf[r32] = 1.0f / l0;
    LDS_WAIT(); asm volatile("" ::: "memory");
    bf16* op = OB + (rowbase + q0 + wid * 32) * 1024 + h * 256 + mc * 128 + r32;
#pragma unroll
    for (int r = 0; r < 16; ++r) {
        const int cr = crow(r, hi); const float f0 = wsf[cr];
#pragma unroll
        for (int d = 0; d < 4; ++d) op[(size_t)cr * 1024 + 32 * d] = (bf16)f2bf(o0[d][r] * f0);
    }
    LDS_WAIT(); asm volatile("" ::: "memory");
}
}

__device__ __forceinline__ void conv_phase(Frame& F, const bf16* U, const bf16* GB, const float* cw, const float* cn, bf16* MIX) {
    const int gw = F.vcu * NWAVES + F.wave, NGW = F.G * NWAVES; const int ch0 = F.lane * 8;
    float w0[8], w1[8], w2[8], gn[8];
#pragma unroll
    for (int i = 0; i < 8; ++i) { w0[i] = cw[ch0 + i]; w1[i] = cw[512 + ch0 + i]; w2[i] = cw[1024 + ch0 + i]; gn[i] = cn[ch0 + i]; }
    for (int g = gw; g < M / 16; g += NGW) {
        const int t0 = 16 * g;
        float um2[8], um1[8];
        if ((t0 & (SEQ - 1)) == 0) {
#pragma unroll
            for (int i = 0; i < 8; ++i) { um2[i] = 0.f; um1[i] = 0.f; }
        } else {
            const v4u a = *(const GAS v4u*)(U + (size_t)(t0 - 2) * 512 + ch0), b = *(const GAS v4u*)(U + (size_t)(t0 - 1) * 512 + ch0);
#pragma unroll
            for (int i = 0; i < 4; ++i) { um2[2 * i] = __uint_as_float(a[i] << 16); um2[2 * i + 1] = __uint_as_float(a[i] & 0xffff0000u); um1[2 * i] = __uint_as_float(b[i] << 16); um1[2 * i + 1] = __uint_as_float(b[i] & 0xffff0000u); }
        }
        for (int t = t0; t < t0 + 16; ++t) {
            const v4u a = *(const GAS v4u*)(U + (size_t)t * 512 + ch0), b = *(const GAS v4u*)(GB + (size_t)t * 512 + ch0);
            float ut[8], gb[8], c[8]; float s = 0.f;
#pragma unroll
            for (int i = 0; i < 4; ++i) { ut[2 * i] = __uint_as_float(a[i] << 16); ut[2 * i + 1] = __uint_as_float(a[i] & 0xffff0000u); gb[2 * i] = __uint_as_float(b[i] << 16); gb[2 * i + 1] = __uint_as_float(b[i] & 0xffff0000u); }
#pragma unroll
            for (int i = 0; i < 8; ++i) { c[i] = gb[i] * (w0[i] * um2[i] + w1[i] * um1[i] + w2[i] * ut[i]); s += c[i] * c[i]; um2[i] = um1[i]; um1[i] = ut[i]; }
            s += __shfl_xor(s, 1); s += __shfl_xor(s, 2); s += __shfl_xor(s, 4);
            const float rn = __builtin_amdgcn_rsqf(s * (1.0f / 64.0f) + EPS);
            v4u o;
#pragma unroll
            for (int i = 0; i < 4; ++i) o[i] = pk2(c[2 * i] * rn * gn[2 * i], c[2 * i + 1] * rn * gn[2 * i + 1]);
            *(GAS v4u*)(MIX + (size_t)t * 1024 + 512 + ch0) = o;
        }
    }
}

__device__ __forceinline__ void combine_phase(Frame& F, const bf16* OB, const float* subln, float lam, bf16* MIX) {
    const int gw = F.vcu * NWAVES + F.wave, NGW = F.G * NWAVES; const int hh = F.lane >> 4, d0 = 8 * (F.lane & 15);
    float gn[8];
#pragma unroll
    for (int i = 0; i < 8; ++i) gn[i] = subln[d0 + i] * (1.0f - LAM_INIT);
    for (int t = gw; t < M; t += NGW) {
        const v4u a = *(const GAS v4u*)(OB + (size_t)t * 1024 + hh * 256 + d0), b = *(const GAS v4u*)(OB + (size_t)t * 1024 + hh * 256 + 128 + d0);
        float c[8]; float s = 0.f;
#pragma unroll
        for (int i = 0; i < 4; ++i) { c[2 * i] = __uint_as_float(a[i] << 16) - lam * __uint_as_float(b[i] << 16); c[2 * i + 1] = __uint_as_float(a[i] & 0xffff0000u) - lam * __uint_as_float(b[i] & 0xffff0000u); }
#pragma unroll
        for (int i = 0; i < 8; ++i) s += c[i] * c[i];
        s += __shfl_xor(s, 1); s += __shfl_xor(s, 2); s += __shfl_xor(s, 4); s += __shfl_xor(s, 8);
        const float rn = __builtin_amdgcn_rsqf(s * (1.0f / 128.0f) + EPS);
        v4u o;
#pragma unroll
        for (int i = 0; i < 4; ++i) o[i] = pk2(c[2 * i] * rn * gn[2 * i], c[2 * i + 1] * rn * gn[2 * i + 1]);
        *(GAS v4u*)(MIX + (size_t)t * 1024 + hh * 128 + d0) = o;
    }
}

__device__ __forceinline__ void final_norm_phase(Frame& F, float* out, const float* gain) {
    const int gw = F.vcu * NWAVES + F.wave, NGW = F.G * NWAVES;
    f32x4 gv[4];
#pragma unroll
    for (int j = 0; j < 4; ++j) gv[j] = *((const GAS f32x4*)gain + F.lane + 64 * j);
    for (int m = gw; m < M; m += NGW) {
        GAS f32x4* xr = (GAS f32x4*)(out + (size_t)m * D) + F.lane;
        f32x4 v[4]; float s = 0.f;
#pragma unroll
        for (int j = 0; j < 4; ++j) { v[j] = xr[64 * j]; s += (v[j].x * v[j].x + v[j].y * v[j].y) + (v[j].z * v[j].z + v[j].w * v[j].w); }
        s = wave_sum(s);
        const float r = __builtin_amdgcn_rsqf(s * (1.0f / D) + EPS);
#pragma unroll
        for (int j = 0; j < 4; ++j) xr[64 * j] = v[j] * r * gv[j];
    }
}

constexpr int N_PHASES = 10;
__global__ void __launch_bounds__(NWAVES * 64, 2) fwd_kernel(Args args) {
    extern __shared__ __attribute__((aligned(16))) unsigned char lds[];
    Frame F;
    F.lds = (LAS unsigned char*)lds;
    F.MISC = (volatile LAS unsigned*)(F.lds + MISC_OFF);
    F.tid = threadIdx.x; F.lane = F.tid & 63; F.wave = __builtin_amdgcn_readfirstlane(F.tid >> 6);
    F.G = gridDim.x; { const int bx = blockIdx.x; F.vcu = (F.G % 8 == 0) ? (bx % 8) * (F.G / 8) + bx / 8 : bx; }
    unsigned char* ws = args.ws;
    F.ctl = (gu32*)(ws + WS_CTL);
    for (int u = F.tid; u < (LDS_BYTES - LDSCTL_OFF) / 4; u += NWAVES * 64) ((LAS unsigned*)(F.lds + LDSCTL_OFF))[u] = 0u;
    __syncthreads();
    const int lo = args.ph_lo, hi = args.ph_hi;
    const bool one_launch = (hi - lo) > 1;
    XcdBarrier bar; bar.bar = (unsigned*)(F.ctl + CW_BAR); bar.x = 0; bar.st = nullptr;
    if (one_launch) bar = xcd_barrier_post((unsigned*)(F.ctl + CW_BAR), F.MISC + 8);
#ifndef PHASE_MASK
#define PHASE_MASK 0x3ff
#endif
#define IN(k) (((PHASE_MASK >> (k)) & 1) && lo <= (k) && (k) < hi)
#define SEAM(k) do { if (IN(k) && IN((k) + 1)) xcd_barrier(bar); } while (0)

    float* ss = (float*)(ws + WS_SS);
    bf16* XB = (bf16*)(ws + WS_XB); bf16* HB = (bf16*)(ws + WS_H); bf16* MIX = (bf16*)(ws + WS_MIX);
    bf16 *QB_ = (bf16*)(ws + WS_Q), *KB_ = (bf16*)(ws + WS_K), *VB_ = (bf16*)(ws + WS_V), *GBB = (bf16*)(ws + WS_GB), *UB = (bf16*)(ws + WS_U), *OBB = (bf16*)(ws + WS_O);

    if (IN(0)) { p0_prologue(F, args); } SEAM(0);
    if (IN(1)) {
        pg8::Gemm g{XB, (const bf16*)(ws + WS_WGU1), M, 2 * FF, D}; pg8::StaticOrder S; S.init(M, 2 * FF, F.G, (int)blockIdx.x);
        pg8::EpiSwiGLU E{HB, FF, ss, 1.0f / D};
        pg8::gemm_phase<pg8::EpiSwiGLU, pg8::StaticOrder, PG8_ALIGN, PG8_SP2>(F.lds + RING_OFF, g, S, E);
    } SEAM(1);
    if (IN(2)) {
        pg8::Gemm g{HB, (const bf16*)(ws + WS_WD1), M, D, FF}; pg8::StaticOrder S; S.init(M, D, F.G, (int)blockIdx.x);
        pg8::EpiRes E{args.in[0], args.out, XB, ss + M, 0.5f};
        pg8::gemm_phase<pg8::EpiRes, pg8::StaticOrder, PG8_ALIGN, PG8_SP2>(F.lds + RING_OFF, g, S, E);
    } SEAM(2);
    if (IN(3)) {
        pg8::Gemm g{XB, (const bf16*)(ws + WS_WIN), M, NIN, D}; pg8::StaticOrder S; S.init(M, NIN, F.G, (int)blockIdx.x);
        pg8::EpiIn E{QB_, KB_, VB_, GBB, UB, ss + M, args.in[7], args.in[8], 0.125f * LOG2E};
        pg8::gemm_phase<pg8::EpiIn, pg8::StaticOrder, PG8_ALIGN, PG8_SP2>(F.lds + RING_OFF, g, S, E);
    } SEAM(3);
    if (IN(4)) {
        conv_phase(F, UB, GBB, args.in[14], args.in[15], MIX);
        const int nun = BATCH * NH * 32;
        for (int i = 0; ; ++i) {
            const int L = i * F.G + F.vcu; if (L >= nun) break;
            const int round = L / 256, w = L % 256, bh = w >> 3, s = w & 7; const int qb = (round & 1) ? 15 - s : s, mc = round >> 1;
            att::attn_unit(bh >> 2, bh & 3, mc, qb, QB_, KB_, VB_, OBB, F.lds + RING_OFF);
        }
    } SEAM(4);
    if (IN(5)) {
        float lam;
        { const float a = args.in[9][F.lane] * args.in[10][F.lane], b2 = args.in[11][F.lane] * args.in[12][F.lane];
          lam = expf(wave_sum(a)) - expf(wave_sum(b2)) + LAM_INIT; }
        combine_phase(F, OBB, args.in[13], lam, MIX);
    } SEAM(5);
    if (IN(6)) {
        pg8::Gemm g{MIX, (const bf16*)(ws + WS_WOUT), M, D, D}; pg8::StaticOrder S; S.init(M, D, F.G, (int)blockIdx.x);
        pg8::EpiRes E{args.out, args.out, XB, ss + 2 * M, 1.0f};
        pg8::gemm_phase<pg8::EpiRes, pg8::StaticOrder, PG8_ALIGN, PG8_SP2>(F.lds + RING_OFF, g, S, E);
    } SEAM(6);
    if (IN(7)) {
        pg8::Gemm g{XB, (const bf16*)(ws + WS_WGU2), M, 2 * FF, D}; pg8::StaticOrder S; S.init(M, 2 * FF, F.G, (int)blockIdx.x);
        pg8::EpiSwiGLU E{HB, FF, ss + 2 * M, 1.0f / D};
        pg8::gemm_phase<pg8::EpiSwiGLU, pg8::StaticOrder, PG8_ALIGN, PG8_SP2>(F.lds + RING_OFF, g, S, E);
    } SEAM(7);
    if (IN(8)) {
        pg8::Gemm g{HB, (const bf16*)(ws + WS_WD2), M, D, FF}; pg8::StaticOrder S; S.init(M, D, F.G, (int)blockIdx.x);
        pg8::EpiRes E{args.out, args.out, nullptr, nullptr, 0.5f};
        pg8::gemm_phase<pg8::EpiRes, pg8::StaticOrder, PG8_ALIGN, PG8_SP2>(F.lds + RING_OFF, g, S, E);
    } SEAM(8);
    if (IN(9)) final_norm_phase(F, args.out, args.in[21]);
#undef IN
#undef SEAM
}

#ifndef MK_N_LAUNCHES
#define MK_N_LAUNCHES 1
#endif
extern "C" void kernel_launch(void* const* d_in, const int* in_sizes, int n_in, void* d_out, int out_size, void* d_ws, size_t ws_size, hipStream_t stream) {
    static int grid = 0;
    if (grid == 0) {
        if (n_in != 22 || in_sizes[0] != M * D || out_size != M * D || ws_size < WS_END) { fprintf(stderr, "kernel_launch: unexpected shapes (n_in %d, in0 %d, out %d, ws %zu); nothing launched\n", n_in, n_in > 0 ? in_sizes[0] : -1, out_size, ws_size); grid = -1; return; }
        int dev = 0, cus = 0;
        if (hipGetDevice(&dev) != hipSuccess || hipDeviceGetAttribute(&cus, hipDeviceAttributeMultiprocessorCount, dev) != hipSuccess) { grid = -1; return; }
        if (hipFuncSetAttribute((const void*)fwd_kernel, hipFuncAttributeMaxDynamicSharedMemorySize, LDS_BYTES) != hipSuccess) { fprintf(stderr, "kernel_launch: hipFuncSetAttribute failed\n"); grid = -1; return; }
        (void)hipGetLastError();
        grid = cus;
    }
    if (grid < 0) return;
    if (hipMemsetAsync((char*)d_ws + WS_CTL, 0, CTL_ZERO_BYTES, stream) != hipSuccess) return;
    Args a{};
    for (int i = 0; i < 22; ++i) a.in[i] = (const float*)d_in[i];
    a.out = (float*)d_out; a.ws = (unsigned char*)d_ws;
    if (MK_N_LAUNCHES == 1) { a.ph_lo = 0; a.ph_hi = N_PHASES; hipLaunchKernelGGL(fwd_kernel, dim3(grid), dim3(NWAVES * 64), LDS_BYTES, stream, a); }
    else for (int p = 0; p < N_PHASES; ++p) { a.ph_lo = p; a.ph_hi = p + 1; hipLaunchKernelGGL(fwd_kernel, dim3(grid), dim3(NWAVES * 64), LDS_BYTES, stream, a); }
}
```

```cpp
#include <hip/hip_runtime.h>
#include <cstdio>
#include <cstdint>
namespace pg8 {
#define PG8_LAS __attribute__((address_space(3)))
typedef unsigned short bf16_t;
typedef short bf16x8 __attribute__((ext_vector_type(8)));
typedef float f32x4 __attribute__((ext_vector_type(4)));
typedef unsigned u32x4 __attribute__((ext_vector_type(4)));
constexpr int BM = 256, BK = 64, HALF = 128, HTB = HALF * BK * 2  , STAGE_BYTES = 8 * HTB, NXCD = 8, WGM = 8;

__host__ __device__ __forceinline__ int lds_byte(int r, int c) { const int st = (r >> 4) * 2 + (c >> 5), rr = r & 15, cc = c & 31, ob = rr * 64 + cc * 2; return st * 1024 + (ob ^ (((ob >> 9) & 1) << 5)); }
__host__ __device__ __forceinline__ void stage_rc(int b, int& R, int& C) { const int st = b / 1024, sb = b % 1024, swz = sb ^ (((sb >> 9) & 1) << 5); R = (st >> 1) * 16 + swz / 64; C = (st & 1) * 32 + (swz % 64) / 2; }
__host__ __device__ __forceinline__ int perm32(int rho) { const int n = rho >> 4, i = rho & 15; return 8 * (i >> 2) + 4 * n + (i & 3); }

struct Unit { int pm, pn; };
struct Gemm { const bf16_t* A; const bf16_t* Bt; int M, N, K; };

struct StaticOrder {
    int nM, nN, nwg, G, c;
    __host__ __device__ void init(int M, int N, int G_, int c_) { nM = M / BM; nN = N / BM; nwg = nM * nN; G = G_; c = c_; }
    __host__ __device__ bool next(int i, Unit& u) const {
        const long L = (long)i * G + c; if (L >= nwg) return false;
        int wgid = (int)L; { const int q = nwg / NXCD, r = nwg % NXCD, xcd = wgid % NXCD, off = wgid / NXCD; wgid = (xcd < r ? xcd * (q + 1) : r * (q + 1) + (xcd - r) * q) + off; }
        const int nig = WGM * nN, gid = wgid / nig, fm = gid * WGM, gsz = (nM - fm) < WGM ? (nM - fm) : WGM;
        u.pm = fm + ((wgid % nig) % gsz); u.pn = (wgid % nig) / gsz; return true;
    }
    __device__ __forceinline__ void a_ready(const Unit&) const {}
    __device__ __forceinline__ void done(const Unit&) const {}
};

__device__ __forceinline__ unsigned cvt_pk_bf16(float lo, float hi) { unsigned r; asm volatile("v_cvt_pk_bf16_f32 %0, %1, %2" : "=v"(r) : "v"(lo), "v"(hi)); return r; }
typedef float f32x2 __attribute__((ext_vector_type(2)));
typedef unsigned u32x2 __attribute__((ext_vector_type(2)));
constexpr float NORM_EPS = 1e-6f;
__device__ __forceinline__ float silu_mul(float g, float u) {
    const float e = __builtin_amdgcn_exp2f(g * -1.4426950408889634f);
    return g * u * __builtin_amdgcn_rcpf(1.0f + e);
}
struct EpiSwiGLU {
    static constexpr bool PERM = true, AFTER_DRAIN = false;
    bf16_t* Hout; int ldh; const float* ss; float inv_k;
    __device__ __forceinline__ void operator()(const f32x4 (&acc)[2][2][4][2], const Unit& u, int wr, int wc, int fr, int fq) const {
        const int row0 = u.pm * BM + wr * 64 + fr, col0 = u.pn * HALF + wc * 32 + 8 * fq;
#pragma unroll
        for (int ai = 0; ai < 2; ++ai)
#pragma unroll
            for (int m = 0; m < 4; ++m) {
                const int row = row0 + ai * HALF + m * 16;
                const float rs = __builtin_amdgcn_rsqf(ss[row] * inv_k + NORM_EPS);
                const f32x4 g0 = acc[ai][0][m][0] * rs, g1 = acc[ai][0][m][1] * rs, u0 = acc[ai][1][m][0] * rs, u1 = acc[ai][1][m][1] * rs;
                u32x4 w;
                w.x = cvt_pk_bf16(silu_mul(g0[0], u0[0]), silu_mul(g0[1], u0[1]));
                w.y = cvt_pk_bf16(silu_mul(g0[2], u0[2]), silu_mul(g0[3], u0[3]));
                w.z = cvt_pk_bf16(silu_mul(g1[0], u1[0]), silu_mul(g1[1], u1[1]));
                w.w = cvt_pk_bf16(silu_mul(g1[2], u1[2]), silu_mul(g1[3], u1[3]));
                *(u32x4*)(Hout + (size_t)row * ldh + col0) = w;
            }
    }
};
struct EpiRes {
    static constexpr bool PERM = false, AFTER_DRAIN = false;
    const float* res; float* out; bf16_t* outb; float* ssacc; float scale;
    __device__ __forceinline__ void operator()(const f32x4 (&acc)[2][2][4][2], const Unit& u, int wr, int wc, int fr, int fq) const {
        const int row0 = u.pm * BM + wr * 64 + fr, col0 = u.pn * BM + wc * 32 + 4 * fq;
#pragma unroll
        for (int ai = 0; ai < 2; ++ai) {
            float srow[4];
#pragma unroll
            for (int m = 0; m < 4; ++m) {
                const size_t off = (size_t)(row0 + ai * HALF + m * 16) * 1024 + col0;
                float s = 0.f;
#pragma unroll
                for (int bj = 0; bj < 2; ++bj)
#pragma unroll
                    for (int n = 0; n < 2; ++n) {
                        const f32x4 r4 = *(const f32x4*)(res + off + bj * HALF + n * 16);
                        const f32x4 o = r4 + acc[ai][bj][m][n] * scale;
                        *(f32x4*)(out + off + bj * HALF + n * 16) = o;
                        if (outb) { u32x2 w; w.x = cvt_pk_bf16(o[0], o[1]); w.y = cvt_pk_bf16(o[2], o[3]); *(u32x2*)(outb + off + bj * HALF + n * 16) = w; }
                        s += (o[0] * o[0] + o[1] * o[1]) + (o[2] * o[2] + o[3] * o[3]);
                    }
                s += __shfl_xor(s, 16); s += __shfl_xor(s, 32);
                srow[m] = s;
                asm volatile("" ::: "memory");
            }
            if (ssacc) {
                const float v = fq == 0 ? srow[0] : fq == 1 ? srow[1] : fq == 2 ? srow[2] : srow[3];
                atomicAdd(ssacc + u.pm * BM + ai * HALF + wr * 64 + fq * 16 + fr, v);
            }
        }
    }
};
struct EpiIn {
    static constexpr bool PERM = true, AFTER_DRAIN = false;
    bf16_t *Q, *K, *V, *GB, *U;
    const float* ss; const float* qg; const float* kg; float qscale;
    __device__ __forceinline__ void operator()(const f32x4 (&acc)[2][2][4][2], const Unit& u, int wr, int wc, int fr, int fq) const {
        const int row0 = u.pm * BM + wr * 64 + fr; const int pn = u.pn;
        if (pn < 4) {
            bf16_t* dst = (pn < 2 ? Q : K) + (size_t)(64 * (4 * (pn & 1) + wc)) + 8 * fq;
            const float* gp = (pn < 2 ? qg : kg) + 8 * fq; const float sc = pn < 2 ? qscale : 1.0f;
            f32x4 gv[2][2];
#pragma unroll
            for (int bj = 0; bj < 2; ++bj)
#pragma unroll
                for (int n = 0; n < 2; ++n) gv[bj][n] = *(const f32x4*)(gp + 32 * bj + 4 * n) * sc;
#pragma unroll
            for (int ai = 0; ai < 2; ++ai)
#pragma unroll
                for (int m = 0; m < 4; ++m) {
                    const int row = row0 + ai * HALF + m * 16;
                    const float rs = __builtin_amdgcn_rsqf(ss[row] * (1.0f / 1024.0f) + NORM_EPS);
                    f32x4 t[2][2]; float s = 0.f;
#pragma unroll
                    for (int bj = 0; bj < 2; ++bj)
#pragma unroll
                        for (int n = 0; n < 2; ++n) { t[bj][n] = acc[ai][bj][m][n] * rs; const f32x4 x = t[bj][n]; s += (x[0] * x[0] + x[1] * x[1]) + (x[2] * x[2] + x[3] * x[3]); }
                    s += __shfl_xor(s, 16); s += __shfl_xor(s, 32);
                    const float rn = __builtin_amdgcn_rsqf(s * (1.0f / 64.0f) + NORM_EPS);
#pragma unroll
                    for (int bj = 0; bj < 2; ++bj) {
                        const f32x4 a = t[bj][0] * rn * gv[bj][0], b = t[bj][1] * rn * gv[bj][1];
                        u32x4 w; w.x = cvt_pk_bf16(a[0], a[1]); w.y = cvt_pk_bf16(a[2], a[3]); w.z = cvt_pk_bf16(b[0], b[1]); w.w = cvt_pk_bf16(b[2], b[3]);
                        *(u32x4*)(dst + (size_t)row * 512 + 32 * bj) = w;
                    }
                }
        } else if (pn < 8) {
            bf16_t* dst = (pn < 6 ? V : GB) + (size_t)(256 * (pn & 1) + wc * 32 + 8 * fq);
#pragma unroll
            for (int ai = 0; ai < 2; ++ai)
#pragma unroll
                for (int m = 0; m < 4; ++m) {
                    const int row = row0 + ai * HALF + m * 16;
                    const float rs = __builtin_amdgcn_rsqf(ss[row] * (1.0f / 1024.0f) + NORM_EPS);
#pragma unroll
                    for (int bj = 0; bj < 2; ++bj) {
                        const f32x4 a = acc[ai][bj][m][0] * rs, b = acc[ai][bj][m][1] * rs;
                        u32x4 w; w.x = cvt_pk_bf16(a[0], a[1]); w.y = cvt_pk_bf16(a[2], a[3]); w.z = cvt_pk_bf16(b[0], b[1]); w.w = cvt_pk_bf16(b[2], b[3]);
                        *(u32x4*)(dst + (size_t)row * 512 + HALF * bj) = w;
                    }
                }
        } else {
            bf16_t* dst = U + (size_t)(128 * (pn - 8) + wc * 32 + 8 * fq);
#pragma unroll
            for (int ai = 0; ai < 2; ++ai)
#pragma unroll
                for (int m = 0; m < 4; ++m) {
                    const int row = row0 + ai * HALF + m * 16;
                    const float rs = __builtin_amdgcn_rsqf(ss[row] * (1.0f / 1024.0f) + NORM_EPS); const float rs2 = rs * rs;
                    const f32x4 a = acc[ai][0][m][0] * acc[ai][1][m][0] * rs2, b = acc[ai][0][m][1] * acc[ai][1][m][1] * rs2;
                    u32x4 w; w.x = cvt_pk_bf16(a[0], a[1]); w.y = cvt_pk_bf16(a[2], a[3]); w.z = cvt_pk_bf16(b[0], b[1]); w.w = cvt_pk_bf16(b[2], b[3]);
                    *(u32x4*)(dst + (size_t)row * 512) = w;
                }
        }
    }
};

template <class Epi, class Sched, bool ALIGN_EPI = false, bool SP2 = false>
__device__ __forceinline__ void gemm_phase(PG8_LAS unsigned char* lds, const Gemm g, const Sched& S, const Epi& E) {
    const int tid = threadIdx.x, wid = __builtin_amdgcn_readfirstlane(tid >> 6), lane = tid & 63, wr = wid >> 2, wc = wid & 3, fr = lane & 15, fq = lane >> 4;
    const int K = g.K, nt = K / BK;
    unsigned voffA[2], voffB[2];
#pragma unroll
    for (int i = 0; i < 2; ++i) { int R, C; stage_rc(tid * 16 + i * 8192, R, C); const int Rb = Epi::PERM ? ((R & ~31) + perm32(R & 31)) : R;
        voffA[i] = (unsigned)(R * K + C) * 2u; voffB[i] = (unsigned)(Rb * K + C) * 2u; }
    const size_t kstep = (size_t)(BK * 2);
    const size_t hstep = (size_t)HALF * K * 2;
    const size_t tstep = 2 * hstep;
    const unsigned ldsw = (unsigned)wid * 1024u;
    const int aoff = lds_byte(wr * 64 + fr, fq * 8), boff = lds_byte(wc * 32 + fr, fq * 8);
#define PG8_SA(b, h) (((b) * 2 + (h)) * HTB)
#define PG8_SB(b, h) ((4 + (b) * 2 + (h)) * HTB)
#define PG8_STAGE(bufoff, gbase, voff) do { _Pragma("unroll") for (int _i = 0; _i < 2; ++_i) \
        __builtin_amdgcn_global_load_lds((const unsigned*)((const char*)(gbase) + (voff)[_i]), (PG8_LAS unsigned*)(lds + (bufoff) + ldsw + _i * 8192), 16, 0, 0); } while (0)
#define PG8_LDA(dst, b, h) do { _Pragma("unroll") for (int m = 0; m < 4; ++m) _Pragma("unroll") for (int k = 0; k < 2; ++k) dst[m][k] = *(const PG8_LAS bf16x8*)(lds + PG8_SA(b, h) + aoff + m * 2048 + k * 1024); } while (0)
#define PG8_LDB(dst, b, h) do { _Pragma("unroll") for (int n = 0; n < 2; ++n) _Pragma("unroll") for (int k = 0; k < 2; ++k) dst[n][k] = *(const PG8_LAS bf16x8*)(lds + PG8_SB(b, h) + boff + n * 2048 + k * 1024); } while (0)
#define PG8_MMA(ai, bj, At, Bt) do { __builtin_amdgcn_s_setprio(1); _Pragma("unroll") for (int m = 0; m < 4; ++m) _Pragma("unroll") for (int n = 0; n < 2; ++n) _Pragma("unroll") for (int k = 0; k < 2; ++k) \
        acc[ai][bj][m][n] = __builtin_amdgcn_mfma_f32_16x16x32_bf16(Bt[n][k], At[m][k], acc[ai][bj][m][n], 0, 0, 0); __builtin_amdgcn_s_setprio(0); } while (0)
#define PG8_WAIT_V(n) asm volatile("s_waitcnt vmcnt(" #n ")" ::: "memory")
#define PG8_WAIT_L(n) asm volatile("s_waitcnt lgkmcnt(" #n ")" ::: "memory")
#define PG8_BAR __builtin_amdgcn_s_barrier()
#define PG8_SCHED __builtin_amdgcn_sched_barrier(0)
    Unit cur, nxt; int ui = 0;
    if (!S.next(0, cur)) return;
    f32x4 acc[2][2][4][2];
#pragma unroll
    for (int a = 0; a < 2; ++a)
#pragma unroll
        for (int b = 0; b < 2; ++b)
#pragma unroll
            for (int m = 0; m < 4; ++m)
#pragma unroll
                for (int n = 0; n < 2; ++n) acc[a][b][m][n] = (f32x4){0.f, 0.f, 0.f, 0.f};
    bf16x8 At[4][2], B0[2][2], B1[2][2];
    const char* cA = (const char*)g.A + (size_t)cur.pm * tstep; const char* cB = (const char*)g.Bt + (size_t)cur.pn * tstep;
    S.a_ready(cur);
    if constexpr (SP2) {
        PG8_STAGE(PG8_SB(0, 0), cB, voffB); PG8_STAGE(PG8_SB(0, 1), cB + hstep, voffB); PG8_STAGE(PG8_SA(0, 0), cA, voffA); PG8_STAGE(PG8_SA(0, 1), cA + hstep, voffA);
        if (wr == 1) PG8_BAR;
        PG8_WAIT_V(2); PG8_BAR;
        PG8_STAGE(PG8_SB(1, 0), cB + kstep, voffB); PG8_STAGE(PG8_SA(1, 0), cA + kstep, voffA); PG8_STAGE(PG8_SB(1, 1), cB + hstep + kstep, voffB);
        PG8_WAIT_V(6); PG8_BAR;
    } else {
        PG8_STAGE(PG8_SB(0, 0), cB, voffB); PG8_STAGE(PG8_SA(0, 0), cA, voffA); PG8_STAGE(PG8_SB(0, 1), cB + hstep, voffB); PG8_STAGE(PG8_SA(0, 1), cA + hstep, voffA);
        if (wr == 1) PG8_BAR;
        PG8_WAIT_V(4); PG8_BAR;
        PG8_STAGE(PG8_SB(1, 0), cB + kstep, voffB); PG8_STAGE(PG8_SA(1, 0), cA + kstep, voffA); PG8_STAGE(PG8_SB(1, 1), cB + hstep + kstep, voffB);
        PG8_WAIT_V(6); PG8_BAR;
    }
    for (;;) {
        const bool has_next = S.next(ui + 1, nxt);
        const char* nA = has_next ? (const char*)g.A + (size_t)nxt.pm * tstep : cA; const char* nB = has_next ? (const char*)g.Bt + (size_t)nxt.pn * tstep : cB;
        for (int t = 0; t < nt; t += 2) {
            const bool last = (t == nt - 2);
            const char* a1 = cA + (size_t)(t + 1) * kstep;
            const char* a2 = last ? nA : cA + (size_t)(t + 2) * kstep; const char* b2 = last ? nB : cB + (size_t)(t + 2) * kstep;
            const char* a3 = a2 + kstep; const char* b3 = b2 + kstep;
            if (last && has_next) S.a_ready(nxt);
            if constexpr (SP2) {
            PG8_LDB(B0, 0, 0); PG8_LDB(B1, 0, 1); PG8_SCHED; PG8_LDA(At, 0, 0); PG8_STAGE(PG8_SA(1, 1), a1 + hstep, voffA);
            PG8_WAIT_V(8); PG8_WAIT_L(0); PG8_BAR; PG8_MMA(0, 0, At, B0); PG8_MMA(0, 1, At, B1); PG8_BAR; PG8_SCHED;
            PG8_LDA(At, 0, 1); PG8_STAGE(PG8_SB(0, 0), b2, voffB); PG8_STAGE(PG8_SB(0, 1), b2 + hstep, voffB); PG8_STAGE(PG8_SA(0, 0), a2, voffA);
            PG8_WAIT_V(8); PG8_WAIT_L(0); PG8_BAR; PG8_MMA(1, 0, At, B0); PG8_MMA(1, 1, At, B1); PG8_BAR; PG8_SCHED;
            PG8_LDB(B0, 1, 0); PG8_LDB(B1, 1, 1); PG8_SCHED; PG8_LDA(At, 1, 0); PG8_STAGE(PG8_SA(0, 1), a2 + hstep, voffA);
            PG8_WAIT_V(8); PG8_WAIT_L(0); PG8_BAR; PG8_MMA(0, 0, At, B0); PG8_MMA(0, 1, At, B1); PG8_BAR; PG8_SCHED;
            PG8_LDA(At, 1, 1); PG8_STAGE(PG8_SB(1, 0), b3, voffB); PG8_STAGE(PG8_SB(1, 1), b3 + hstep, voffB); PG8_STAGE(PG8_SA(1, 0), a3, voffA);
            PG8_WAIT_V(8); PG8_WAIT_L(0); PG8_BAR; PG8_MMA(1, 0, At, B0); PG8_MMA(1, 1, At, B1); PG8_BAR; PG8_SCHED;
            } else {
            PG8_LDB(B0, 0, 0); PG8_SCHED; PG8_LDA(At, 0, 0); PG8_STAGE(PG8_SA(1, 1), a1 + hstep, voffA);
            PG8_WAIT_L(8); PG8_BAR; PG8_WAIT_L(0); PG8_MMA(0, 0, At, B0); PG8_BAR; PG8_SCHED;
            PG8_LDB(B1, 0, 1); PG8_STAGE(PG8_SB(0, 0), b2, voffB);
            PG8_BAR; PG8_WAIT_L(0); PG8_MMA(0, 1, At, B1); PG8_BAR;
            PG8_LDA(At, 0, 1); PG8_STAGE(PG8_SA(0, 0), a2, voffA);
            PG8_BAR; PG8_WAIT_L(0); PG8_MMA(1, 0, At, B0); PG8_BAR; PG8_SCHED;
            PG8_STAGE(PG8_SB(0, 1), b2 + hstep, voffB);
            PG8_WAIT_V(6); PG8_BAR; PG8_MMA(1, 1, At, B1); PG8_BAR;
            PG8_LDB(B0, 1, 0); PG8_SCHED; PG8_LDA(At, 1, 0); PG8_STAGE(PG8_SA(0, 1), a2 + hstep, voffA);
            PG8_WAIT_L(8); PG8_BAR; PG8_WAIT_L(0); PG8_MMA(0, 0, At, B0); PG8_BAR; PG8_SCHED;
            PG8_LDB(B1, 1, 1); PG8_STAGE(PG8_SB(1, 0), b3, voffB);
            PG8_BAR; PG8_WAIT_L(0); PG8_MMA(0, 1, At, B1); PG8_BAR;
            PG8_LDA(At, 1, 1); PG8_STAGE(PG8_SA(1, 0), a3, voffA);
            PG8_BAR; PG8_WAIT_L(0); PG8_MMA(1, 0, At, B0); PG8_BAR; PG8_SCHED;
            PG8_STAGE(PG8_SB(1, 1), b3 + hstep, voffB);
            PG8_WAIT_V(6); PG8_BAR; PG8_MMA(1, 1, At, B1); PG8_BAR;
            }
        }
        if constexpr (ALIGN_EPI) { if (wr == 0) PG8_BAR; }
        if constexpr (!Epi::AFTER_DRAIN) { E(acc, cur, wr, wc, fr, fq); S.done(cur); }
        if (!has_next) break;
#pragma unroll
        for (int a = 0; a < 2; ++a)
#pragma unroll
            for (int b = 0; b < 2; ++b)
#pragma unroll
                for (int m = 0; m < 4; ++m)
#pragma unroll
                    for (int n = 0; n < 2; ++n) acc[a][b][m][n] = (f32x4){0.f, 0.f, 0.f, 0.f};
        cur = nxt; cA = nA; cB = nB; ++ui;
        if constexpr (ALIGN_EPI) { if (wr == 1) PG8_BAR; }
    }
    PG8_WAIT_V(0);
    if constexpr (!ALIGN_EPI) { if (wr == 0) PG8_BAR; }
    PG8_BAR;
    if constexpr (Epi::AFTER_DRAIN) { E.fused(acc, cur, wr, wc, fr, fq, lds, wid, lane); S.done(cur); }
#undef PG8_SA
#undef PG8_SB
#undef PG8_STAGE
#undef PG8_LDA
#undef PG8_LDB
#undef PG8_MMA
#undef PG8_WAIT_V
#undef PG8_WAIT_L
#undef PG8_BAR
#undef PG8_SCHED
}
}

#ifndef PG8_SP2
#define PG8_SP2 true
#endif
#ifndef PG8_ALIGN
#define PG8_ALIGN true
#endif
#define GAS __attribute__((address_space(1)))
#define LAS __attribute__((address_space(3)))
typedef unsigned short bf16;
typedef unsigned v4u __attribute__((ext_vector_type(4)));
typedef float f32x4 __attribute__((ext_vector_type(4)));
typedef short bf16x8 __attribute__((ext_vector_type(8)));
typedef GAS unsigned gu32;
typedef GAS unsigned long long gu64;
#define RLX_AGENT __ATOMIC_RELAXED, __HIP_MEMORY_SCOPE_AGENT
#define LDS_WAIT() asm volatile("s_waitcnt lgkmcnt(0)" ::: "memory")
#define VM_WAIT() asm volatile("s_waitcnt vmcnt(0)" ::: "memory")
__device__ __forceinline__ unsigned long long rt() { return __builtin_amdgcn_s_memrealtime(); }
__device__ __forceinline__ unsigned f2bf(float f) { unsigned u = __builtin_bit_cast(unsigned, f); return (u + 0x7fffu + ((u >> 16) & 1u)) >> 16; }
__device__ __forceinline__ unsigned pk2(float lo, float hi) { return f2bf(lo) | (f2bf(hi) << 16); }

#define XB_TMO      128
#define XB_XCNT(j)  (256  + 64 * (j))
#define XB_XSUB(j)  (1280 + 64 * (j))
#define XB_XGEN(j)  (2304 + 64 * (j))
#define XB_TOP      3328
#define XB_TOPGEN   3392
#define XCD_BAR_WORDS 3456
#define XB_SPIN_CAP (1u << 18)

__device__ __forceinline__ unsigned xb_ld(unsigned* p)              { return __hip_atomic_load(p, __ATOMIC_RELAXED, __HIP_MEMORY_SCOPE_AGENT); }
__device__ __forceinline__ unsigned xb_add(unsigned* p, unsigned v) { return __hip_atomic_fetch_add(p, v, __ATOMIC_RELAXED, __HIP_MEMORY_SCOPE_AGENT); }
__device__ __forceinline__ unsigned xb_xcc_id() { return (unsigned)__builtin_amdgcn_s_getreg((3 << 11) | 20) & 0xFu; }
#define XB_SPIN(cond, bar) do { unsigned _sp = 0; while (cond) { __builtin_amdgcn_s_sleep(1); \
    if ((++_sp & 255u) == 0u) { if (xb_ld(&(bar)[XB_TMO])) break; if (_sp > XB_SPIN_CAP) { atomicAdd(&(bar)[XB_TMO], 1u); break; } } } } while (0)

struct XcdBarrier {
    unsigned* bar; unsigned x;
    volatile LAS unsigned* st;
};

__device__ __forceinline__ XcdBarrier xcd_barrier_post(unsigned* bar, volatile LAS unsigned* st) {
    XcdBarrier b; b.bar = bar; b.x = xb_xcc_id(); b.st = st;
    if (threadIdx.x == 0) (void)xb_add(&bar[XB_XCNT(b.x)], 1u);
    return b;
}
__device__ __forceinline__ void xcd_barrier_complete(unsigned* bar, unsigned x, unsigned& nloc, unsigned& nx) {
    const unsigned G = gridDim.x * gridDim.y * gridDim.z;
    unsigned sum, cnt, mine, sp = 0u;
    for (;;) {
        sum = 0u; cnt = 0u; mine = 0u;
#pragma unroll
        for (unsigned j = 0; j < 16; ++j) { const unsigned c = xb_ld(&bar[XB_XCNT(j)]); sum += c; cnt += (c > 0u) ? 1u : 0u; mine = (j == x) ? c : mine; }
        if (sum == G) break;
        __builtin_amdgcn_s_sleep(1);
        if ((++sp & 255u) == 0u) { if (xb_ld(&bar[XB_TMO])) break; if (sp > XB_SPIN_CAP) { atomicAdd(&bar[XB_TMO], 1u); break; } }
    }
    nloc = mine > 0u ? mine : 1u; nx = cnt > 0u ? cnt : 1u;
}

__device__ __forceinline__ void xcd_barrier(const XcdBarrier& b) {
    asm volatile("s_waitcnt vmcnt(0)" ::: "memory");
    __syncthreads();
    if (threadIdx.x == 0) {
        unsigned* bar = b.bar;
        __builtin_amdgcn_s_waitcnt(0);
        unsigned nloc = b.st[0], nx = b.st[1];
        if (nloc == 0u) { xcd_barrier_complete(bar, b.x, nloc, nx); b.st[0] = nloc; b.st[1] = nx; }
        const unsigned old = xb_add(&bar[XB_XSUB(b.x)], 1u);
        const unsigned gen = old / nloc;
        if (old + 1u == (gen + 1u) * nloc) {
            __builtin_amdgcn_fence(__ATOMIC_RELEASE, "agent");
            asm volatile("s_waitcnt vmcnt(0)" ::: "memory");
            const unsigned og = xb_add(&bar[XB_TOP], 1u);
            const unsigned tg = og / nx;
            if (og + 1u == (tg + 1u) * nx) xb_add(&bar[XB_TOPGEN], 1u);
            else XB_SPIN(xb_ld(&bar[XB_TOPGEN]) == tg, bar);
            __builtin_amdgcn_fence(__ATOMIC_ACQUIRE, "agent");
            xb_add(&bar[XB_XGEN(b.x)], 1u);
            asm volatile("s_waitcnt vmcnt(0)" ::: "memory");
        } else {
            XB_SPIN(xb_ld(&bar[XB_XGEN(b.x)]) == gen, bar);
            __builtin_amdgcn_fence(__ATOMIC_ACQUIRE, "agent");
            asm volatile("s_waitcnt vmcnt(0)" ::: "memory");
        }
    }
    __syncthreads();
}

constexpr int NWAVES = 8;
constexpr int BATCH = 8, SEQ = 4096, D = 1024, FF = 2816, NIN = 3072, NH = 4;
constexpr int M = BATCH * SEQ;
constexpr float EPS = 1e-6f;
constexpr float LAM_INIT = 0.2f;
constexpr float LOG2E = 1.4426950408889634f;

constexpr size_t MiB = 1u << 20;
constexpr size_t WS_CTL = 0, CTL_ZERO_BYTES = 1 * MiB;
constexpr size_t WS_SS = 1 * MiB;
constexpr size_t WS_WGU1 = 2 * MiB, WS_WD1 = 13 * MiB, WS_WIN = 19 * MiB, WS_WOUT = 25 * MiB, WS_WGU2 = 27 * MiB, WS_WD2 = 38 * MiB;
constexpr size_t WS_XB = 48 * MiB;
constexpr size_t WS_H = 112 * MiB;
constexpr size_t WS_Q = WS_H, WS_K = WS_H + 32 * MiB, WS_V = WS_H + 64 * MiB, WS_GB = WS_H + 96 * MiB, WS_U = WS_H + 128 * MiB;
constexpr size_t WS_MIX = 288 * MiB;
constexpr size_t WS_O = 352 * MiB;
constexpr size_t WS_END = 416 * MiB;
static_assert(WS_WD2 + (size_t)D * FF * 2 <= WS_XB && WS_U + (size_t)M * 512 * 2 <= WS_H + (size_t)M * FF * 2 && WS_H + (size_t)M * FF * 2 <= WS_MIX, "d_ws map");
constexpr int CW_TMO = 0, CW_CODE = 1, CW_BAR = 4096;

constexpr int RING_OFF = 0, RING_BYTES = 131072;
constexpr int LDSCTL_OFF = RING_BYTES, MISC_OFF = LDSCTL_OFF + 320;
constexpr int LDS_BYTES = 147456;
static_assert(MISC_OFF + 128 <= LDS_BYTES, "LDS map");

typedef unsigned u32x4 __attribute__((ext_vector_type(4)));
typedef float f32x16 __attribute__((ext_vector_type(16)));
typedef short s16x4 __attribute__((ext_vector_type(4)));

struct Frame {
    LAS unsigned char* lds;
    volatile LAS unsigned* MISC;
    gu32* ctl;
    int tid, lane, wave, vcu, G;
};

__device__ __forceinline__ float wave_sum(float v) {
#pragma unroll
    for (int o = 1; o < 64; o <<= 1) v += __shfl_xor(v, o);
    return v;
}

__device__ __forceinline__ void transpose_item(const float* W, int srcN, int s0, int k0, const float* gain, bf16* WT, int K, int n0, LAS float* scr, int lane) {
#pragma unroll 8
    for (int i = 0; i < 32; ++i) { const int kk = 2 * i + (lane >> 5); float v = W[(size_t)(k0 + kk) * srcN + s0 + (lane & 31)]; if (gain) v *= gain[k0 + kk]; scr[kk * 33 + (lane & 31)] = v; }
    LDS_WAIT(); asm volatile("" ::: "memory");
    const int c = lane & 7;
#pragma unroll
    for (int j = 0; j < 4; ++j) { const int n = (lane >> 3) + 8 * j; const LAS float* s = scr + (8 * c) * 33 + n;
        v4u o; o.x = pk2(s[0 * 33], s[1 * 33]); o.y = pk2(s[2 * 33], s[3 * 33]); o.z = pk2(s[4 * 33], s[5 * 33]); o.w = pk2(s[6 * 33], s[7 * 33]);
        *(GAS v4u*)(WT + (size_t)(n0 + n) * K + k0 + 8 * c) = o; }
    LDS_WAIT(); asm volatile("" ::: "memory");
}
struct Args { const float* in[22]; float* out; unsigned char* ws; int ph_lo, ph_hi; };

__device__ __forceinline__ void p0_prologue(Frame& F, const Args& A) {
    LAS float* scr = (LAS float*)(F.lds + RING_OFF + F.wave * 16384);
    const int gw = F.vcu * NWAVES + F.wave, NGW = F.G * NWAVES;
    unsigned char* ws = A.ws;
    constexpr int I_GU = (D / 64) * (2 * FF / 32), I_DN = (FF / 64) * (D / 32), I_IN = (D / 64) * (NIN / 32), I_OUT = (D / 64) * (D / 32);
    constexpr int NITEMS = 2 * I_GU + 2 * I_DN + I_IN + I_OUT;
    for (int it = gw; it < NITEMS; it += NGW) {
        int r = it;
        if (r < 2 * I_GU) {
            const int l = r >= I_GU; if (l) r -= I_GU;
            constexpr int nblk = 2 * FF / 32; const int kb = r / nblk, nb = r % nblk, n0 = 32 * nb;
            const int pn = n0 >> 8, half = (n0 >> 7) & 1, j = n0 & 127;
            const float* W = A.in[l ? (half ? 19 : 18) : (half ? 3 : 2)];
            transpose_item(W, FF, 128 * pn + j, 64 * kb, A.in[l ? 17 : 1], (bf16*)(ws + (l ? WS_WGU2 : WS_WGU1)), D, n0, scr, F.lane);
            continue;
        }
        r -= 2 * I_GU;
        if (r < 2 * I_DN) {
            const int l = r >= I_DN; if (l) r -= I_DN;
            constexpr int nblk = D / 32; const int kb = r / nblk, nb = r % nblk;
            transpose_item(A.in[l ? 20 : 4], D, 32 * nb, 64 * kb, nullptr, (bf16*)(ws + (l ? WS_WD2 : WS_WD1)), FF, 32 * nb, scr, F.lane);
            continue;
        }
        r -= 2 * I_DN;
        if (r < I_IN) {
            constexpr int nblk = NIN / 32; const int kb = r / nblk, nb = r % nblk, n0 = 32 * nb;
            const int pn = n0 >> 8, half = (n0 >> 7) & 1, j = n0 & 127;
            int s0;
            if (pn < 4) s0 = (pn >> 1) * 512 + 64 * (4 * (pn & 1) + (j >> 5)) + 32 * half;
            else if (pn < 8) s0 = n0;
            else s0 = (half ? 2560 : 2048) + 128 * (pn - 8) + j;
            transpose_item(A.in[6], NIN, s0, 64 * kb, A.in[5], (bf16*)(ws + WS_WIN), D, n0, scr, F.lane);
            continue;
        }
        r -= I_IN;
        { constexpr int nblk = D / 32; const int kb = r / nblk, nb = r % nblk;
          transpose_item(A.in[16], D, 32 * nb, 64 * kb, nullptr, (bf16*)(ws + WS_WOUT), D, 32 * nb, scr, F.lane); }
    }
    const float* x = A.in[0]; bf16* xb = (bf16*)(ws + WS_XB); float* ss = (float*)(ws + WS_SS);
    for (int m = gw; m < M; m += NGW) {
        const GAS f32x4* xr = (const GAS f32x4*)(x + (size_t)m * D) + F.lane;
        f32x4 v[4]; float s = 0.f;
#pragma unroll
        for (int j = 0; j < 4; ++j) { v[j] = xr[64 * j]; s += (v[j].x * v[j].x + v[j].y * v[j].y) + (v[j].z * v[j].z + v[j].w * v[j].w); }
        s = wave_sum(s);
        GAS unsigned long long* o8 = (GAS unsigned long long*)(xb + (size_t)m * D) + F.lane;
#pragma unroll
        for (int j = 0; j < 4; ++j) o8[64 * j] = (unsigned long long)pk2(v[j].x, v[j].y) | ((unsigned long long)pk2(v[j].z, v[j].w) << 32);
        if (F.lane == 0) { ss[m] = s; ss[M + m] = 0.f; ss[2 * M + m] = 0.f; }
    }
}

namespace att {
constexpr int SLOT = 24576;
constexpr int L_KV = 0, L_WS = 2 * SLOT, L_Q = L_WS + 4096, L_END = L_Q + 32768;
static_assert(L_END <= RING_BYTES, "attention LDS");
constexpr float THR = 8.0f;
__device__ __forceinline__ int crow(int r, int hi) { return (r & 3) + 8 * (r >> 2) + 4 * hi; }
typedef __bf16 bf16x2_t __attribute__((ext_vector_type(2))); typedef float f32x2_t __attribute__((ext_vector_type(2)));
__device__ __forceinline__ unsigned cvtpk(float lo, float hi) { f32x2_t v = {lo, hi}; bf16x2_t b = __builtin_convertvector(v, bf16x2_t); return __builtin_bit_cast(unsigned, b); }
typedef short v4i16_t __attribute__((ext_vector_type(4)));
__device__ __forceinline__ s16x4 vtr(LAS const unsigned char* p) { return __builtin_bit_cast(s16x4, __builtin_amdgcn_ds_read_tr16_b64_v4i16((LAS v4i16_t*)p)); }
#define MX3(a, b, c) __builtin_fmaxf(__builtin_fmaxf((a), (b)), (c))

__device__ __forceinline__ void attn_unit(int b, int h, int mc, int qb, const bf16* Qg, const bf16* Kg, const bf16* Vg, bf16* OB, LAS unsigned char* shm) {
    const int tid = threadIdx.x, lane = tid & 63, r32 = lane & 31, hi = lane >> 5; const int wid = __builtin_amdgcn_readfirstlane(tid >> 6);
    const size_t rowbase = (size_t)b * SEQ; const int q0 = qb * 256;
    const float sl2 = LOG2E * __builtin_amdgcn_exp2f(-2.0f * (float)(h + 1));
    LAS float* wsf = (LAS float*)(shm + L_WS) + wid * 128;
    LAS unsigned char* Qf = shm + L_Q + wid * 4096;
    const int NT = (q0 + 256) / 64;
    const bf16* ksrc = Kg + (rowbase + lane) * 512 + h * 128 + mc * 64 + wid * 8;
    const int vp0 = wid * 2, vp1 = wid * 2 + 1;
    const bf16* vsrc0 = Vg + (rowbase + 16 * (vp0 & 3) + (lane >> 2)) * 512 + h * 128 + (vp0 >> 2) * 32 + (lane & 3) * 8;
    const bf16* vsrc1 = Vg + (rowbase + 16 * (vp1 & 3) + (lane >> 2)) * 512 + h * 128 + (vp1 >> 2) * 32 + (lane & 3) * 8;
#define ATT_DMA(t, slot) do { const size_t go_ = (size_t)(t) * 64 * 512; LAS unsigned char* sb_ = shm + L_KV + (slot) * SLOT; \
        __builtin_amdgcn_global_load_lds((const unsigned*)(ksrc + go_), (LAS unsigned*)(sb_ + wid * 1024), 16, 0, 0); \
        __builtin_amdgcn_global_load_lds((const unsigned*)(vsrc0 + go_), (LAS unsigned*)(sb_ + 8192 + vp0 * 1024), 16, 0, 0); \
        __builtin_amdgcn_global_load_lds((const unsigned*)(vsrc1 + go_), (LAS unsigned*)(sb_ + 8192 + vp1 * 1024), 16, 0, 0); } while (0)
    __syncthreads();
    ATT_DMA(NT - 1, 0);
    {
        const bf16* qp = Qg + (rowbase + q0 + wid * 32 + r32) * 512 + h * 128 + mc * 64 + hi * 8;
#pragma unroll
        for (int d0 = 0; d0 < 4; ++d0) *(LAS u32x4*)(Qf + d0 * 1024 + lane * 16) = *(const GAS u32x4*)(qp + d0 * 16);
    }
    f32x16 o[4];
#pragma unroll
    for (int d = 0; d < 4; ++d)
#pragma unroll
        for (int r = 0; r < 16; ++r) o[d][r] = 0.f;
    float mhat = 0.f, lrun = 0.f;
    const int irel = wid * 32 + r32;
    f32x16 cb;
#pragma unroll
    for (int r = 0; r < 16; ++r) cb[r] = sl2 * (float)(crow(r, hi) - irel);
    const LAS unsigned char* vbl = (const LAS unsigned char*)shm + L_KV + 8192 + ((lane >> 4) & 1) * 32 + (lane & 3) * 8 + (4 * hi + ((lane & 15) >> 2)) * 64;
    const LAS unsigned char* kbl = (const LAS unsigned char*)shm + L_KV + hi * 1024 + r32 * 16;
    for (int it = 0; it < NT; ++it) {
        const int t = NT - 1 - it, slot = it & 1;
        asm volatile("s_waitcnt vmcnt(0)" ::: "memory");
        __syncthreads();
        if (it + 1 < NT) ATT_DMA(t - 1, slot ^ 1);
        const int jb = t - (NT - 4);
        if (jb >= 0 && 64 * jb > 32 * wid + 31) continue;
        const float at = sl2 * (float)(64 * t - q0) - mhat, at1 = at + 32.0f * sl2;
        f32x16 p0, p1;
#pragma unroll
        for (int r = 0; r < 16; ++r) { p0[r] = cb[r] + at; p1[r] = cb[r] + at1; }
        const LAS unsigned char* kb = kbl + slot * SLOT;
#pragma unroll
        for (int d0 = 0; d0 < 4; ++d0) {
            const bf16x8 qf = *(LAS const bf16x8*)(Qf + d0 * 1024 + lane * 16);
            const bf16x8 b0 = *(LAS const bf16x8*)(kb + d0 * 2048), b1 = *(LAS const bf16x8*)(kb + d0 * 2048 + 512);
            p0 = __builtin_amdgcn_mfma_f32_32x32x16_bf16(b0, qf, p0, 0, 0, 0);
            p1 = __builtin_amdgcn_mfma_f32_32x32x16_bf16(b1, qf, p1, 0, 0, 0);
        }
        if (jb >= 0) {
            const int kb0 = 64 * jb + 4 * hi;
#pragma unroll
            for (int r = 0; r < 16; ++r) { const int kv = kb0 + (r & 3) + 8 * (r >> 2); if (kv > irel) p0[r] = -INFINITY; if (kv + 32 > irel) p1[r] = -INFINITY; }
        }
        float ra = MX3(p0[0], p0[1], p1[0]), rb = MX3(p0[2], p0[3], p1[1]); ra = MX3(ra, p1[2], p1[3]);
#pragma unroll
        for (int r = 4; r < 16; r += 4) { ra = MX3(ra, p0[r], p0[r + 1]); rb = MX3(rb, p0[r + 2], p0[r + 3]); ra = MX3(ra, p1[r], p1[r + 1]); rb = MX3(rb, p1[r + 2], p1[r + 3]); }
        float rm = __builtin_fmaxf(ra, rb); rm = __builtin_fmaxf(rm, __shfl_xor(rm, 32));
        if (__any(rm > THR)) {
            const float dl = __builtin_fmaxf(rm, 0.f); mhat += dl;
#pragma unroll
            for (int r = 0; r < 16; ++r) { p0[r] -= dl; p1[r] -= dl; }
            const float f = __builtin_amdgcn_exp2f(-dl); lrun *= f;
            if (hi == 0) wsf[r32] = f;
            LDS_WAIT(); asm volatile("" ::: "memory");
#pragma unroll
            for (int r = 0; r < 16; ++r) { const float fr_ = wsf[crow(r, hi)];
#pragma unroll
                for (int d = 0; d < 4; ++d) o[d][r] *= fr_; }
            LDS_WAIT(); asm volatile("" ::: "memory");
        }
        float s0 = 0.f, s1 = 0.f;
#pragma unroll
        for (int r = 0; r < 16; ++r) { p0[r] = __builtin_amdgcn_exp2f(p0[r]); p1[r] = __builtin_amdgcn_exp2f(p1[r]); s0 += p0[r]; s1 += p1[r]; }
        lrun += s0 + s1;
        u32x4 pw[4];
        pw[0] = (u32x4){cvtpk(p0[0], p0[1]), cvtpk(p0[2], p0[3]), cvtpk(p0[4], p0[5]), cvtpk(p0[6], p0[7])};
        pw[1] = (u32x4){cvtpk(p0[8], p0[9]), cvtpk(p0[10], p0[11]), cvtpk(p0[12], p0[13]), cvtpk(p0[14], p0[15])};
        pw[2] = (u32x4){cvtpk(p1[0], p1[1]), cvtpk(p1[2], p1[3]), cvtpk(p1[4], p1[5]), cvtpk(p1[6], p1[7])};
        pw[3] = (u32x4){cvtpk(p1[8], p1[9]), cvtpk(p1[10], p1[11]), cvtpk(p1[12], p1[13]), cvtpk(p1[14], p1[15])};
        const LAS unsigned char* vb = vbl + slot * SLOT;
#pragma unroll
        for (int d0 = 0; d0 < 4; ++d0)
#pragma unroll
            for (int ks = 0; ks < 4; ++ks) {
                const s16x4 lo = vtr(vb + d0 * 4096 + ks * 1024), h8 = vtr(vb + d0 * 4096 + ks * 1024 + 512);
                const bf16x8 vf = (bf16x8){lo[0], lo[1], lo[2], lo[3], h8[0], h8[1], h8[2], h8[3]};
                o[d0] = __builtin_amdgcn_mfma_f32_32x32x16_bf16(__builtin_bit_cast(bf16x8, pw[ks]), vf, o[d0], 0, 0, 0);
            }
    }
#undef ATT_DMA
    lrun += __shfl_xor(lrun, 32);
    if (hi == 0) wsf[r32] = 1.0f / lrun;
    LDS_WAIT(); asm volatile("" ::: "memory");
    bf16* op = OB + (rowbase + q0 + wid * 32) * 1024 + h * 256 + mc * 128 + r32;
#pragma unroll
    for (int r = 0; r < 16; ++r) {
        const int cr = crow(r, hi); const float f0 = wsf[cr];
#pragma unroll
        for (int d = 0; d < 4; ++d) op[(size_t)cr * 1024 + 32 * d] = (bf16)f2bf(o[d][r] * f0);
    }
    LDS_WAIT(); asm volatile("" ::: "memory");
}
#undef MX3
}

__device__ __forceinline__ void conv_phase(Frame& F, const bf16* U, const bf16* GB, const float* cw, const float* cn, bf16* MIX) {
    const int gw = F.vcu * NWAVES + F.wave, NGW = F.G * NWAVES; const int ch0 = F.lane * 8;
    float w0[8], w1[8], w2[8], gn[8];
#pragma unroll
    for (int i = 0; i < 8; ++i) { w0[i] = cw[ch0 + i]; w1[i] = cw[512 + ch0 + i]; w2[i] = cw[1024 + ch0 + i]; gn[i] = cn[ch0 + i]; }
    for (int g = gw; g < M / 16; g += NGW) {
        const int t0 = 16 * g;
        float um2[8], um1[8];
        if ((t0 & (SEQ - 1)) == 0) {
#pragma unroll
            for (int i = 0; i < 8; ++i) { um2[i] = 0.f; um1[i] = 0.f; }
        } else {
            const v4u a = *(const GAS v4u*)(U + (size_t)(t0 - 2) * 512 + ch0), b = *(const GAS v4u*)(U + (size_t)(t0 - 1) * 512 + ch0);
#pragma unroll
            for (int i = 0; i < 4; ++i) { um2[2 * i] = __uint_as_float(a[i] << 16); um2[2 * i + 1] = __uint_as_float(a[i] & 0xffff0000u); um1[2 * i] = __uint_as_float(b[i] << 16); um1[2 * i + 1] = __uint_as_float(b[i] & 0xffff0000u); }
        }
        for (int t = t0; t < t0 + 16; ++t) {
            const v4u a = *(const GAS v4u*)(U + (size_t)t * 512 + ch0), b = *(const GAS v4u*)(GB + (size_t)t * 512 + ch0);
            float ut[8], gb[8], c[8]; float s = 0.f;
#pragma unroll
            for (int i = 0; i < 4; ++i) { ut[2 * i] = __uint_as_float(a[i] << 16); ut[2 * i + 1] = __uint_as_float(a[i] & 0xffff0000u); gb[2 * i] = __uint_as_float(b[i] << 16); gb[2 * i + 1] = __uint_as_float(b[i] & 0xffff0000u); }
#pragma unroll
            for (int i = 0; i < 8; ++i) { c[i] = gb[i] * (w0[i] * um2[i] + w1[i] * um1[i] + w2[i] * ut[i]); s += c[i] * c[i]; um2[i] = um1[i]; um1[i] = ut[i]; }
            s += __shfl_xor(s, 1); s += __shfl_xor(s, 2); s += __shfl_xor(s, 4);
            const float rn = __builtin_amdgcn_rsqf(s * (1.0f / 64.0f) + EPS);
            v4u o;
#pragma unroll
            for (int i = 0; i < 4; ++i) o[i] = pk2(c[2 * i] * rn * gn[2 * i], c[2 * i + 1] * rn * gn[2 * i + 1]);
            *(GAS v4u*)(MIX + (size_t)t * 1024 + 512 + ch0) = o;
        }
    }
}

__device__ __forceinline__ void combine_phase(Frame& F, const bf16* OB, const float* subln, float lam, bf16* MIX) {
    const int gw = F.vcu * NWAVES + F.wave, NGW = F.G * NWAVES; const int hh = F.lane >> 4, d0 = 8 * (F.lane & 15);
    float gn[8];
#pragma unroll
    for (int i = 0; i < 8; ++i) gn[i] = subln[d0 + i] * (1.0f - LAM_INIT);
    for (int t = gw; t < M; t += NGW) {
        const v4u a = *(const GAS v4u*)(OB + (size_t)t * 1024 + hh * 256 + d0), b = *(const GAS v4u*)(OB + (size_t)t * 1024 + hh * 256 + 128 + d0);
        float c[8]; float s = 0.f;
#pragma unroll
        for (int i = 0; i < 4; ++i) { c[2 * i] = __uint_as_float(a[i] << 16) - lam * __uint_as_float(b[i] << 16); c[2 * i + 1] = __uint_as_float(a[i] & 0xffff0000u) - lam * __uint_as_float(b[i] & 0xffff0000u); }
#pragma unroll
        for (int i = 0; i < 8; ++i) s += c[i] * c[i];
        s += __shfl_xor(s, 1); s += __shfl_xor(s, 2); s += __shfl_xor(s, 4); s += __shfl_xor(s, 8);
        const float rn = __builtin_amdgcn_rsqf(s * (1.0f / 128.0f) + EPS);
        v4u o;
#pragma unroll
        for (int i = 0; i < 4; ++i) o[i] = pk2(c[2 * i] * rn * gn[2 * i], c[2 * i + 1] * rn * gn[2 * i + 1]);
        *(GAS v4u*)(MIX + (size_t)t * 1024 + hh * 128 + d0) = o;
    }
}

__device__ __forceinline__ void final_norm_phase(Frame& F, float* out, const float* gain) {
    const int gw = F.vcu * NWAVES + F.wave, NGW = F.G * NWAVES;
    f32x4 gv[4];
#pragma unroll
    for (int j = 0; j < 4; ++j) gv[j] = *((const GAS f32x4*)gain + F.lane + 64 * j);
    for (int m = gw; m < M; m += NGW) {
        GAS f32x4* xr = (GAS f32x4*)(out + (size_t)m * D) + F.lane;
        f32x4 v[4]; float s = 0.f;
#pragma unroll
        for (int j = 0; j < 4; ++j) { v[j] = xr[64 * j]; s += (v[j].x * v[j].x + v[j].y * v[j].y) + (v[j].z * v[j].z + v[j].w * v[j].w); }
        s = wave_sum(s);
        const float r = __builtin_amdgcn_rsqf(s * (1.0f / D) + EPS);
#pragma unroll
        for (int j = 0; j < 4; ++j) xr[64 * j] = v[j] * r * gv[j];
    }
}

constexpr int N_PHASES = 10;
__global__ void __launch_bounds__(NWAVES * 64, 2) fwd_kernel(Args args) {
    extern __shared__ __attribute__((aligned(16))) unsigned char lds[];
    Frame F;
    F.lds = (LAS unsigned char*)lds;
    F.MISC = (volatile LAS unsigned*)(F.lds + MISC_OFF);
    F.tid = threadIdx.x; F.lane = F.tid & 63; F.wave = __builtin_amdgcn_readfirstlane(F.tid >> 6);
    F.G = gridDim.x; { const int bx = blockIdx.x; F.vcu = (F.G % 8 == 0) ? (bx % 8) * (F.G / 8) + bx / 8 : bx; }
    unsigned char* ws = args.ws;
    F.ctl = (gu32*)(ws + WS_CTL);
    for (int u = F.tid; u < (LDS_BYTES - LDSCTL_OFF) / 4; u += NWAVES * 64) ((LAS unsigned*)(F.lds + LDSCTL_OFF))[u] = 0u;
    __syncthreads();
    const int lo = args.ph_lo, hi = args.ph_hi;
    const bool one_launch = (hi - lo) > 1;
    XcdBarrier bar; bar.bar = (unsigned*)(F.ctl + CW_BAR); bar.x = 0; bar.st = nullptr;
    if (one_launch) bar = xcd_barrier_post((unsigned*)(F.ctl + CW_BAR), F.MISC + 8);
#ifndef PHASE_MASK
#define PHASE_MASK 0x3ff
#endif
#define IN(k) (((PHASE_MASK >> (k)) & 1) && lo <= (k) && (k) < hi)
#define SEAM(k) do { if (IN(k) && IN((k) + 1)) xcd_barrier(bar); } while (0)

    float* ss = (float*)(ws + WS_SS);
    bf16* XB = (bf16*)(ws + WS_XB); bf16* HB = (bf16*)(ws + WS_H); bf16* MIX = (bf16*)(ws + WS_MIX);
    bf16 *QB_ = (bf16*)(ws + WS_Q), *KB_ = (bf16*)(ws + WS_K), *VB_ = (bf16*)(ws + WS_V), *GBB = (bf16*)(ws + WS_GB), *UB = (bf16*)(ws + WS_U), *OBB = (bf16*)(ws + WS_O);

#ifndef DUP_PHASE
#define DUP_PHASE -1
#endif
#define REPS(k) for (int rep = 0; rep < ((DUP_PHASE == (k)) ? 2 : 1); ++rep)
#ifdef PROBE_PH_A
    gu64* tsw = (gu64*)(F.ctl + 2048);
#define STAMP(k) do { if (blockIdx.x == 0 && F.tid == 0) __hip_atomic_store(tsw + (k), rt(), RLX_AGENT); } while (0)
#else
#define STAMP(k) do {} while (0)
#endif
    STAMP(0);
    if (IN(0)) { p0_prologue(F, args); } SEAM(0); STAMP(1);
    if (IN(1)) REPS(1) {
        pg8::Gemm g{XB, (const bf16*)(ws + WS_WGU1), M, 2 * FF, D}; pg8::StaticOrder S; S.init(M, 2 * FF, F.G, (int)blockIdx.x);
        pg8::EpiSwiGLU E{HB, FF, ss, 1.0f / D};
        pg8::gemm_phase<pg8::EpiSwiGLU, pg8::StaticOrder, PG8_ALIGN, PG8_SP2>(F.lds + RING_OFF, g, S, E);
    } SEAM(1); STAMP(2);
    if (IN(2)) REPS(2) {
        pg8::Gemm g{HB, (const bf16*)(ws + WS_WD1), M, D, FF}; pg8::StaticOrder S; S.init(M, D, F.G, (int)blockIdx.x);
        pg8::EpiRes E{args.in[0], args.out, XB, rep ? ss + 3 * M : ss + M, 0.5f};
        pg8::gemm_phase<pg8::EpiRes, pg8::StaticOrder, PG8_ALIGN, PG8_SP2>(F.lds + RING_OFF, g, S, E);
    } SEAM(2); STAMP(3);
    if (IN(3)) REPS(3) {
        pg8::Gemm g{XB, (const bf16*)(ws + WS_WIN), M, NIN, D}; pg8::StaticOrder S; S.init(M, NIN, F.G, (int)blockIdx.x);
        pg8::EpiIn E{QB_, KB_, VB_, GBB, UB, ss + M, args.in[7], args.in[8], 0.125f * LOG2E};
        pg8::gemm_phase<pg8::EpiIn, pg8::StaticOrder, PG8_ALIGN, PG8_SP2>(F.lds + RING_OFF, g, S, E);
    } SEAM(3); STAMP(4);
    if (IN(4)) REPS(4) {
        conv_phase(F, UB, GBB, args.in[14], args.in[15], MIX);
        const int nun = BATCH * NH * 32;
        for (int i = 0; ; ++i) {
            const int L = i * F.G + F.vcu; if (L >= nun) break;
            const int round = L / 256, w = L % 256, bh = w >> 3, s = w & 7; const int qb = (round & 1) ? 15 - s : s, mc = round >> 1;
            att::attn_unit(bh >> 2, bh & 3, mc, qb, QB_, KB_, VB_, OBB, F.lds + RING_OFF);
        }
    } SEAM(4); STAMP(5);
    if (IN(5)) {
        float lam;
        { const float a = args.in[9][F.lane] * args.in[10][F.lane], b2 = args.in[11][F.lane] * args.in[12][F.lane];
          lam = expf(wave_sum(a)) - expf(wave_sum(b2)) + LAM_INIT; }
        combine_phase(F, OBB, args.in[13], lam, MIX);
    } SEAM(5); STAMP(6);
    if (IN(6)) REPS(6) {
        pg8::Gemm g{MIX, (const bf16*)(ws + WS_WOUT), M, D, D}; pg8::StaticOrder S; S.init(M, D, F.G, (int)blockIdx.x);
        pg8::EpiRes E{args.out, rep ? (float*)(ws + WS_H) : args.out, rep ? nullptr : XB, rep ? ss + 3 * M : ss + 2 * M, 1.0f};
        pg8::gemm_phase<pg8::EpiRes, pg8::StaticOrder, PG8_ALIGN, PG8_SP2>(F.lds + RING_OFF, g, S, E);
    } SEAM(6); STAMP(7);
    if (IN(7)) {
        pg8::Gemm g{XB, (const bf16*)(ws + WS_WGU2), M, 2 * FF, D}; pg8::StaticOrder S; S.init(M, 2 * FF, F.G, (int)blockIdx.x);
        pg8::EpiSwiGLU E{HB, FF, ss + 2 * M, 1.0f / D};
        pg8::gemm_phase<pg8::EpiSwiGLU, pg8::StaticOrder, PG8_ALIGN, PG8_SP2>(F.lds + RING_OFF, g, S, E);
    } SEAM(7); STAMP(8);
    if (IN(8)) {
        pg8::Gemm g{HB, (const bf16*)(ws + WS_WD2), M, D, FF}; pg8::StaticOrder S; S.init(M, D, F.G, (int)blockIdx.x);
        pg8::EpiRes E{args.out, args.out, nullptr, nullptr, 0.5f};
        pg8::gemm_phase<pg8::EpiRes, pg8::StaticOrder, PG8_ALIGN, PG8_SP2>(F.lds + RING_OFF, g, S, E);
    } SEAM(8); STAMP(9);
    if (IN(9)) final_norm_phase(F, args.out, args.in[21]);
#ifdef PROBE_PH_A
    STAMP(10);
    __syncthreads();
    if (blockIdx.x == 0 && F.wave == 0) {
        asm volatile("s_waitcnt vmcnt(0)" ::: "memory");
        const float ta = (float)(__hip_atomic_load(tsw + PROBE_PH_A + 1, RLX_AGENT) - __hip_atomic_load(tsw + PROBE_PH_A, RLX_AGENT)) * 0.01f;
        const float tb = (float)(__hip_atomic_load(tsw + PROBE_PH_B + 1, RLX_AGENT) - __hip_atomic_load(tsw + PROBE_PH_B, RLX_AGENT)) * 0.01f;
        if (F.lane == 0) args.out[0] += ta;
        for (int j = 1; j < 16; ++j) args.out[F.lane + 64 * j] += tb * 0.01f;
    }
#endif
#undef IN
#undef SEAM
}

#ifndef MK_N_LAUNCHES
#define MK_N_LAUNCHES 1
#endif
extern "C" void kernel_launch(void* const* d_in, const int* in_sizes, int n_in, void* d_out, int out_size, void* d_ws, size_t ws_size, hipStream_t stream) {
    static int grid = 0;
    if (grid == 0) {
        if (n_in != 22 || in_sizes[0] != M * D || out_size != M * D || ws_size < WS_END) { fprintf(stderr, "kernel_launch: unexpected shapes (n_in %d, in0 %d, out %d, ws %zu); nothing launched\n", n_in, n_in > 0 ? in_sizes[0] : -1, out_size, ws_size); grid = -1; return; }
        int dev = 0, cus = 0;
        if (hipGetDevice(&dev) != hipSuccess || hipDeviceGetAttribute(&cus, hipDeviceAttributeMultiprocessorCount, dev) != hipSuccess) { grid = -1; return; }
        if (hipFuncSetAttribute((const void*)fwd_kernel, hipFuncAttributeMaxDynamicSharedMemorySize, LDS_BYTES) != hipSuccess) { fprintf(stderr, "kernel_launch: hipFuncSetAttribute failed\n"); grid = -1; return; }
        (void)hipGetLastError();
        grid = cus;
    }
    if (grid < 0) return;
    if (hipMemsetAsync((char*)d_ws + WS_CTL, 0, CTL_ZERO_BYTES, stream) != hipSuccess) return;
    Args a{};
    for (int i = 0; i < 22; ++i) a.in[i] = (const float*)d_in[i];
    a.out = (float*)d_out; a.ws = (unsigned char*)d_ws;
    if (MK_N_LAUNCHES == 1) { a.ph_lo = 0; a.ph_hi = N_PHASES; hipLaunchKernelGGL(fwd_kernel, dim3(grid), dim3(NWAVES * 64), LDS_BYTES, stream, a); }
    else for (int p = 0; p < N_PHASES; ++p) { a.ph_lo = p; a.ph_hi = p + 1; hipLaunchKernelGGL(fwd_kernel, dim3(grid), dim3(NWAVES * 64), LDS_BYTES, stream, a); }
}
```

```cpp
#include <hip/hip_runtime.h>
#include <cstdio>
#include <cstdint>
namespace pg8 {
#define PG8_LAS __attribute__((address_space(3)))
typedef unsigned short bf16_t;
typedef short bf16x8 __attribute__((ext_vector_type(8)));
typedef float f32x4 __attribute__((ext_vector_type(4)));
typedef unsigned u32x4 __attribute__((ext_vector_type(4)));
constexpr int BM = 256, BK = 64, HALF = 128, HTB = HALF * BK * 2  , STAGE_BYTES = 8 * HTB, NXCD = 8, WGM = 8;

__host__ __device__ __forceinline__ int lds_byte(int r, int c) { const int st = (r >> 4) * 2 + (c >> 5), rr = r & 15, cc = c & 31, ob = rr * 64 + cc * 2; return st * 1024 + (ob ^ (((ob >> 9) & 1) << 5)); }
__host__ __device__ __forceinline__ void stage_rc(int b, int& R, int& C) { const int st = b / 1024, sb = b % 1024, swz = sb ^ (((sb >> 9) & 1) << 5); R = (st >> 1) * 16 + swz / 64; C = (st & 1) * 32 + (swz % 64) / 2; }
__host__ __device__ __forceinline__ int perm32(int rho) { const int n = rho >> 4, i = rho & 15; return 8 * (i >> 2) + 4 * n + (i & 3); }

struct Unit { int pm, pn; };
struct Gemm { const bf16_t* A; const bf16_t* Bt; int M, N, K; };

struct StaticOrder {
    int nM, nN, nwg, G, c;
    __host__ __device__ void init(int M, int N, int G_, int c_) { nM = M / BM; nN = N / BM; nwg = nM * nN; G = G_; c = c_; }
    __host__ __device__ bool next(int i, Unit& u) const {
        const long L = (long)i * G + c; if (L >= nwg) return false;
        int wgid = (int)L; { const int q = nwg / NXCD, r = nwg % NXCD, xcd = wgid % NXCD, off = wgid / NXCD; wgid = (xcd < r ? xcd * (q + 1) : r * (q + 1) + (xcd - r) * q) + off; }
        const int nig = WGM * nN, gid = wgid / nig, fm = gid * WGM, gsz = (nM - fm) < WGM ? (nM - fm) : WGM;
        u.pm = fm + ((wgid % nig) % gsz); u.pn = (wgid % nig) / gsz; return true;
    }
    __device__ __forceinline__ void a_ready(const Unit&) const {}
    __device__ __forceinline__ void done(const Unit&) const {}
};

__device__ __forceinline__ unsigned cvt_pk_bf16(float lo, float hi) { unsigned r; asm volatile("v_cvt_pk_bf16_f32 %0, %1, %2" : "=v"(r) : "v"(lo), "v"(hi)); return r; }
typedef float f32x2 __attribute__((ext_vector_type(2)));
typedef unsigned u32x2 __attribute__((ext_vector_type(2)));
constexpr float NORM_EPS = 1e-6f;
__device__ __forceinline__ float silu_mul(float g, float u) {
    const float e = __builtin_amdgcn_exp2f(g * -1.4426950408889634f);
    return g * u * __builtin_amdgcn_rcpf(1.0f + e);
}
struct EpiSwiGLU {
    static constexpr bool PERM = true, AFTER_DRAIN = false;
    bf16_t* Hout; int ldh; const float* ss; float inv_k;
    __device__ __forceinline__ void operator()(const f32x4 (&acc)[2][2][4][2], const Unit& u, int wr, int wc, int fr, int fq) const {
        const int row0 = u.pm * BM + wr * 64 + fr, col0 = u.pn * HALF + wc * 32 + 8 * fq;
#pragma unroll
        for (int ai = 0; ai < 2; ++ai)
#pragma unroll
            for (int m = 0; m < 4; ++m) {
                const int row = row0 + ai * HALF + m * 16;
                const float rs = __builtin_amdgcn_rsqf(ss[row] * inv_k + NORM_EPS);
                const f32x4 g0 = acc[ai][0][m][0] * rs, g1 = acc[ai][0][m][1] * rs, u0 = acc[ai][1][m][0] * rs, u1 = acc[ai][1][m][1] * rs;
                u32x4 w;
                w.x = cvt_pk_bf16(silu_mul(g0[0], u0[0]), silu_mul(g0[1], u0[1]));
                w.y = cvt_pk_bf16(silu_mul(g0[2], u0[2]), silu_mul(g0[3], u0[3]));
                w.z = cvt_pk_bf16(silu_mul(g1[0], u1[0]), silu_mul(g1[1], u1[1]));
                w.w = cvt_pk_bf16(silu_mul(g1[2], u1[2]), silu_mul(g1[3], u1[3]));
                *(u32x4*)(Hout + (size_t)row * ldh + col0) = w;
            }
    }
};
template <bool RES_F32> struct EpiResB {
    static constexpr bool PERM = true, AFTER_DRAIN = false;
    const void* res; bf16_t* out; float* ssacc; float scale;
    __device__ __forceinline__ void operator()(const f32x4 (&acc)[2][2][4][2], const Unit& u, int wr, int wc, int fr, int fq) const {
        const int row0 = u.pm * BM + wr * 64 + fr, col0 = u.pn * BM + wc * 32 + 8 * fq;
#pragma unroll
        for (int ai = 0; ai < 2; ++ai) {
            float srow[4];
            if constexpr (RES_F32) {
                const float* rp = (const float*)res;
#pragma unroll
                for (int mh = 0; mh < 2; ++mh) {
                    f32x4 rv[2][2][2];
#pragma unroll
                    for (int mm = 0; mm < 2; ++mm)
#pragma unroll
                        for (int bj = 0; bj < 2; ++bj)
#pragma unroll
                            for (int n = 0; n < 2; ++n) rv[mm][bj][n] = *(const f32x4*)(rp + (size_t)(row0 + ai * HALF + (2 * mh + mm) * 16) * 1024 + col0 + bj * HALF + 4 * n);
#pragma unroll
                    for (int mm = 0; mm < 2; ++mm) {
                        const int m = 2 * mh + mm; const size_t off = (size_t)(row0 + ai * HALF + m * 16) * 1024 + col0; float s = 0.f;
#pragma unroll
                        for (int bj = 0; bj < 2; ++bj) {
                            const f32x4 a = rv[mm][bj][0] + acc[ai][bj][m][0] * scale, b = rv[mm][bj][1] + acc[ai][bj][m][1] * scale;
                            s += (a[0] * a[0] + a[1] * a[1]) + (a[2] * a[2] + a[3] * a[3]) + (b[0] * b[0] + b[1] * b[1]) + (b[2] * b[2] + b[3] * b[3]);
                            u32x4 w; w.x = cvt_pk_bf16(a[0], a[1]); w.y = cvt_pk_bf16(a[2], a[3]); w.z = cvt_pk_bf16(b[0], b[1]); w.w = cvt_pk_bf16(b[2], b[3]);
                            *(u32x4*)(out + off + bj * HALF) = w;
                        }
                        s += __shfl_xor(s, 16); s += __shfl_xor(s, 32); srow[m] = s;
                    }
                    asm volatile("" ::: "memory");
                }
            } else {
                const bf16_t* rp = (const bf16_t*)res;
                u32x4 rv[4][2];
#pragma unroll
                for (int m = 0; m < 4; ++m)
#pragma unroll
                    for (int bj = 0; bj < 2; ++bj) rv[m][bj] = *(const u32x4*)(rp + (size_t)(row0 + ai * HALF + m * 16) * 1024 + col0 + bj * HALF);
#pragma unroll
                for (int m = 0; m < 4; ++m) {
                    const size_t off = (size_t)(row0 + ai * HALF + m * 16) * 1024 + col0; float s = 0.f;
#pragma unroll
                    for (int bj = 0; bj < 2; ++bj) {
                        const u32x4 r = rv[m][bj];
                        const f32x4 ra = {__uint_as_float(r.x << 16), __uint_as_float(r.x & 0xffff0000u), __uint_as_float(r.y << 16), __uint_as_float(r.y & 0xffff0000u)};
                        const f32x4 rb = {__uint_as_float(r.z << 16), __uint_as_float(r.z & 0xffff0000u), __uint_as_float(r.w << 16), __uint_as_float(r.w & 0xffff0000u)};
                        const f32x4 a = ra + acc[ai][bj][m][0] * scale, b = rb + acc[ai][bj][m][1] * scale;
                        s += (a[0] * a[0] + a[1] * a[1]) + (a[2] * a[2] + a[3] * a[3]) + (b[0] * b[0] + b[1] * b[1]) + (b[2] * b[2] + b[3] * b[3]);
                        u32x4 w; w.x = cvt_pk_bf16(a[0], a[1]); w.y = cvt_pk_bf16(a[2], a[3]); w.z = cvt_pk_bf16(b[0], b[1]); w.w = cvt_pk_bf16(b[2], b[3]);
                        *(u32x4*)(out + off + bj * HALF) = w;
                    }
                    s += __shfl_xor(s, 16); s += __shfl_xor(s, 32); srow[m] = s;
                }
                asm volatile("" ::: "memory");
            }
            if (ssacc) {
                const float v = fq == 0 ? srow[0] : fq == 1 ? srow[1] : fq == 2 ? srow[2] : srow[3];
                atomicAdd(ssacc + u.pm * BM + ai * HALF + wr * 64 + fq * 16 + fr, v);
            }
        }
    }
};
struct EpiIn {
    static constexpr bool PERM = true, AFTER_DRAIN = false;
    bf16_t *Q, *K, *V, *GB, *U;
    const float* ss; const float* qg; const float* kg; float qscale;
    __device__ __forceinline__ void operator()(const f32x4 (&acc)[2][2][4][2], const Unit& u, int wr, int wc, int fr, int fq) const {
        const int row0 = u.pm * BM + wr * 64 + fr; const int pn = u.pn;
        if (pn < 4) {
            bf16_t* dst = (pn < 2 ? Q : K) + (size_t)(64 * (4 * (pn & 1) + wc)) + 8 * fq;
            const float* gp = (pn < 2 ? qg : kg) + 8 * fq; const float sc = pn < 2 ? qscale : 1.0f;
            f32x4 gv[2][2];
#pragma unroll
            for (int bj = 0; bj < 2; ++bj)
#pragma unroll
                for (int n = 0; n < 2; ++n) gv[bj][n] = *(const f32x4*)(gp + 32 * bj + 4 * n) * sc;
#pragma unroll
            for (int ai = 0; ai < 2; ++ai)
#pragma unroll
                for (int m = 0; m < 4; ++m) {
                    const int row = row0 + ai * HALF + m * 16;
                    const float rs = __builtin_amdgcn_rsqf(ss[row] * (1.0f / 1024.0f) + NORM_EPS);
                    f32x4 t[2][2]; float s = 0.f;
#pragma unroll
                    for (int bj = 0; bj < 2; ++bj)
#pragma unroll
                        for (int n = 0; n < 2; ++n) { t[bj][n] = acc[ai][bj][m][n] * rs; const f32x4 x = t[bj][n]; s += (x[0] * x[0] + x[1] * x[1]) + (x[2] * x[2] + x[3] * x[3]); }
                    s += __shfl_xor(s, 16); s += __shfl_xor(s, 32);
                    const float rn = __builtin_amdgcn_rsqf(s * (1.0f / 64.0f) + NORM_EPS);
#pragma unroll
                    for (int bj = 0; bj < 2; ++bj) {
                        const f32x4 a = t[bj][0] * rn * gv[bj][0], b = t[bj][1] * rn * gv[bj][1];
                        u32x4 w; w.x = cvt_pk_bf16(a[0], a[1]); w.y = cvt_pk_bf16(a[2], a[3]); w.z = cvt_pk_bf16(b[0], b[1]); w.w = cvt_pk_bf16(b[2], b[3]);
                        *(u32x4*)(dst + (size_t)row * 512 + 32 * bj) = w;
                    }
                }
        } else if (pn < 8) {
            bf16_t* dst = (pn < 6 ? V : GB) + (size_t)(256 * (pn & 1) + wc * 32 + 8 * fq);
#pragma unroll
            for (int ai = 0; ai < 2; ++ai)
#pragma unroll
                for (int m = 0; m < 4; ++m) {
                    const int row = row0 + ai * HALF + m * 16;
                    const float rs = __builtin_amdgcn_rsqf(ss[row] * (1.0f / 1024.0f) + NORM_EPS);
#pragma unroll
                    for (int bj = 0; bj < 2; ++bj) {
                        const f32x4 a = acc[ai][bj][m][0] * rs, b = acc[ai][bj][m][1] * rs;
                        u32x4 w; w.x = cvt_pk_bf16(a[0], a[1]); w.y = cvt_pk_bf16(a[2], a[3]); w.z = cvt_pk_bf16(b[0], b[1]); w.w = cvt_pk_bf16(b[2], b[3]);
                        *(u32x4*)(dst + (size_t)row * 512 + HALF * bj) = w;
                    }
                }
        } else {
            bf16_t* dst = U + (size_t)(128 * (pn - 8) + wc * 32 + 8 * fq);
#pragma unroll
            for (int ai = 0; ai < 2; ++ai)
#pragma unroll
                for (int m = 0; m < 4; ++m) {
                    const int row = row0 + ai * HALF + m * 16;
                    const float rs = __builtin_amdgcn_rsqf(ss[row] * (1.0f / 1024.0f) + NORM_EPS); const float rs2 = rs * rs;
                    const f32x4 a = acc[ai][0][m][0] * acc[ai][1][m][0] * rs2, b = acc[ai][0][m][1] * acc[ai][1][m][1] * rs2;
                    u32x4 w; w.x = cvt_pk_bf16(a[0], a[1]); w.y = cvt_pk_bf16(a[2], a[3]); w.z = cvt_pk_bf16(b[0], b[1]); w.w = cvt_pk_bf16(b[2], b[3]);
                    *(u32x4*)(dst + (size_t)row * 512) = w;
                }
        }
    }
};

template <class Epi, class Sched, bool ALIGN_EPI = false, bool SP2 = false>
__device__ __forceinline__ void gemm_phase(PG8_LAS unsigned char* lds, const Gemm g, const Sched& S, const Epi& E) {
    const int tid = threadIdx.x, wid = __builtin_amdgcn_readfirstlane(tid >> 6), lane = tid & 63, wr = wid >> 2, wc = wid & 3, fr = lane & 15, fq = lane >> 4;
    const int K = g.K, nt = K / BK;
    unsigned voffA[2], voffB[2];
#pragma unroll
    for (int i = 0; i < 2; ++i) { int R, C; stage_rc(tid * 16 + i * 8192, R, C); const int Rb = Epi::PERM ? ((R & ~31) + perm32(R & 31)) : R;
        voffA[i] = (unsigned)(R * K + C) * 2u; voffB[i] = (unsigned)(Rb * K + C) * 2u; }
    const size_t kstep = (size_t)(BK * 2);
    const size_t hstep = (size_t)HALF * K * 2;
    const size_t tstep = 2 * hstep;
    const unsigned ldsw = (unsigned)wid * 1024u;
    const int aoff = lds_byte(wr * 64 + fr, fq * 8), boff = lds_byte(wc * 32 + fr, fq * 8);
#define PG8_SA(b, h) (((b) * 2 + (h)) * HTB)
#define PG8_SB(b, h) ((4 + (b) * 2 + (h)) * HTB)
#define PG8_STAGE(bufoff, gbase, voff) do { _Pragma("unroll") for (int _i = 0; _i < 2; ++_i) \
        __builtin_amdgcn_global_load_lds((const unsigned*)((const char*)(gbase) + (voff)[_i]), (PG8_LAS unsigned*)(lds + (bufoff) + ldsw + _i * 8192), 16, 0, 0); } while (0)
#define PG8_LDA(dst, b, h) do { _Pragma("unroll") for (int m = 0; m < 4; ++m) _Pragma("unroll") for (int k = 0; k < 2; ++k) dst[m][k] = *(const PG8_LAS bf16x8*)(lds + PG8_SA(b, h) + aoff + m * 2048 + k * 1024); } while (0)
#define PG8_LDB(dst, b, h) do { _Pragma("unroll") for (int n = 0; n < 2; ++n) _Pragma("unroll") for (int k = 0; k < 2; ++k) dst[n][k] = *(const PG8_LAS bf16x8*)(lds + PG8_SB(b, h) + boff + n * 2048 + k * 1024); } while (0)
#define PG8_MMA(ai, bj, At, Bt) do { __builtin_amdgcn_s_setprio(1); _Pragma("unroll") for (int m = 0; m < 4; ++m) _Pragma("unroll") for (int n = 0; n < 2; ++n) _Pragma("unroll") for (int k = 0; k < 2; ++k) \
        acc[ai][bj][m][n] = __builtin_amdgcn_mfma_f32_16x16x32_bf16(Bt[n][k], At[m][k], acc[ai][bj][m][n], 0, 0, 0); __builtin_amdgcn_s_setprio(0); } while (0)
#define PG8_WAIT_V(n) asm volatile("s_waitcnt vmcnt(" #n ")" ::: "memory")
#define PG8_WAIT_L(n) asm volatile("s_waitcnt lgkmcnt(" #n ")" ::: "memory")
#define PG8_BAR __builtin_amdgcn_s_barrier()
#define PG8_SCHED __builtin_amdgcn_sched_barrier(0)
    Unit cur, nxt; int ui = 0;
    if (!S.next(0, cur)) return;
    f32x4 acc[2][2][4][2];
#pragma unroll
    for (int a = 0; a < 2; ++a)
#pragma unroll
        for (int b = 0; b < 2; ++b)
#pragma unroll
            for (int m = 0; m < 4; ++m)
#pragma unroll
                for (int n = 0; n < 2; ++n) acc[a][b][m][n] = (f32x4){0.f, 0.f, 0.f, 0.f};
    bf16x8 At[4][2], B0[2][2], B1[2][2];
    const char* cA = (const char*)g.A + (size_t)cur.pm * tstep; const char* cB = (const char*)g.Bt + (size_t)cur.pn * tstep;
    S.a_ready(cur);
    if constexpr (SP2) {
        PG8_STAGE(PG8_SB(0, 0), cB, voffB); PG8_STAGE(PG8_SB(0, 1), cB + hstep, voffB); PG8_STAGE(PG8_SA(0, 0), cA, voffA); PG8_STAGE(PG8_SA(0, 1), cA + hstep, voffA);
        if (wr == 1) PG8_BAR;
        PG8_WAIT_V(2); PG8_BAR;
        PG8_STAGE(PG8_SB(1, 0), cB + kstep, voffB); PG8_STAGE(PG8_SA(1, 0), cA + kstep, voffA); PG8_STAGE(PG8_SB(1, 1), cB + hstep + kstep, voffB);
        PG8_WAIT_V(6); PG8_BAR;
    } else {
        PG8_STAGE(PG8_SB(0, 0), cB, voffB); PG8_STAGE(PG8_SA(0, 0), cA, voffA); PG8_STAGE(PG8_SB(0, 1), cB + hstep, voffB); PG8_STAGE(PG8_SA(0, 1), cA + hstep, voffA);
        if (wr == 1) PG8_BAR;
        PG8_WAIT_V(4); PG8_BAR;
        PG8_STAGE(PG8_SB(1, 0), cB + kstep, voffB); PG8_STAGE(PG8_SA(1, 0), cA + kstep, voffA); PG8_STAGE(PG8_SB(1, 1), cB + hstep + kstep, voffB);
        PG8_WAIT_V(6); PG8_BAR;
    }
    for (;;) {
        const bool has_next = S.next(ui + 1, nxt);
        const char* nA = has_next ? (const char*)g.A + (size_t)nxt.pm * tstep : cA; const char* nB = has_next ? (const char*)g.Bt + (size_t)nxt.pn * tstep : cB;
        for (int t = 0; t < nt; t += 2) {
            const bool last = (t == nt - 2);
            const char* a1 = cA + (size_t)(t + 1) * kstep;
            const char* a2 = last ? nA : cA + (size_t)(t + 2) * kstep; const char* b2 = last ? nB : cB + (size_t)(t + 2) * kstep;
            const char* a3 = a2 + kstep; const char* b3 = b2 + kstep;
            if (last && has_next) S.a_ready(nxt);
            if constexpr (SP2) {
            PG8_LDB(B0, 0, 0); PG8_LDB(B1, 0, 1); PG8_SCHED; PG8_LDA(At, 0, 0); PG8_STAGE(PG8_SA(1, 1), a1 + hstep, voffA);
            PG8_WAIT_V(8); PG8_WAIT_L(0); PG8_BAR; PG8_MMA(0, 0, At, B0); PG8_MMA(0, 1, At, B1); PG8_BAR; PG8_SCHED;
            PG8_LDA(At, 0, 1); PG8_STAGE(PG8_SB(0, 0), b2, voffB); PG8_STAGE(PG8_SB(0, 1), b2 + hstep, voffB); PG8_STAGE(PG8_SA(0, 0), a2, voffA);
            PG8_WAIT_V(8); PG8_WAIT_L(0); PG8_BAR; PG8_MMA(1, 0, At, B0); PG8_MMA(1, 1, At, B1); PG8_BAR; PG8_SCHED;
            PG8_LDB(B0, 1, 0); PG8_LDB(B1, 1, 1); PG8_SCHED; PG8_LDA(At, 1, 0); PG8_STAGE(PG8_SA(0, 1), a2 + hstep, voffA);
            PG8_WAIT_V(8); PG8_WAIT_L(0); PG8_BAR; PG8_MMA(0, 0, At, B0); PG8_MMA(0, 1, At, B1); PG8_BAR; PG8_SCHED;
            PG8_LDA(At, 1, 1); PG8_STAGE(PG8_SB(1, 0), b3, voffB); PG8_STAGE(PG8_SB(1, 1), b3 + hstep, voffB); PG8_STAGE(PG8_SA(1, 0), a3, voffA);
            PG8_WAIT_V(8); PG8_WAIT_L(0); PG8_BAR; PG8_MMA(1, 0, At, B0); PG8_MMA(1, 1, At, B1); PG8_BAR; PG8_SCHED;
            } else {
            PG8_LDB(B0, 0, 0); PG8_SCHED; PG8_LDA(At, 0, 0); PG8_STAGE(PG8_SA(1, 1), a1 + hstep, voffA);
            PG8_WAIT_L(8); PG8_BAR; PG8_WAIT_L(0); PG8_MMA(0, 0, At, B0); PG8_BAR; PG8_SCHED;
            PG8_LDB(B1, 0, 1); PG8_STAGE(PG8_SB(0, 0), b2, voffB);
            PG8_BAR; PG8_WAIT_L(0); PG8_MMA(0, 1, At, B1); PG8_BAR;
            PG8_LDA(At, 0, 1); PG8_STAGE(PG8_SA(0, 0), a2, voffA);
            PG8_BAR; PG8_WAIT_L(0); PG8_MMA(1, 0, At, B0); PG8_BAR; PG8_SCHED;
            PG8_STAGE(PG8_SB(0, 1), b2 + hstep, voffB);
            PG8_WAIT_V(6); PG8_BAR; PG8_MMA(1, 1, At, B1); PG8_BAR;
            PG8_LDB(B0, 1, 0); PG8_SCHED; PG8_LDA(At, 1, 0); PG8_STAGE(PG8_SA(0, 1), a2 + hstep, voffA);
            PG8_WAIT_L(8); PG8_BAR; PG8_WAIT_L(0); PG8_MMA(0, 0, At, B0); PG8_BAR; PG8_SCHED;
            PG8_LDB(B1, 1, 1); PG8_STAGE(PG8_SB(1, 0), b3, voffB);
            PG8_BAR; PG8_WAIT_L(0); PG8_MMA(0, 1, At, B1); PG8_BAR;
            PG8_LDA(At, 1, 1); PG8_STAGE(PG8_SA(1, 0), a3, voffA);
            PG8_BAR; PG8_WAIT_L(0); PG8_MMA(1, 0, At, B0); PG8_BAR; PG8_SCHED;
            PG8_STAGE(PG8_SB(1, 1), b3 + hstep, voffB);
            PG8_WAIT_V(6); PG8_BAR; PG8_MMA(1, 1, At, B1); PG8_BAR;
            }
        }
        if constexpr (ALIGN_EPI) { if (wr == 0) PG8_BAR; }
        if constexpr (!Epi::AFTER_DRAIN) { E(acc, cur, wr, wc, fr, fq); S.done(cur); }
        if (!has_next) break;
#pragma unroll
        for (int a = 0; a < 2; ++a)
#pragma unroll
            for (int b = 0; b < 2; ++b)
#pragma unroll
                for (int m = 0; m < 4; ++m)
#pragma unroll
                    for (int n = 0; n < 2; ++n) acc[a][b][m][n] = (f32x4){0.f, 0.f, 0.f, 0.f};
        cur = nxt; cA = nA; cB = nB; ++ui;
        if constexpr (ALIGN_EPI) { if (wr == 1) PG8_BAR; }
    }
    PG8_WAIT_V(0);
    if constexpr (!ALIGN_EPI) { if (wr == 0) PG8_BAR; }
    PG8_BAR;
    if constexpr (Epi::AFTER_DRAIN) { E.fused(acc, cur, wr, wc, fr, fq, lds, wid, lane); S.done(cur); }
#undef PG8_SA
#undef PG8_SB
#undef PG8_STAGE
#undef PG8_LDA
#undef PG8_LDB
#undef PG8_MMA
#undef PG8_WAIT_V
#undef PG8_WAIT_L
#undef PG8_BAR
#undef PG8_SCHED
}
}

#ifndef PG8_SP2
#define PG8_SP2 true
#endif
#ifndef PG8_ALIGN
#define PG8_ALIGN true
#endif
#define GAS __attribute__((address_space(1)))
#define LAS __attribute__((address_space(3)))
typedef unsigned short bf16;
typedef unsigned v4u __attribute__((ext_vector_type(4)));
typedef float f32x4 __attribute__((ext_vector_type(4)));
typedef short bf16x8 __attribute__((ext_vector_type(8)));
typedef GAS unsigned gu32;
typedef GAS unsigned long long gu64;
#define RLX_AGENT __ATOMIC_RELAXED, __HIP_MEMORY_SCOPE_AGENT
#define LDS_WAIT() asm volatile("s_waitcnt lgkmcnt(0)" ::: "memory")
#define VM_WAIT() asm volatile("s_waitcnt vmcnt(0)" ::: "memory")
__device__ __forceinline__ unsigned long long rt() { return __builtin_amdgcn_s_memrealtime(); }
__device__ __forceinline__ unsigned f2bf(float f) { unsigned u = __builtin_bit_cast(unsigned, f); return (u + 0x7fffu + ((u >> 16) & 1u)) >> 16; }
__device__ __forceinline__ unsigned pk2(float lo, float hi) { return f2bf(lo) | (f2bf(hi) << 16); }

#define XB_TMO      128
#define XB_XCNT(j)  (256  + 64 * (j))
#define XB_XSUB(j)  (1280 + 64 * (j))
#define XB_XGEN(j)  (2304 + 64 * (j))
#define XB_TOP      3328
#define XB_TOPGEN   3392
#define XCD_BAR_WORDS 3456
#define XB_SPIN_CAP (1u << 18)

__device__ __forceinline__ unsigned xb_ld(unsigned* p)              { return __hip_atomic_load(p, __ATOMIC_RELAXED, __HIP_MEMORY_SCOPE_AGENT); }
__device__ __forceinline__ unsigned xb_add(unsigned* p, unsigned v) { return __hip_atomic_fetch_add(p, v, __ATOMIC_RELAXED, __HIP_MEMORY_SCOPE_AGENT); }
__device__ __forceinline__ unsigned xb_xcc_id() { return (unsigned)__builtin_amdgcn_s_getreg((3 << 11) | 20) & 0xFu; }
#define XB_SPIN(cond, bar) do { unsigned _sp = 0; while (cond) { __builtin_amdgcn_s_sleep(1); \
    if ((++_sp & 255u) == 0u) { if (xb_ld(&(bar)[XB_TMO])) break; if (_sp > XB_SPIN_CAP) { atomicAdd(&(bar)[XB_TMO], 1u); break; } } } } while (0)

struct XcdBarrier {
    unsigned* bar; unsigned x;
    volatile LAS unsigned* st;
};

__device__ __forceinline__ XcdBarrier xcd_barrier_post(unsigned* bar, volatile LAS unsigned* st) {
    XcdBarrier b; b.bar = bar; b.x = xb_xcc_id(); b.st = st;
    if (threadIdx.x == 0) (void)xb_add(&bar[XB_XCNT(b.x)], 1u);
    return b;
}
__device__ __forceinline__ void xcd_barrier_complete(unsigned* bar, unsigned x, unsigned& nloc, unsigned& nx) {
    const unsigned G = gridDim.x * gridDim.y * gridDim.z;
    unsigned sum, cnt, mine, sp = 0u;
    for (;;) {
        sum = 0u; cnt = 0u; mine = 0u;
#pragma unroll
        for (unsigned j = 0; j < 16; ++j) { const unsigned c = xb_ld(&bar[XB_XCNT(j)]); sum += c; cnt += (c > 0u) ? 1u : 0u; mine = (j == x) ? c : mine; }
        if (sum == G) break;
        __builtin_amdgcn_s_sleep(1);
        if ((++sp & 255u) == 0u) { if (xb_ld(&bar[XB_TMO])) break; if (sp > XB_SPIN_CAP) { atomicAdd(&bar[XB_TMO], 1u); break; } }
    }
    nloc = mine > 0u ? mine : 1u; nx = cnt > 0u ? cnt : 1u;
}

__device__ __forceinline__ void xcd_barrier(const XcdBarrier& b) {
    asm volatile("s_waitcnt vmcnt(0)" ::: "memory");
    __syncthreads();
    if (threadIdx.x == 0) {
        unsigned* bar = b.bar;
        __builtin_amdgcn_s_waitcnt(0);
        unsigned nloc = b.st[0], nx = b.st[1];
        if (nloc == 0u) { xcd_barrier_complete(bar, b.x, nloc, nx); b.st[0] = nloc; b.st[1] = nx; }
        const unsigned old = xb_add(&bar[XB_XSUB(b.x)], 1u);
        const unsigned gen = old / nloc;
        if (old + 1u == (gen + 1u) * nloc) {
            __builtin_amdgcn_fence(__ATOMIC_RELEASE, "agent");
            asm volatile("s_waitcnt vmcnt(0)" ::: "memory");
            const unsigned og = xb_add(&bar[XB_TOP], 1u);
            const unsigned tg = og / nx;
            if (og + 1u == (tg + 1u) * nx) xb_add(&bar[XB_TOPGEN], 1u);
            else XB_SPIN(xb_ld(&bar[XB_TOPGEN]) == tg, bar);
            __builtin_amdgcn_fence(__ATOMIC_ACQUIRE, "agent");
            xb_add(&bar[XB_XGEN(b.x)], 1u);
            asm volatile("s_waitcnt vmcnt(0)" ::: "memory");
        } else {
            XB_SPIN(xb_ld(&bar[XB_XGEN(b.x)]) == gen, bar);
            __builtin_amdgcn_fence(__ATOMIC_ACQUIRE, "agent");
            asm volatile("s_waitcnt vmcnt(0)" ::: "memory");
        }
    }
    __syncthreads();
}

constexpr int NWAVES = 8;
constexpr int BATCH = 8, SEQ = 4096, D = 1024, FF = 2816, NIN = 3072, NH = 4;
constexpr int M = BATCH * SEQ;
constexpr float EPS = 1e-6f;
constexpr float LAM_INIT = 0.2f;
constexpr float LOG2E = 1.4426950408889634f;

constexpr size_t MiB = 1u << 20;
constexpr size_t WS_CTL = 0, CTL_ZERO_BYTES = 1 * MiB;
constexpr size_t WS_SS = 1 * MiB;
constexpr size_t WS_WGU1 = 2 * MiB, WS_WD1 = 13 * MiB, WS_WIN = 19 * MiB, WS_WOUT = 25 * MiB, WS_WGU2 = 27 * MiB, WS_WD2 = 38 * MiB;
constexpr size_t WS_XB = 48 * MiB;
constexpr size_t WS_H = 112 * MiB;
constexpr size_t WS_Q = WS_H, WS_K = WS_H + 32 * MiB, WS_V = WS_H + 64 * MiB, WS_GB = WS_H + 96 * MiB, WS_U = WS_H + 128 * MiB;
constexpr size_t WS_MIX = 288 * MiB;
constexpr size_t WS_O = 352 * MiB;
constexpr size_t WS_END = 416 * MiB;
static_assert(WS_WD2 + (size_t)D * FF * 2 <= WS_XB && WS_U + (size_t)M * 512 * 2 <= WS_H + (size_t)M * FF * 2 && WS_H + (size_t)M * FF * 2 <= WS_MIX, "d_ws map");
constexpr int CW_TMO = 0, CW_CODE = 1, CW_BAR = 4096;

constexpr int RING_OFF = 0, RING_BYTES = 131072;
constexpr int LDSCTL_OFF = RING_BYTES, MISC_OFF = LDSCTL_OFF + 320;
constexpr int LDS_BYTES = 147456;
static_assert(MISC_OFF + 128 <= LDS_BYTES, "LDS map");

typedef unsigned u32x4 __attribute__((ext_vector_type(4)));
typedef float f32x16 __attribute__((ext_vector_type(16)));
typedef short s16x4 __attribute__((ext_vector_type(4)));

struct Frame {
    LAS unsigned char* lds;
    volatile LAS unsigned* MISC;
    gu32* ctl;
    int tid, lane, wave, vcu, G;
};

__device__ __forceinline__ float wave_sum(float v) {
#pragma unroll
    for (int o = 1; o < 64; o <<= 1) v += __shfl_xor(v, o);
    return v;
}

__device__ __forceinline__ void transpose_item(const float* W, int srcN, int s0, int k0, const float* gain, bf16* WT, int K, int n0, LAS float* scr, int lane) {
#pragma unroll 8
    for (int i = 0; i < 32; ++i) { const int kk = 2 * i + (lane >> 5); float v = W[(size_t)(k0 + kk) * srcN + s0 + (lane & 31)]; if (gain) v *= gain[k0 + kk]; scr[kk * 33 + (lane & 31)] = v; }
    LDS_WAIT(); asm volatile("" ::: "memory");
    const int c = lane & 7;
#pragma unroll
    for (int j = 0; j < 4; ++j) { const int n = (lane >> 3) + 8 * j; const LAS float* s = scr + (8 * c) * 33 + n;
        v4u o; o.x = pk2(s[0 * 33], s[1 * 33]); o.y = pk2(s[2 * 33], s[3 * 33]); o.z = pk2(s[4 * 33], s[5 * 33]); o.w = pk2(s[6 * 33], s[7 * 33]);
        *(GAS v4u*)(WT + (size_t)(n0 + n) * K + k0 + 8 * c) = o; }
    LDS_WAIT(); asm volatile("" ::: "memory");
}
struct Args { const float* in[22]; float* out; unsigned char* ws; int ph_lo, ph_hi; };

__device__ __forceinline__ void p0_prologue(Frame& F, const Args& A) {
    LAS float* scr = (LAS float*)(F.lds + RING_OFF + F.wave * 16384);
    const int gw = F.vcu * NWAVES + F.wave, NGW = F.G * NWAVES;
    unsigned char* ws = A.ws;
    constexpr int I_GU = (D / 64) * (2 * FF / 32), I_DN = (FF / 64) * (D / 32), I_IN = (D / 64) * (NIN / 32), I_OUT = (D / 64) * (D / 32);
    constexpr int NITEMS = 2 * I_GU + 2 * I_DN + I_IN + I_OUT;
    for (int it = gw; it < NITEMS; it += NGW) {
        int r = it;
        if (r < 2 * I_GU) {
            const int l = r >= I_GU; if (l) r -= I_GU;
            constexpr int nblk = 2 * FF / 32; const int kb = r / nblk, nb = r % nblk, n0 = 32 * nb;
            const int pn = n0 >> 8, half = (n0 >> 7) & 1, j = n0 & 127;
            const float* W = A.in[l ? (half ? 19 : 18) : (half ? 3 : 2)];
            transpose_item(W, FF, 128 * pn + j, 64 * kb, A.in[l ? 17 : 1], (bf16*)(ws + (l ? WS_WGU2 : WS_WGU1)), D, n0, scr, F.lane);
            continue;
        }
        r -= 2 * I_GU;
        if (r < 2 * I_DN) {
            const int l = r >= I_DN; if (l) r -= I_DN;
            constexpr int nblk = D / 32; const int kb = r / nblk, nb = r % nblk;
            transpose_item(A.in[l ? 20 : 4], D, 32 * nb, 64 * kb, nullptr, (bf16*)(ws + (l ? WS_WD2 : WS_WD1)), FF, 32 * nb, scr, F.lane);
            continue;
        }
        r -= 2 * I_DN;
        if (r < I_IN) {
            constexpr int nblk = NIN / 32; const int kb = r / nblk, nb = r % nblk, n0 = 32 * nb;
            const int pn = n0 >> 8, half = (n0 >> 7) & 1, j = n0 & 127;
            int s0;
            if (pn < 4) s0 = (pn >> 1) * 512 + 64 * (4 * (pn & 1) + (j >> 5)) + 32 * half;
            else if (pn < 8) s0 = n0;
            else s0 = (half ? 2560 : 2048) + 128 * (pn - 8) + j;
            transpose_item(A.in[6], NIN, s0, 64 * kb, A.in[5], (bf16*)(ws + WS_WIN), D, n0, scr, F.lane);
            continue;
        }
        r -= I_IN;
        { constexpr int nblk = D / 32; const int kb = r / nblk, nb = r % nblk;
          transpose_item(A.in[16], D, 32 * nb, 64 * kb, nullptr, (bf16*)(ws + WS_WOUT), D, 32 * nb, scr, F.lane); }
    }
    const float* x = A.in[0]; bf16* xb = (bf16*)(ws + WS_XB); float* ss = (float*)(ws + WS_SS);
    for (int m = gw; m < M; m += NGW) {
        const GAS f32x4* xr = (const GAS f32x4*)(x + (size_t)m * D) + F.lane;
        f32x4 v[4]; float s = 0.f;
#pragma unroll
        for (int j = 0; j < 4; ++j) { v[j] = xr[64 * j]; s += (v[j].x * v[j].x + v[j].y * v[j].y) + (v[j].z * v[j].z + v[j].w * v[j].w); }
        s = wave_sum(s);
        GAS unsigned long long* o8 = (GAS unsigned long long*)(xb + (size_t)m * D) + F.lane;
#pragma unroll
        for (int j = 0; j < 4; ++j) o8[64 * j] = (unsigned long long)pk2(v[j].x, v[j].y) | ((unsigned long long)pk2(v[j].z, v[j].w) << 32);
        if (F.lane == 0) { ss[m] = s; ss[M + m] = 0.f; ss[2 * M + m] = 0.f; }
    }
}

namespace att {
constexpr int SLOT = 24576;
constexpr int L_KV = 0, L_WS = 2 * SLOT, L_Q = L_WS + 4096, L_END = L_Q + 32768;
static_assert(L_END <= RING_BYTES, "attention LDS");
constexpr float THR = 8.0f;
__device__ __forceinline__ int crow(int r, int hi) { return (r & 3) + 8 * (r >> 2) + 4 * hi; }
typedef __bf16 bf16x2_t __attribute__((ext_vector_type(2))); typedef float f32x2_t __attribute__((ext_vector_type(2)));
__device__ __forceinline__ unsigned cvtpk(float lo, float hi) { f32x2_t v = {lo, hi}; bf16x2_t b = __builtin_convertvector(v, bf16x2_t); return __builtin_bit_cast(unsigned, b); }
typedef short v4i16_t __attribute__((ext_vector_type(4)));
__device__ __forceinline__ s16x4 vtr(LAS const unsigned char* p) { return __builtin_bit_cast(s16x4, __builtin_amdgcn_ds_read_tr16_b64_v4i16((LAS v4i16_t*)p)); }
#define MX3(a, b, c) __builtin_fmaxf(__builtin_fmaxf((a), (b)), (c))

__device__ __forceinline__ void attn_unit(int b, int h, int mc, int qb, const bf16* Qg, const bf16* Kg, const bf16* Vg, bf16* OB, LAS unsigned char* shm) {
    const int tid = threadIdx.x, lane = tid & 63, r32 = lane & 31, hi = lane >> 5; const int wid = __builtin_amdgcn_readfirstlane(tid >> 6);
    const size_t rowbase = (size_t)b * SEQ; const int q0 = qb * 256;
    const float sl2 = LOG2E * __builtin_amdgcn_exp2f(-2.0f * (float)(h + 1));
    LAS float* wsf = (LAS float*)(shm + L_WS) + wid * 128;
    LAS unsigned char* Qf = shm + L_Q + wid * 4096;
    const int NT = (q0 + 256) / 64;
    const bf16* ksrc = Kg + (rowbase + lane) * 512 + h * 128 + mc * 64 + wid * 8;
    const int vp0 = wid * 2, vp1 = wid * 2 + 1;
    const bf16* vsrc0 = Vg + (rowbase + 16 * (vp0 & 3) + (lane >> 2)) * 512 + h * 128 + (vp0 >> 2) * 32 + (lane & 3) * 8;
    const bf16* vsrc1 = Vg + (rowbase + 16 * (vp1 & 3) + (lane >> 2)) * 512 + h * 128 + (vp1 >> 2) * 32 + (lane & 3) * 8;
#define ATT_DMA(t, slot) do { const size_t go_ = (size_t)(t) * 64 * 512; LAS unsigned char* sb_ = shm + L_KV + (slot) * SLOT; \
        __builtin_amdgcn_global_load_lds((const unsigned*)(ksrc + go_), (LAS unsigned*)(sb_ + wid * 1024), 16, 0, 0); \
        __builtin_amdgcn_global_load_lds((const unsigned*)(vsrc0 + go_), (LAS unsigned*)(sb_ + 8192 + vp0 * 1024), 16, 0, 0); \
        __builtin_amdgcn_global_load_lds((const unsigned*)(vsrc1 + go_), (LAS unsigned*)(sb_ + 8192 + vp1 * 1024), 16, 0, 0); } while (0)
    __syncthreads();
    ATT_DMA(NT - 1, 0);
    {
        const bf16* qp = Qg + (rowbase + q0 + wid * 32 + r32) * 512 + h * 128 + mc * 64 + hi * 8;
#pragma unroll
        for (int d0 = 0; d0 < 4; ++d0) *(LAS u32x4*)(Qf + d0 * 1024 + lane * 16) = *(const GAS u32x4*)(qp + d0 * 16);
    }
    f32x16 o[4];
#pragma unroll
    for (int d = 0; d < 4; ++d)
#pragma unroll
        for (int r = 0; r < 16; ++r) o[d][r] = 0.f;
    float mhat = 0.f, lrun = 0.f;
    const int irel = wid * 32 + r32;
    f32x16 cb;
#pragma unroll
    for (int r = 0; r < 16; ++r) cb[r] = sl2 * (float)(crow(r, hi) - irel);
    const LAS unsigned char* vbl = (const LAS unsigned char*)shm + L_KV + 8192 + ((lane >> 4) & 1) * 32 + (lane & 3) * 8 + (4 * hi + ((lane & 15) >> 2)) * 64;
    const LAS unsigned char* kbl = (const LAS unsigned char*)shm + L_KV + hi * 1024 + r32 * 16;
    for (int it = 0; it < NT; ++it) {
        const int t = NT - 1 - it, slot = it & 1;
        asm volatile("s_waitcnt vmcnt(0)" ::: "memory");
        __syncthreads();
        if (it + 1 < NT) ATT_DMA(t - 1, slot ^ 1);
        const int jb = t - (NT - 4);
        if (jb >= 0 && 64 * jb > 32 * wid + 31) continue;
        const float at = sl2 * (float)(64 * t - q0) - mhat, at1 = at + 32.0f * sl2;
        f32x16 p0, p1;
#pragma unroll
        for (int r = 0; r < 16; ++r) { p0[r] = cb[r] + at; p1[r] = cb[r] + at1; }
        const LAS unsigned char* kb = kbl + slot * SLOT;
#pragma unroll
        for (int d0 = 0; d0 < 4; ++d0) {
            const bf16x8 qf = *(LAS const bf16x8*)(Qf + d0 * 1024 + lane * 16);
            const bf16x8 b0 = *(LAS const bf16x8*)(kb + d0 * 2048), b1 = *(LAS const bf16x8*)(kb + d0 * 2048 + 512);
            p0 = __builtin_amdgcn_mfma_f32_32x32x16_bf16(b0, qf, p0, 0, 0, 0);
            p1 = __builtin_amdgcn_mfma_f32_32x32x16_bf16(b1, qf, p1, 0, 0, 0);
        }
        if (jb >= 0) {
            const int kb0 = 64 * jb + 4 * hi;
#pragma unroll
            for (int r = 0; r < 16; ++r) { const int kv = kb0 + (r & 3) + 8 * (r >> 2); if (kv > irel) p0[r] = -INFINITY; if (kv + 32 > irel) p1[r] = -INFINITY; }
        }
        float ra = MX3(p0[0], p0[1], p1[0]), rb = MX3(p0[2], p0[3], p1[1]); ra = MX3(ra, p1[2], p1[3]);
#pragma unroll
        for (int r = 4; r < 16; r += 4) { ra = MX3(ra, p0[r], p0[r + 1]); rb = MX3(rb, p0[r + 2], p0[r + 3]); ra = MX3(ra, p1[r], p1[r + 1]); rb = MX3(rb, p1[r + 2], p1[r + 3]); }
        float rm = __builtin_fmaxf(ra, rb); rm = __builtin_fmaxf(rm, __shfl_xor(rm, 32));
        if (__any(rm > THR)) {
            const float dl = __builtin_fmaxf(rm, 0.f); mhat += dl;
#pragma unroll
            for (int r = 0; r < 16; ++r) { p0[r] -= dl; p1[r] -= dl; }
            const float f = __builtin_amdgcn_exp2f(-dl); lrun *= f;
            if (hi == 0) wsf[r32] = f;
            LDS_WAIT(); asm volatile("" ::: "memory");
#pragma unroll
            for (int r = 0; r < 16; ++r) { const float fr_ = wsf[crow(r, hi)];
#pragma unroll
                for (int d = 0; d < 4; ++d) o[d][r] *= fr_; }
            LDS_WAIT(); asm volatile("" ::: "memory");
        }
        float s0 = 0.f, s1 = 0.f;
#pragma unroll
        for (int r = 0; r < 16; ++r) { p0[r] = __builtin_amdgcn_exp2f(p0[r]); p1[r] = __builtin_amdgcn_exp2f(p1[r]); s0 += p0[r]; s1 += p1[r]; }
        lrun += s0 + s1;
        u32x4 pw[4];
        pw[0] = (u32x4){cvtpk(p0[0], p0[1]), cvtpk(p0[2], p0[3]), cvtpk(p0[4], p0[5]), cvtpk(p0[6], p0[7])};
        pw[1] = (u32x4){cvtpk(p0[8], p0[9]), cvtpk(p0[10], p0[11]), cvtpk(p0[12], p0[13]), cvtpk(p0[14], p0[15])};
        pw[2] = (u32x4){cvtpk(p1[0], p1[1]), cvtpk(p1[2], p1[3]), cvtpk(p1[4], p1[5]), cvtpk(p1[6], p1[7])};
        pw[3] = (u32x4){cvtpk(p1[8], p1[9]), cvtpk(p1[10], p1[11]), cvtpk(p1[12], p1[13]), cvtpk(p1[14], p1[15])};
        const LAS unsigned char* vb = vbl + slot * SLOT;
#pragma unroll
        for (int d0 = 0; d0 < 4; ++d0)
#pragma unroll
            for (int ks = 0; ks < 4; ++ks) {
                const s16x4 lo = vtr(vb + d0 * 4096 + ks * 1024), h8 = vtr(vb + d0 * 4096 + ks * 1024 + 512);
                const bf16x8 vf = (bf16x8){lo[0], lo[1], lo[2], lo[3], h8[0], h8[1], h8[2], h8[3]};
                o[d0] = __builtin_amdgcn_mfma_f32_32x32x16_bf16(__builtin_bit_cast(bf16x8, pw[ks]), vf, o[d0], 0, 0, 0);
            }
    }
#undef ATT_DMA
    lrun += __shfl_xor(lrun, 32);
    if (hi == 0) wsf[r32] = 1.0f / lrun;
    LDS_WAIT(); asm volatile("" ::: "memory");
    bf16* op = OB + (rowbase + q0 + wid * 32) * 1024 + h * 256 + mc * 128 + r32;
#pragma unroll
    for (int r = 0; r < 16; ++r) {
        const int cr = crow(r, hi); const float f0 = wsf[cr];
#pragma unroll
        for (int d = 0; d < 4; ++d) op[(size_t)cr * 1024 + 32 * d] = (bf16)f2bf(o[d][r] * f0);
    }
    LDS_WAIT(); asm volatile("" ::: "memory");
}
#undef MX3
}

__device__ __forceinline__ void conv_phase(Frame& F, const bf16* U, const bf16* GB, const float* cw, const float* cn, bf16* MIX) {
    const int gw = F.vcu * NWAVES + F.wave, NGW = F.G * NWAVES; const int ch0 = F.lane * 8;
    float w0[8], w1[8], w2[8], gn[8];
#pragma unroll
    for (int i = 0; i < 8; ++i) { w0[i] = cw[ch0 + i]; w1[i] = cw[512 + ch0 + i]; w2[i] = cw[1024 + ch0 + i]; gn[i] = cn[ch0 + i]; }
    for (int g = gw; g < M / 16; g += NGW) {
        const int t0 = 16 * g;
        float um2[8], um1[8];
        if ((t0 & (SEQ - 1)) == 0) {
#pragma unroll
            for (int i = 0; i < 8; ++i) { um2[i] = 0.f; um1[i] = 0.f; }
        } else {
            const v4u a = *(const GAS v4u*)(U + (size_t)(t0 - 2) * 512 + ch0), b = *(const GAS v4u*)(U + (size_t)(t0 - 1) * 512 + ch0);
#pragma unroll
            for (int i = 0; i < 4; ++i) { um2[2 * i] = __uint_as_float(a[i] << 16); um2[2 * i + 1] = __uint_as_float(a[i] & 0xffff0000u); um1[2 * i] = __uint_as_float(b[i] << 16); um1[2 * i + 1] = __uint_as_float(b[i] & 0xffff0000u); }
        }
        for (int t = t0; t < t0 + 16; ++t) {
            const v4u a = *(const GAS v4u*)(U + (size_t)t * 512 + ch0), b = *(const GAS v4u*)(GB + (size_t)t * 512 + ch0);
            float ut[8], gb[8], c[8]; float s = 0.f;
#pragma unroll
            for (int i = 0; i < 4; ++i) { ut[2 * i] = __uint_as_float(a[i] << 16); ut[2 * i + 1] = __uint_as_float(a[i] & 0xffff0000u); gb[2 * i] = __uint_as_float(b[i] << 16); gb[2 * i + 1] = __uint_as_float(b[i] & 0xffff0000u); }
#pragma unroll
            for (int i = 0; i < 8; ++i) { c[i] = gb[i] * (w0[i] * um2[i] + w1[i] * um1[i] + w2[i] * ut[i]); s += c[i] * c[i]; um2[i] = um1[i]; um1[i] = ut[i]; }
            s += __shfl_xor(s, 1); s += __shfl_xor(s, 2); s += __shfl_xor(s, 4);
            const float rn = __builtin_amdgcn_rsqf(s * (1.0f / 64.0f) + EPS);
            v4u o;
#pragma unroll
            for (int i = 0; i < 4; ++i) o[i] = pk2(c[2 * i] * rn * gn[2 * i], c[2 * i + 1] * rn * gn[2 * i + 1]);
            *(GAS v4u*)(MIX + (size_t)t * 1024 + 512 + ch0) = o;
        }
    }
}

__device__ __forceinline__ void combine_phase(Frame& F, const bf16* OB, const float* subln, float lam, bf16* MIX) {
    const int gw = F.vcu * NWAVES + F.wave, NGW = F.G * NWAVES; const int hh = F.lane >> 4, d0 = 8 * (F.lane & 15);
    float gn[8];
#pragma unroll
    for (int i = 0; i < 8; ++i) gn[i] = subln[d0 + i] * (1.0f - LAM_INIT);
    for (int t = gw; t < M; t += NGW) {
        const v4u a = *(const GAS v4u*)(OB + (size_t)t * 1024 + hh * 256 + d0), b = *(const GAS v4u*)(OB + (size_t)t * 1024 + hh * 256 + 128 + d0);
        float c[8]; float s = 0.f;
#pragma unroll
        for (int i = 0; i < 4; ++i) { c[2 * i] = __uint_as_float(a[i] << 16) - lam * __uint_as_float(b[i] << 16); c[2 * i + 1] = __uint_as_float(a[i] & 0xffff0000u) - lam * __uint_as_float(b[i] & 0xffff0000u); }
#pragma unroll
        for (int i = 0; i < 8; ++i) s += c[i] * c[i];
        s += __shfl_xor(s, 1); s += __shfl_xor(s, 2); s += __shfl_xor(s, 4); s += __shfl_xor(s, 8);
        const float rn = __builtin_amdgcn_rsqf(s * (1.0f / 128.0f) + EPS);
        v4u o;
#pragma unroll
        for (int i = 0; i < 4; ++i) o[i] = pk2(c[2 * i] * rn * gn[2 * i], c[2 * i + 1] * rn * gn[2 * i + 1]);
        *(GAS v4u*)(MIX + (size_t)t * 1024 + hh * 128 + d0) = o;
    }
}

__device__ __forceinline__ void final_norm_phase(Frame& F, const bf16* xb, float* out, const float* gain) {
    const int gw = F.vcu * NWAVES + F.wave, NGW = F.G * NWAVES;
    f32x4 gv[4];
#pragma unroll
    for (int j = 0; j < 4; ++j) gv[j] = *((const GAS f32x4*)gain + 4 * F.lane + j);
    for (int m = gw; m < M; m += NGW) {
        const GAS v4u* xr = (const GAS v4u*)(xb + (size_t)m * D) + 2 * F.lane;
        const v4u a = xr[0], b = xr[1];
        f32x4 v[4]; float s = 0.f;
        v[0] = (f32x4){__uint_as_float(a.x << 16), __uint_as_float(a.x & 0xffff0000u), __uint_as_float(a.y << 16), __uint_as_float(a.y & 0xffff0000u)};
        v[1] = (f32x4){__uint_as_float(a.z << 16), __uint_as_float(a.z & 0xffff0000u), __uint_as_float(a.w << 16), __uint_as_float(a.w & 0xffff0000u)};
        v[2] = (f32x4){__uint_as_float(b.x << 16), __uint_as_float(b.x & 0xffff0000u), __uint_as_float(b.y << 16), __uint_as_float(b.y & 0xffff0000u)};
        v[3] = (f32x4){__uint_as_float(b.z << 16), __uint_as_float(b.z & 0xffff0000u), __uint_as_float(b.w << 16), __uint_as_float(b.w & 0xffff0000u)};
#pragma unroll
        for (int j = 0; j < 4; ++j) s += (v[j].x * v[j].x + v[j].y * v[j].y) + (v[j].z * v[j].z + v[j].w * v[j].w);
        s = wave_sum(s);
        const float r = __builtin_amdgcn_rsqf(s * (1.0f / D) + EPS);
        GAS f32x4* orow = (GAS f32x4*)(out + (size_t)m * D) + 4 * F.lane;
#pragma unroll
        for (int j = 0; j < 4; ++j) orow[j] = v[j] * r * gv[j];
    }
}

constexpr int N_PHASES = 10;
__global__ void __launch_bounds__(NWAVES * 64, 2) fwd_kernel(Args args) {
    extern __shared__ __attribute__((aligned(16))) unsigned char lds[];
    Frame F;
    F.lds = (LAS unsigned char*)lds;
    F.MISC = (volatile LAS unsigned*)(F.lds + MISC_OFF);
    F.tid = threadIdx.x; F.lane = F.tid & 63; F.wave = __builtin_amdgcn_readfirstlane(F.tid >> 6);
    F.G = gridDim.x; { const int bx = blockIdx.x; F.vcu = (F.G % 8 == 0) ? (bx % 8) * (F.G / 8) + bx / 8 : bx; }
    unsigned char* ws = args.ws;
    F.ctl = (gu32*)(ws + WS_CTL);
    for (int u = F.tid; u < (LDS_BYTES - LDSCTL_OFF) / 4; u += NWAVES * 64) ((LAS unsigned*)(F.lds + LDSCTL_OFF))[u] = 0u;
    __syncthreads();
    const int lo = args.ph_lo, hi = args.ph_hi;
    const bool one_launch = (hi - lo) > 1;
    XcdBarrier bar; bar.bar = (unsigned*)(F.ctl + CW_BAR); bar.x = 0; bar.st = nullptr;
    if (one_launch) bar = xcd_barrier_post((unsigned*)(F.ctl + CW_BAR), F.MISC + 8);
#ifndef PHASE_MASK
#define PHASE_MASK 0x3ff
#endif
#define IN(k) (((PHASE_MASK >> (k)) & 1) && lo <= (k) && (k) < hi)
#define SEAM(k) do { if (IN(k) && IN((k) + 1)) xcd_barrier(bar); } while (0)

    float* ss = (float*)(ws + WS_SS);
    bf16* XB = (bf16*)(ws + WS_XB); bf16* HB = (bf16*)(ws + WS_H); bf16* MIX = (bf16*)(ws + WS_MIX);
    bf16 *QB_ = (bf16*)(ws + WS_Q), *KB_ = (bf16*)(ws + WS_K), *VB_ = (bf16*)(ws + WS_V), *GBB = (bf16*)(ws + WS_GB), *UB = (bf16*)(ws + WS_U), *OBB = (bf16*)(ws + WS_O);

#ifndef DUP_PHASE
#define DUP_PHASE -1
#endif
#define REPS(k) for (int rep = 0; rep < ((DUP_PHASE == (k)) ? 2 : 1); ++rep)
#ifdef PROBE_PH_A
    gu64* tsw = (gu64*)(F.ctl + 2048);
#define STAMP(k) do { if (blockIdx.x == 0 && F.tid == 0) __hip_atomic_store(tsw + (k), rt(), RLX_AGENT); } while (0)
#else
#define STAMP(k) do {} while (0)
#endif
    STAMP(0);
    if (IN(0)) { p0_prologue(F, args); } SEAM(0); STAMP(1);
    if (IN(1)) REPS(1) {
        pg8::Gemm g{XB, (const bf16*)(ws + WS_WGU1), M, 2 * FF, D}; pg8::StaticOrder S; S.init(M, 2 * FF, F.G, (int)blockIdx.x);
        pg8::EpiSwiGLU E{HB, FF, ss, 1.0f / D};
        pg8::gemm_phase<pg8::EpiSwiGLU, pg8::StaticOrder, PG8_ALIGN, PG8_SP2>(F.lds + RING_OFF, g, S, E);
    } SEAM(1); STAMP(2);
    if (IN(2)) REPS(2) {
        pg8::Gemm g{HB, (const bf16*)(ws + WS_WD1), M, D, FF}; pg8::StaticOrder S; S.init(M, D, F.G, (int)blockIdx.x);
        pg8::EpiResB<true> E{args.in[0], XB, rep ? ss + 3 * M : ss + M, 0.5f};
        pg8::gemm_phase<pg8::EpiResB<true>, pg8::StaticOrder, PG8_ALIGN, PG8_SP2>(F.lds + RING_OFF, g, S, E);
    } SEAM(2); STAMP(3);
    if (IN(3)) REPS(3) {
        pg8::Gemm g{XB, (const bf16*)(ws + WS_WIN), M, NIN, D}; pg8::StaticOrder S; S.init(M, NIN, F.G, (int)blockIdx.x);
        pg8::EpiIn E{QB_, KB_, VB_, GBB, UB, ss + M, args.in[7], args.in[8], 0.125f * LOG2E};
        pg8::gemm_phase<pg8::EpiIn, pg8::StaticOrder, PG8_ALIGN, PG8_SP2>(F.lds + RING_OFF, g, S, E);
    } SEAM(3); STAMP(4);
    if (IN(4)) REPS(4) {
        conv_phase(F, UB, GBB, args.in[14], args.in[15], MIX);
        const int nun = BATCH * NH * 32;
        for (int i = 0; ; ++i) {
            const int L = i * F.G + F.vcu; if (L >= nun) break;
            const int round = L / 256, w = L % 256, bh = w >> 3, s = w & 7; const int qb = (round & 1) ? 15 - s : s, mc = round >> 1;
            att::attn_unit(bh >> 2, bh & 3, mc, qb, QB_, KB_, VB_, OBB, F.lds + RING_OFF);
        }
    } SEAM(4); STAMP(5);
    if (IN(5)) {
        float lam;
        { const float a = args.in[9][F.lane] * args.in[10][F.lane], b2 = args.in[11][F.lane] * args.in[12][F.lane];
          lam = expf(wave_sum(a)) - expf(wave_sum(b2)) + LAM_INIT; }
        combine_phase(F, OBB, args.in[13], lam, MIX);
    } SEAM(5); STAMP(6);
    if (IN(6)) REPS(6) {
        pg8::Gemm g{MIX, (const bf16*)(ws + WS_WOUT), M, D, D}; pg8::StaticOrder S; S.init(M, D, F.G, (int)blockIdx.x);
        pg8::EpiResB<false> E{XB, rep ? (bf16*)(ws + WS_H) : XB, rep ? ss + 3 * M : ss + 2 * M, 1.0f};
        pg8::gemm_phase<pg8::EpiResB<false>, pg8::StaticOrder, PG8_ALIGN, PG8_SP2>(F.lds + RING_OFF, g, S, E);
    } SEAM(6); STAMP(7);
    if (IN(7)) {
        pg8::Gemm g{XB, (const bf16*)(ws + WS_WGU2), M, 2 * FF, D}; pg8::StaticOrder S; S.init(M, 2 * FF, F.G, (int)blockIdx.x);
        pg8::EpiSwiGLU E{HB, FF, ss + 2 * M, 1.0f / D};
        pg8::gemm_phase<pg8::EpiSwiGLU, pg8::StaticOrder, PG8_ALIGN, PG8_SP2>(F.lds + RING_OFF, g, S, E);
    } SEAM(7); STAMP(8);
    if (IN(8)) {
        pg8::Gemm g{HB, (const bf16*)(ws + WS_WD2), M, D, FF}; pg8::StaticOrder S; S.init(M, D, F.G, (int)blockIdx.x);
        pg8::EpiResB<false> E{XB, XB, nullptr, 0.5f};
        pg8::gemm_phase<pg8::EpiResB<false>, pg8::StaticOrder, PG8_ALIGN, PG8_SP2>(F.lds + RING_OFF, g, S, E);
    } SEAM(8); STAMP(9);
    if (IN(9)) final_norm_phase(F, XB, args.out, args.in[21]);
#ifdef PROBE_PH_A
    STAMP(10);
    __syncthreads();
    if (blockIdx.x == 0 && F.wave == 0) {
        asm volatile("s_waitcnt vmcnt(0)" ::: "memory");
        const float ta = (float)(__hip_atomic_load(tsw + PROBE_PH_A + 1, RLX_AGENT) - __hip_atomic_load(tsw + PROBE_PH_A, RLX_AGENT)) * 0.01f;
        const float tb = (float)(__hip_atomic_load(tsw + PROBE_PH_B + 1, RLX_AGENT) - __hip_atomic_load(tsw + PROBE_PH_B, RLX_AGENT)) * 0.01f;
        if (F.lane == 0) args.out[0] += ta;
        for (int j = 1; j < 16; ++j) args.out[F.lane + 64 * j] += tb * 0.01f;
    }
#endif
#undef IN
#undef SEAM
}

#ifndef MK_N_LAUNCHES
#define MK_N_LAUNCHES 1
#endif
extern "C" void kernel_launch(void* const* d_in, const int* in_sizes, int n_in, void* d_out, int out_size, void* d_ws, size_t ws_size, hipStream_t stream) {
    static int grid = 0;
    if (grid == 0) {
        if (n_in != 22 || in_sizes[0] != M * D || out_size != M * D || ws_size < WS_END) { fprintf(stderr, "kernel_launch: unexpected shapes (n_in %d, in0 %d, out %d, ws %zu); nothing launched\n", n_in, n_in > 0 ? in_sizes[0] : -1, out_size, ws_size); grid = -1; return; }
        int dev = 0, cus = 0;
        if (hipGetDevice(&dev) != hipSuccess || hipDeviceGetAttribute(&cus, hipDeviceAttributeMultiprocessorCount, dev) != hipSuccess) { grid = -1; return; }
        if (hipFuncSetAttribute((const void*)fwd_kernel, hipFuncAttributeMaxDynamicSharedMemorySize, LDS_BYTES) != hipSuccess) { fprintf(stderr, "kernel_launch: hipFuncSetAttribute failed\n"); grid = -1; return; }
        (void)hipGetLastError();
        grid = cus;
    }
    if (grid < 0) return;
    if (hipMemsetAsync((char*)d_ws + WS_CTL, 0, CTL_ZERO_BYTES, stream) != hipSuccess) return;
    Args a{};
    for (int i = 0; i < 22; ++i) a.in[i] = (const float*)d_in[i];
    a.out = (float*)d_out; a.ws = (unsigned char*)d_ws;
    if (MK_N_LAUNCHES == 1) { a.ph_lo = 0; a.ph_hi = N_PHASES; hipLaunchKernelGGL(fwd_kernel, dim3(grid), dim3(NWAVES * 64), LDS_BYTES, stream, a); }
    else for (int p = 0; p < N_PHASES; ++p) { a.ph_lo = p; a.ph_hi = p + 1; hipLaunchKernelGGL(fwd_kernel, dim3(grid), dim3(NWAVES * 64), LDS_BYTES, stream, a); }
}
```

```cpp
#include <hip/hip_runtime.h>
#include <cstdio>
#include <cstdint>
namespace pg8 {
#define PG8_LAS __attribute__((address_space(3)))
typedef unsigned short bf16_t;
typedef short bf16x8 __attribute__((ext_vector_type(8)));
typedef float f32x4 __attribute__((ext_vector_type(4)));
typedef unsigned u32x4 __attribute__((ext_vector_type(4)));
constexpr int BM = 256, BK = 64, HALF = 128, HTB = HALF * BK * 2  , STAGE_BYTES = 8 * HTB, NXCD = 8, WGM = 8;

__host__ __device__ __forceinline__ int lds_byte(int r, int c) { const int st = (r >> 4) * 2 + (c >> 5), rr = r & 15, cc = c & 31, ob = rr * 64 + cc * 2; return st * 1024 + (ob ^ (((ob >> 9) & 1) << 5)); }
__host__ __device__ __forceinline__ void stage_rc(int b, int& R, int& C) { const int st = b / 1024, sb = b % 1024, swz = sb ^ (((sb >> 9) & 1) << 5); R = (st >> 1) * 16 + swz / 64; C = (st & 1) * 32 + (swz % 64) / 2; }
__host__ __device__ __forceinline__ int perm32(int rho) { const int n = rho >> 4, i = rho & 15; return 8 * (i >> 2) + 4 * n + (i & 3); }

struct Unit { int pm, pn; };
struct Gemm { const bf16_t* A; const bf16_t* Bt; int M, N, K; };

struct StaticOrder {
    int nM, nN, nwg, G, c;
    __host__ __device__ void init(int M, int N, int G_, int c_) { nM = M / BM; nN = N / BM; nwg = nM * nN; G = G_; c = c_; }
    __host__ __device__ bool next(int i, Unit& u) const {
        const long L = (long)i * G + c; if (L >= nwg) return false;
        int wgid = (int)L; { const int q = nwg / NXCD, r = nwg % NXCD, xcd = wgid % NXCD, off = wgid / NXCD; wgid = (xcd < r ? xcd * (q + 1) : r * (q + 1) + (xcd - r) * q) + off; }
        const int nig = WGM * nN, gid = wgid / nig, fm = gid * WGM, gsz = (nM - fm) < WGM ? (nM - fm) : WGM;
        u.pm = fm + ((wgid % nig) % gsz); u.pn = (wgid % nig) / gsz; return true;
    }
    __device__ __forceinline__ void a_ready(const Unit&) const {}
    __device__ __forceinline__ void done(const Unit&) const {}
};

__device__ __forceinline__ unsigned cvt_pk_bf16(float lo, float hi) { unsigned r; asm volatile("v_cvt_pk_bf16_f32 %0, %1, %2" : "=v"(r) : "v"(lo), "v"(hi)); return r; }
typedef float f32x2 __attribute__((ext_vector_type(2)));
typedef unsigned u32x2 __attribute__((ext_vector_type(2)));
constexpr float NORM_EPS = 1e-6f;
__device__ __forceinline__ float silu_mul(float g, float u) {
    const float e = __builtin_amdgcn_exp2f(g * -1.4426950408889634f);
    return g * u * __builtin_amdgcn_rcpf(1.0f + e);
}
struct EpiSwiGLU {
    static constexpr bool PERM = true, AFTER_DRAIN = false;
    bf16_t* Hout; int ldh; const float* ss; float inv_k;
    __device__ __forceinline__ void operator()(const f32x4 (&acc)[2][2][4][2], const Unit& u, int wr, int wc, int fr, int fq) const {
        const int row0 = u.pm * BM + wr * 64 + fr, col0 = u.pn * HALF + wc * 32 + 8 * fq;
#pragma unroll
        for (int ai = 0; ai < 2; ++ai)
#pragma unroll
            for (int m = 0; m < 4; ++m) {
                const int row = row0 + ai * HALF + m * 16;
                const float rs = __builtin_amdgcn_rsqf(ss[row] * inv_k + NORM_EPS);
                const f32x4 g0 = acc[ai][0][m][0] * rs, g1 = acc[ai][0][m][1] * rs, u0 = acc[ai][1][m][0] * rs, u1 = acc[ai][1][m][1] * rs;
                u32x4 w;
                w.x = cvt_pk_bf16(silu_mul(g0[0], u0[0]), silu_mul(g0[1], u0[1]));
                w.y = cvt_pk_bf16(silu_mul(g0[2], u0[2]), silu_mul(g0[3], u0[3]));
                w.z = cvt_pk_bf16(silu_mul(g1[0], u1[0]), silu_mul(g1[1], u1[1]));
                w.w = cvt_pk_bf16(silu_mul(g1[2], u1[2]), silu_mul(g1[3], u1[3]));
                *(u32x4*)(Hout + (size_t)row * ldh + col0) = w;
            }
    }
};
template <bool RES_F32> struct EpiResB {
    static constexpr bool PERM = true, AFTER_DRAIN = false;
    const void* res; bf16_t* out; float* ssacc; float scale;
    __device__ __forceinline__ void operator()(const f32x4 (&acc)[2][2][4][2], const Unit& u, int wr, int wc, int fr, int fq) const {
        const int row0 = u.pm * BM + wr * 64 + fr, col0 = u.pn * BM + wc * 32 + 8 * fq;
#pragma unroll
        for (int ai = 0; ai < 2; ++ai) {
            float srow[4];
            if constexpr (RES_F32) {
                const float* rp = (const float*)res;
#pragma unroll
                for (int mh = 0; mh < 2; ++mh) {
                    f32x4 rv[2][2][2];
#pragma unroll
                    for (int mm = 0; mm < 2; ++mm)
#pragma unroll
                        for (int bj = 0; bj < 2; ++bj)
#pragma unroll
                            for (int n = 0; n < 2; ++n) rv[mm][bj][n] = *(const f32x4*)(rp + (size_t)(row0 + ai * HALF + (2 * mh + mm) * 16) * 1024 + col0 + bj * HALF + 4 * n);
#pragma unroll
                    for (int mm = 0; mm < 2; ++mm) {
                        const int m = 2 * mh + mm; const size_t off = (size_t)(row0 + ai * HALF + m * 16) * 1024 + col0; float s = 0.f;
#pragma unroll
                        for (int bj = 0; bj < 2; ++bj) {
                            const f32x4 a = rv[mm][bj][0] + acc[ai][bj][m][0] * scale, b = rv[mm][bj][1] + acc[ai][bj][m][1] * scale;
                            s += (a[0] * a[0] + a[1] * a[1]) + (a[2] * a[2] + a[3] * a[3]) + (b[0] * b[0] + b[1] * b[1]) + (b[2] * b[2] + b[3] * b[3]);
                            u32x4 w; w.x = cvt_pk_bf16(a[0], a[1]); w.y = cvt_pk_bf16(a[2], a[3]); w.z = cvt_pk_bf16(b[0], b[1]); w.w = cvt_pk_bf16(b[2], b[3]);
                            *(u32x4*)(out + off + bj * HALF) = w;
                        }
                        s += __shfl_xor(s, 16); s += __shfl_xor(s, 32); srow[m] = s;
                    }
                    asm volatile("" ::: "memory");
                }
            } else {
                const bf16_t* rp = (const bf16_t*)res;
                u32x4 rv[4][2];
#pragma unroll
                for (int m = 0; m < 4; ++m)
#pragma unroll
                    for (int bj = 0; bj < 2; ++bj) rv[m][bj] = *(const u32x4*)(rp + (size_t)(row0 + ai * HALF + m * 16) * 1024 + col0 + bj * HALF);
#pragma unroll
                for (int m = 0; m < 4; ++m) {
                    const size_t off = (size_t)(row0 + ai * HALF + m * 16) * 1024 + col0; float s = 0.f;
#pragma unroll
                    for (int bj = 0; bj < 2; ++bj) {
                        const u32x4 r = rv[m][bj];
                        const f32x4 ra = {__uint_as_float(r.x << 16), __uint_as_float(r.x & 0xffff0000u), __uint_as_float(r.y << 16), __uint_as_float(r.y & 0xffff0000u)};
                        const f32x4 rb = {__uint_as_float(r.z << 16), __uint_as_float(r.z & 0xffff0000u), __uint_as_float(r.w << 16), __uint_as_float(r.w & 0xffff0000u)};
                        const f32x4 a = ra + acc[ai][bj][m][0] * scale, b = rb + acc[ai][bj][m][1] * scale;
                        s += (a[0] * a[0] + a[1] * a[1]) + (a[2] * a[2] + a[3] * a[3]) + (b[0] * b[0] + b[1] * b[1]) + (b[2] * b[2] + b[3] * b[3]);
                        u32x4 w; w.x = cvt_pk_bf16(a[0], a[1]); w.y = cvt_pk_bf16(a[2], a[3]); w.z = cvt_pk_bf16(b[0], b[1]); w.w = cvt_pk_bf16(b[2], b[3]);
                        *(u32x4*)(out + off + bj * HALF) = w;
                    }
                    s += __shfl_xor(s, 16); s += __shfl_xor(s, 32); srow[m] = s;
                }
                asm volatile("" ::: "memory");
            }
            if (ssacc) {
                const float v = fq == 0 ? srow[0] : fq == 1 ? srow[1] : fq == 2 ? srow[2] : srow[3];
                atomicAdd(ssacc + u.pm * BM + ai * HALF + wr * 64 + fq * 16 + fr, v);
            }
        }
    }
};
struct EpiIn {
    static constexpr bool PERM = true, AFTER_DRAIN = false;
    bf16_t *Q, *K, *V, *GB, *U;
    const float* ss; const float* qg; const float* kg; float qscale;
    __device__ __forceinline__ void operator()(const f32x4 (&acc)[2][2][4][2], const Unit& u, int wr, int wc, int fr, int fq) const {
        const int row0 = u.pm * BM + wr * 64 + fr; const int pn = u.pn;
        if (pn < 4) {
            bf16_t* dst = (pn < 2 ? Q : K) + (size_t)(64 * (4 * (pn & 1) + wc)) + 8 * fq;
            const float* gp = (pn < 2 ? qg : kg) + 8 * fq; const float sc = pn < 2 ? qscale : 1.0f;
            f32x4 gv[2][2];
#pragma unroll
            for (int bj = 0; bj < 2; ++bj)
#pragma unroll
                for (int n = 0; n < 2; ++n) gv[bj][n] = *(const f32x4*)(gp + 32 * bj + 4 * n) * sc;
#pragma unroll
            for (int ai = 0; ai < 2; ++ai)
#pragma unroll
                for (int m = 0; m < 4; ++m) {
                    const int row = row0 + ai * HALF + m * 16;
                    const float rs = __builtin_amdgcn_rsqf(ss[row] * (1.0f / 1024.0f) + NORM_EPS);
                    f32x4 t[2][2]; float s = 0.f;
#pragma unroll
                    for (int bj = 0; bj < 2; ++bj)
#pragma unroll
                        for (int n = 0; n < 2; ++n) { t[bj][n] = acc[ai][bj][m][n] * rs; const f32x4 x = t[bj][n]; s += (x[0] * x[0] + x[1] * x[1]) + (x[2] * x[2] + x[3] * x[3]); }
                    s += __shfl_xor(s, 16); s += __shfl_xor(s, 32);
                    const float rn = __builtin_amdgcn_rsqf(s * (1.0f / 64.0f) + NORM_EPS);
#pragma unroll
                    for (int bj = 0; bj < 2; ++bj) {
                        const f32x4 a = t[bj][0] * rn * gv[bj][0], b = t[bj][1] * rn * gv[bj][1];
                        u32x4 w; w.x = cvt_pk_bf16(a[0], a[1]); w.y = cvt_pk_bf16(a[2], a[3]); w.z = cvt_pk_bf16(b[0], b[1]); w.w = cvt_pk_bf16(b[2], b[3]);
                        *(u32x4*)(dst + (size_t)row * 512 + 32 * bj) = w;
                    }
                }
        } else if (pn < 8) {
            bf16_t* dst = (pn < 6 ? V : GB) + (size_t)(256 * (pn & 1) + wc * 32 + 8 * fq);
#pragma unroll
            for (int ai = 0; ai < 2; ++ai)
#pragma unroll
                for (int m = 0; m < 4; ++m) {
                    const int row = row0 + ai * HALF + m * 16;
                    const float rs = __builtin_amdgcn_rsqf(ss[row] * (1.0f / 1024.0f) + NORM_EPS);
#pragma unroll
                    for (int bj = 0; bj < 2; ++bj) {
                        const f32x4 a = acc[ai][bj][m][0] * rs, b = acc[ai][bj][m][1] * rs;
                        u32x4 w; w.x = cvt_pk_bf16(a[0], a[1]); w.y = cvt_pk_bf16(a[2], a[3]); w.z = cvt_pk_bf16(b[0], b[1]); w.w = cvt_pk_bf16(b[2], b[3]);
                        *(u32x4*)(dst + (size_t)row * 512 + HALF * bj) = w;
                    }
                }
        } else {
            bf16_t* dst = U + (size_t)(128 * (pn - 8) + wc * 32 + 8 * fq);
#pragma unroll
            for (int ai = 0; ai < 2; ++ai)
#pragma unroll
                for (int m = 0; m < 4; ++m) {
                    const int row = row0 + ai * HALF + m * 16;
                    const float rs = __builtin_amdgcn_rsqf(ss[row] * (1.0f / 1024.0f) + NORM_EPS); const float rs2 = rs * rs;
                    const f32x4 a = acc[ai][0][m][0] * acc[ai][1][m][0] * rs2, b = acc[ai][0][m][1] * acc[ai][1][m][1] * rs2;
                    u32x4 w; w.x = cvt_pk_bf16(a[0], a[1]); w.y = cvt_pk_bf16(a[2], a[3]); w.z = cvt_pk_bf16(b[0], b[1]); w.w = cvt_pk_bf16(b[2], b[3]);
                    *(u32x4*)(dst + (size_t)row * 512) = w;
                }
        }
    }
};

template <class Epi, class Sched, bool ALIGN_EPI = false, bool SP2 = false>
__device__ __forceinline__ void gemm_phase(PG8_LAS unsigned char* lds, const Gemm g, const Sched& S, const Epi& E) {
    const int tid = threadIdx.x, wid = __builtin_amdgcn_readfirstlane(tid >> 6), lane = tid & 63, wr = wid >> 2, wc = wid & 3, fr = lane & 15, fq = lane >> 4;
    const int K = g.K, nt = K / BK;
    unsigned voffA[2], voffB[2];
#pragma unroll
    for (int i = 0; i < 2; ++i) { int R, C; stage_rc(tid * 16 + i * 8192, R, C); const int Rb = Epi::PERM ? ((R & ~31) + perm32(R & 31)) : R;
        voffA[i] = (unsigned)(R * K + C) * 2u; voffB[i] = (unsigned)(Rb * K + C) * 2u; }
    const size_t kstep = (size_t)(BK * 2);
    const size_t hstep = (size_t)HALF * K * 2;
    const size_t tstep = 2 * hstep;
    const unsigned ldsw = (unsigned)wid * 1024u;
    const int aoff = lds_byte(wr * 64 + fr, fq * 8), boff = lds_byte(wc * 32 + fr, fq * 8);
#define PG8_SA(b, h) (((b) * 2 + (h)) * HTB)
#define PG8_SB(b, h) ((4 + (b) * 2 + (h)) * HTB)
#define PG8_STAGE(bufoff, gbase, voff) do { _Pragma("unroll") for (int _i = 0; _i < 2; ++_i) \
        __builtin_amdgcn_global_load_lds((const unsigned*)((const char*)(gbase) + (voff)[_i]), (PG8_LAS unsigned*)(lds + (bufoff) + ldsw + _i * 8192), 16, 0, 0); } while (0)
#define PG8_LDA(dst, b, h) do { _Pragma("unroll") for (int m = 0; m < 4; ++m) _Pragma("unroll") for (int k = 0; k < 2; ++k) dst[m][k] = *(const PG8_LAS bf16x8*)(lds + PG8_SA(b, h) + aoff + m * 2048 + k * 1024); } while (0)
#define PG8_LDB(dst, b, h) do { _Pragma("unroll") for (int n = 0; n < 2; ++n) _Pragma("unroll") for (int k = 0; k < 2; ++k) dst[n][k] = *(const PG8_LAS bf16x8*)(lds + PG8_SB(b, h) + boff + n * 2048 + k * 1024); } while (0)
#define PG8_MMA(ai, bj, At, Bt) do { __builtin_amdgcn_s_setprio(1); _Pragma("unroll") for (int m = 0; m < 4; ++m) _Pragma("unroll") for (int n = 0; n < 2; ++n) _Pragma("unroll") for (int k = 0; k < 2; ++k) \
        acc[ai][bj][m][n] = __builtin_amdgcn_mfma_f32_16x16x32_bf16(Bt[n][k], At[m][k], acc[ai][bj][m][n], 0, 0, 0); __builtin_amdgcn_s_setprio(0); } while (0)
#define PG8_WAIT_V(n) asm volatile("s_waitcnt vmcnt(" #n ")" ::: "memory")
#define PG8_WAIT_L(n) asm volatile("s_waitcnt lgkmcnt(" #n ")" ::: "memory")
#define PG8_BAR __builtin_amdgcn_s_barrier()
#define PG8_SCHED __builtin_amdgcn_sched_barrier(0)
    Unit cur, nxt; int ui = 0;
    if (!S.next(0, cur)) return;
    f32x4 acc[2][2][4][2];
#pragma unroll
    for (int a = 0; a < 2; ++a)
#pragma unroll
        for (int b = 0; b < 2; ++b)
#pragma unroll
            for (int m = 0; m < 4; ++m)
#pragma unroll
                for (int n = 0; n < 2; ++n) acc[a][b][m][n] = (f32x4){0.f, 0.f, 0.f, 0.f};
    bf16x8 At[4][2], B0[2][2], B1[2][2];
    const char* cA = (const char*)g.A + (size_t)cur.pm * tstep; const char* cB = (const char*)g.Bt + (size_t)cur.pn * tstep;
    S.a_ready(cur);
    if constexpr (SP2) {
        PG8_STAGE(PG8_SB(0, 0), cB, voffB); PG8_STAGE(PG8_SB(0, 1), cB + hstep, voffB); PG8_STAGE(PG8_SA(0, 0), cA, voffA); PG8_STAGE(PG8_SA(0, 1), cA + hstep, voffA);
        if (wr == 1) PG8_BAR;
        PG8_WAIT_V(2); PG8_BAR;
        PG8_STAGE(PG8_SB(1, 0), cB + kstep, voffB); PG8_STAGE(PG8_SA(1, 0), cA + kstep, voffA); PG8_STAGE(PG8_SB(1, 1), cB + hstep + kstep, voffB);
        PG8_WAIT_V(6); PG8_BAR;
    } else {
        PG8_STAGE(PG8_SB(0, 0), cB, voffB); PG8_STAGE(PG8_SA(0, 0), cA, voffA); PG8_STAGE(PG8_SB(0, 1), cB + hstep, voffB); PG8_STAGE(PG8_SA(0, 1), cA + hstep, voffA);
        if (wr == 1) PG8_BAR;
        PG8_WAIT_V(4); PG8_BAR;
        PG8_STAGE(PG8_SB(1, 0), cB + kstep, voffB); PG8_STAGE(PG8_SA(1, 0), cA + kstep, voffA); PG8_STAGE(PG8_SB(1, 1), cB + hstep + kstep, voffB);
        PG8_WAIT_V(6); PG8_BAR;
    }
    for (;;) {
        const bool has_next = S.next(ui + 1, nxt);
        const char* nA = has_next ? (const char*)g.A + (size_t)nxt.pm * tstep : cA; const char* nB = has_next ? (const char*)g.Bt + (size_t)nxt.pn * tstep : cB;
        for (int t = 0; t < nt; t += 2) {
            const bool last = (t == nt - 2);
            const char* a1 = cA + (size_t)(t + 1) * kstep;
            const char* a2 = last ? nA : cA + (size_t)(t + 2) * kstep; const char* b2 = last ? nB : cB + (size_t)(t + 2) * kstep;
            const char* a3 = a2 + kstep; const char* b3 = b2 + kstep;
            if (last && has_next) S.a_ready(nxt);
            if constexpr (SP2) {
            PG8_LDB(B0, 0, 0); PG8_LDB(B1, 0, 1); PG8_SCHED; PG8_LDA(At, 0, 0); PG8_STAGE(PG8_SA(1, 1), a1 + hstep, voffA);
            PG8_WAIT_V(8); PG8_WAIT_L(0); PG8_BAR; PG8_MMA(0, 0, At, B0); PG8_MMA(0, 1, At, B1); PG8_BAR; PG8_SCHED;
            PG8_LDA(At, 0, 1); PG8_STAGE(PG8_SB(0, 0), b2, voffB); PG8_STAGE(PG8_SB(0, 1), b2 + hstep, voffB); PG8_STAGE(PG8_SA(0, 0), a2, voffA);
            PG8_WAIT_V(8); PG8_WAIT_L(0); PG8_BAR; PG8_MMA(1, 0, At, B0); PG8_MMA(1, 1, At, B1); PG8_BAR; PG8_SCHED;
            PG8_LDB(B0, 1, 0); PG8_LDB(B1, 1, 1); PG8_SCHED; PG8_LDA(At, 1, 0); PG8_STAGE(PG8_SA(0, 1), a2 + hstep, voffA);
            PG8_WAIT_V(8); PG8_WAIT_L(0); PG8_BAR; PG8_MMA(0, 0, At, B0); PG8_MMA(0, 1, At, B1); PG8_BAR; PG8_SCHED;
            PG8_LDA(At, 1, 1); PG8_STAGE(PG8_SB(1, 0), b3, voffB); PG8_STAGE(PG8_SB(1, 1), b3 + hstep, voffB); PG8_STAGE(PG8_SA(1, 0), a3, voffA);
            PG8_WAIT_V(8); PG8_WAIT_L(0); PG8_BAR; PG8_MMA(1, 0, At, B0); PG8_MMA(1, 1, At, B1); PG8_BAR; PG8_SCHED;
            } else {
            PG8_LDB(B0, 0, 0); PG8_SCHED; PG8_LDA(At, 0, 0); PG8_STAGE(PG8_SA(1, 1), a1 + hstep, voffA);
            PG8_WAIT_L(8); PG8_BAR; PG8_WAIT_L(0); PG8_MMA(0, 0, At, B0); PG8_BAR; PG8_SCHED;
            PG8_LDB(B1, 0, 1); PG8_STAGE(PG8_SB(0, 0), b2, voffB);
            PG8_BAR; PG8_WAIT_L(0); PG8_MMA(0, 1, At, B1); PG8_BAR;
            PG8_LDA(At, 0, 1); PG8_STAGE(PG8_SA(0, 0), a2, voffA);
            PG8_BAR; PG8_WAIT_L(0); PG8_MMA(1, 0, At, B0); PG8_BAR; PG8_SCHED;
            PG8_STAGE(PG8_SB(0, 1), b2 + hstep, voffB);
            PG8_WAIT_V(6); PG8_BAR; PG8_MMA(1, 1, At, B1); PG8_BAR;
            PG8_LDB(B0, 1, 0); PG8_SCHED; PG8_LDA(At, 1, 0); PG8_STAGE(PG8_SA(0, 1), a2 + hstep, voffA);
            PG8_WAIT_L(8); PG8_BAR; PG8_WAIT_L(0); PG8_MMA(0, 0, At, B0); PG8_BAR; PG8_SCHED;
            PG8_LDB(B1, 1, 1); PG8_STAGE(PG8_SB(1, 0), b3, voffB);
            PG8_BAR; PG8_WAIT_L(0); PG8_MMA(0, 1, At, B1); PG8_BAR;
            PG8_LDA(At, 1, 1); PG8_STAGE(PG8_SA(1, 0), a3, voffA);
            PG8_BAR; PG8_WAIT_L(0); PG8_MMA(1, 0, At, B0); PG8_BAR; PG8_SCHED;
            PG8_STAGE(PG8_SB(1, 1), b3 + hstep, voffB);
            PG8_WAIT_V(6); PG8_BAR; PG8_MMA(1, 1, At, B1); PG8_BAR;
            }
        }
        if constexpr (ALIGN_EPI) { if (wr == 0) PG8_BAR; }
        if constexpr (!Epi::AFTER_DRAIN) { E(acc, cur, wr, wc, fr, fq); S.done(cur); }
        if (!has_next) break;
#pragma unroll
        for (int a = 0; a < 2; ++a)
#pragma unroll
            for (int b = 0; b < 2; ++b)
#pragma unroll
                for (int m = 0; m < 4; ++m)
#pragma unroll
                    for (int n = 0; n < 2; ++n) acc[a][b][m][n] = (f32x4){0.f, 0.f, 0.f, 0.f};
        cur = nxt; cA = nA; cB = nB; ++ui;
        if constexpr (ALIGN_EPI) { if (wr == 1) PG8_BAR; }
    }
    PG8_WAIT_V(0);
    if constexpr (!ALIGN_EPI) { if (wr == 0) PG8_BAR; }
    PG8_BAR;
    if constexpr (Epi::AFTER_DRAIN) { E.fused(acc, cur, wr, wc, fr, fq, lds, wid, lane); S.done(cur); }
#undef PG8_SA
#undef PG8_SB
#undef PG8_STAGE
#undef PG8_LDA
#undef PG8_LDB
#undef PG8_MMA
#undef PG8_WAIT_V
#undef PG8_WAIT_L
#undef PG8_BAR
#undef PG8_SCHED
}
}

#ifndef PG8_SP2
#define PG8_SP2 true
#endif
#ifndef PG8_ALIGN
#define PG8_ALIGN true
#endif
#define GAS __attribute__((address_space(1)))
#define LAS __attribute__((address_space(3)))
typedef unsigned short bf16;
typedef unsigned v4u __attribute__((ext_vector_type(4)));
typedef float f32x4 __attribute__((ext_vector_type(4)));
typedef short bf16x8 __attribute__((ext_vector_type(8)));
typedef GAS unsigned gu32;
typedef GAS unsigned long long gu64;
#define RLX_AGENT __ATOMIC_RELAXED, __HIP_MEMORY_SCOPE_AGENT
#define LDS_WAIT() asm volatile("s_waitcnt lgkmcnt(0)" ::: "memory")
#define VM_WAIT() asm volatile("s_waitcnt vmcnt(0)" ::: "memory")
__device__ __forceinline__ unsigned long long rt() { return __builtin_amdgcn_s_memrealtime(); }
__device__ __forceinline__ unsigned f2bf(float f) { unsigned u = __builtin_bit_cast(unsigned, f); return (u + 0x7fffu + ((u >> 16) & 1u)) >> 16; }
__device__ __forceinline__ unsigned pk2(float lo, float hi) { return f2bf(lo) | (f2bf(hi) << 16); }

#define XB_TMO      128
#define XB_XCNT(j)  (256  + 64 * (j))
#define XB_XSUB(j)  (1280 + 64 * (j))
#define XB_XGEN(j)  (2304 + 64 * (j))
#define XB_TOP      3328
#define XB_TOPGEN   3392
#define XCD_BAR_WORDS 3456
#define XB_SPIN_CAP (1u << 18)

__device__ __forceinline__ unsigned xb_ld(unsigned* p)              { return __hip_atomic_load(p, __ATOMIC_RELAXED, __HIP_MEMORY_SCOPE_AGENT); }
__device__ __forceinline__ unsigned xb_add(unsigned* p, unsigned v) { return __hip_atomic_fetch_add(p, v, __ATOMIC_RELAXED, __HIP_MEMORY_SCOPE_AGENT); }
__device__ __forceinline__ unsigned xb_xcc_id() { return (unsigned)__builtin_amdgcn_s_getreg((3 << 11) | 20) & 0xFu; }
#define XB_SPIN(cond, bar) do { unsigned _sp = 0; while (cond) { __builtin_amdgcn_s_sleep(1); \
    if ((++_sp & 255u) == 0u) { if (xb_ld(&(bar)[XB_TMO])) break; if (_sp > XB_SPIN_CAP) { atomicAdd(&(bar)[XB_TMO], 1u); break; } } } } while (0)

struct XcdBarrier {
    unsigned* bar; unsigned x;
    volatile LAS unsigned* st;
};

__device__ __forceinline__ XcdBarrier xcd_barrier_post(unsigned* bar, volatile LAS unsigned* st) {
    XcdBarrier b; b.bar = bar; b.x = xb_xcc_id(); b.st = st;
    if (threadIdx.x == 0) (void)xb_add(&bar[XB_XCNT(b.x)], 1u);
    return b;
}
__device__ __forceinline__ void xcd_barrier_complete(unsigned* bar, unsigned x, unsigned& nloc, unsigned& nx) {
    const unsigned G = gridDim.x * gridDim.y * gridDim.z;
    unsigned sum, cnt, mine, sp = 0u;
    for (;;) {
        sum = 0u; cnt = 0u; mine = 0u;
#pragma unroll
        for (unsigned j = 0; j < 16; ++j) { const unsigned c = xb_ld(&bar[XB_XCNT(j)]); sum += c; cnt += (c > 0u) ? 1u : 0u; mine = (j == x) ? c : mine; }
        if (sum == G) break;
        __builtin_amdgcn_s_sleep(1);
        if ((++sp & 255u) == 0u) { if (xb_ld(&bar[XB_TMO])) break; if (sp > XB_SPIN_CAP) { atomicAdd(&bar[XB_TMO], 1u); break; } }
    }
    nloc = mine > 0u ? mine : 1u; nx = cnt > 0u ? cnt : 1u;
}

__device__ __forceinline__ void xcd_barrier(const XcdBarrier& b) {
    asm volatile("s_waitcnt vmcnt(0)" ::: "memory");
    __syncthreads();
    if (threadIdx.x == 0) {
        unsigned* bar = b.bar;
        __builtin_amdgcn_s_waitcnt(0);
        unsigned nloc = b.st[0], nx = b.st[1];
        if (nloc == 0u) { xcd_barrier_complete(bar, b.x, nloc, nx); b.st[0] = nloc; b.st[1] = nx; }
        const unsigned old = xb_add(&bar[XB_XSUB(b.x)], 1u);
        const unsigned gen = old / nloc;
        if (old + 1u == (gen + 1u) * nloc) {
            __builtin_amdgcn_fence(__ATOMIC_RELEASE, "agent");
            asm volatile("s_waitcnt vmcnt(0)" ::: "memory");
            const unsigned og = xb_add(&bar[XB_TOP], 1u);
            const unsigned tg = og / nx;
            if (og + 1u == (tg + 1u) * nx) xb_add(&bar[XB_TOPGEN], 1u);
            else XB_SPIN(xb_ld(&bar[XB_TOPGEN]) == tg, bar);
            __builtin_amdgcn_fence(__ATOMIC_ACQUIRE, "agent");
            xb_add(&bar[XB_XGEN(b.x)], 1u);
            asm volatile("s_waitcnt vmcnt(0)" ::: "memory");
        } else {
            XB_SPIN(xb_ld(&bar[XB_XGEN(b.x)]) == gen, bar);
            __builtin_amdgcn_fence(__ATOMIC_ACQUIRE, "agent");
            asm volatile("s_waitcnt vmcnt(0)" ::: "memory");
        }
    }
    __syncthreads();
}

constexpr int NWAVES = 8;
constexpr int BATCH = 8, SEQ = 4096, D = 1024, FF = 2816, NIN = 3072, NH = 4;
constexpr int M = BATCH * SEQ;
constexpr float EPS = 1e-6f;
constexpr float LAM_INIT = 0.2f;
constexpr float LOG2E = 1.4426950408889634f;

constexpr size_t MiB = 1u << 20;
constexpr size_t WS_CTL = 0, CTL_ZERO_BYTES = 1 * MiB;
constexpr size_t WS_SS = 1 * MiB;
constexpr size_t WS_WGU1 = 2 * MiB, WS_WD1 = 13 * MiB, WS_WIN = 19 * MiB, WS_WOUT = 25 * MiB, WS_WGU2 = 27 * MiB, WS_WD2 = 38 * MiB;
constexpr size_t WS_XB = 48 * MiB;
constexpr size_t WS_H = 112 * MiB;
constexpr size_t WS_Q = WS_H, WS_K = WS_H + 32 * MiB, WS_V = WS_H + 64 * MiB, WS_GB = WS_H + 96 * MiB, WS_U = WS_H + 128 * MiB;
constexpr size_t WS_MIX = 288 * MiB;
constexpr size_t WS_O = 352 * MiB;
constexpr size_t WS_END = 416 * MiB;
static_assert(WS_WD2 + (size_t)D * FF * 2 <= WS_XB && WS_U + (size_t)M * 512 * 2 <= WS_H + (size_t)M * FF * 2 && WS_H + (size_t)M * FF * 2 <= WS_MIX, "d_ws map");
constexpr int CW_TMO = 0, CW_CODE = 1, CW_BAR = 4096;

constexpr int RING_OFF = 0, RING_BYTES = 131072;
constexpr int LDS_BYTES = 163840;
constexpr int LDSCTL_OFF = LDS_BYTES - 512, MISC_OFF = LDSCTL_OFF + 320;
static_assert(MISC_OFF + 128 <= LDS_BYTES && RING_BYTES <= LDSCTL_OFF, "LDS map");

typedef unsigned u32x4 __attribute__((ext_vector_type(4)));
typedef float f32x16 __attribute__((ext_vector_type(16)));
typedef short s16x4 __attribute__((ext_vector_type(4)));

struct Frame {
    LAS unsigned char* lds;
    volatile LAS unsigned* MISC;
    gu32* ctl;
    int tid, lane, wave, vcu, G;
};

__device__ __forceinline__ float wave_sum(float v) {
#pragma unroll
    for (int o = 1; o < 64; o <<= 1) v += __shfl_xor(v, o);
    return v;
}

__device__ __forceinline__ void transpose_item(const float* W, int srcN, int s0, int k0, const float* gain, bf16* WT, int K, int n0, LAS float* scr, int lane) {
#pragma unroll 8
    for (int i = 0; i < 32; ++i) { const int kk = 2 * i + (lane >> 5); float v = W[(size_t)(k0 + kk) * srcN + s0 + (lane & 31)]; if (gain) v *= gain[k0 + kk]; scr[kk * 33 + (lane & 31)] = v; }
    LDS_WAIT(); asm volatile("" ::: "memory");
    const int c = lane & 7;
#pragma unroll
    for (int j = 0; j < 4; ++j) { const int n = (lane >> 3) + 8 * j; const LAS float* s = scr + (8 * c) * 33 + n;
        v4u o; o.x = pk2(s[0 * 33], s[1 * 33]); o.y = pk2(s[2 * 33], s[3 * 33]); o.z = pk2(s[4 * 33], s[5 * 33]); o.w = pk2(s[6 * 33], s[7 * 33]);
        *(GAS v4u*)(WT + (size_t)(n0 + n) * K + k0 + 8 * c) = o; }
    LDS_WAIT(); asm volatile("" ::: "memory");
}
struct Args { const float* in[22]; float* out; unsigned char* ws; int ph_lo, ph_hi; };

__device__ __forceinline__ void p0_prologue(Frame& F, const Args& A) {
    LAS float* scr = (LAS float*)(F.lds + RING_OFF + F.wave * 16384);
    const int gw = F.vcu * NWAVES + F.wave, NGW = F.G * NWAVES;
    unsigned char* ws = A.ws;
    constexpr int I_GU = (D / 64) * (2 * FF / 32), I_DN = (FF / 64) * (D / 32), I_IN = (D / 64) * (NIN / 32), I_OUT = (D / 64) * (D / 32);
    constexpr int NITEMS = 2 * I_GU + 2 * I_DN + I_IN + I_OUT;
    for (int it = gw; it < NITEMS; it += NGW) {
        int r = it;
        if (r < 2 * I_GU) {
            const int l = r >= I_GU; if (l) r -= I_GU;
            constexpr int nblk = 2 * FF / 32; const int kb = r / nblk, nb = r % nblk, n0 = 32 * nb;
            const int pn = n0 >> 8, half = (n0 >> 7) & 1, j = n0 & 127;
            const float* W = A.in[l ? (half ? 19 : 18) : (half ? 3 : 2)];
            transpose_item(W, FF, 128 * pn + j, 64 * kb, A.in[l ? 17 : 1], (bf16*)(ws + (l ? WS_WGU2 : WS_WGU1)), D, n0, scr, F.lane);
            continue;
        }
        r -= 2 * I_GU;
        if (r < 2 * I_DN) {
            const int l = r >= I_DN; if (l) r -= I_DN;
            constexpr int nblk = D / 32; const int kb = r / nblk, nb = r % nblk;
            transpose_item(A.in[l ? 20 : 4], D, 32 * nb, 64 * kb, nullptr, (bf16*)(ws + (l ? WS_WD2 : WS_WD1)), FF, 32 * nb, scr, F.lane);
            continue;
        }
        r -= 2 * I_DN;
        if (r < I_IN) {
            constexpr int nblk = NIN / 32; const int kb = r / nblk, nb = r % nblk, n0 = 32 * nb;
            const int pn = n0 >> 8, half = (n0 >> 7) & 1, j = n0 & 127;
            int s0;
            if (pn < 4) s0 = (pn >> 1) * 512 + 64 * (4 * (pn & 1) + (j >> 5)) + 32 * half;
            else if (pn < 8) s0 = n0;
            else s0 = (half ? 2560 : 2048) + 128 * (pn - 8) + j;
            transpose_item(A.in[6], NIN, s0, 64 * kb, A.in[5], (bf16*)(ws + WS_WIN), D, n0, scr, F.lane);
            continue;
        }
        r -= I_IN;
        { constexpr int nblk = D / 32; const int kb = r / nblk, nb = r % nblk;
          transpose_item(A.in[16], D, 32 * nb, 64 * kb, nullptr, (bf16*)(ws + WS_WOUT), D, 32 * nb, scr, F.lane); }
    }
    const float* x = A.in[0]; bf16* xb = (bf16*)(ws + WS_XB); float* ss = (float*)(ws + WS_SS);
    for (int m = gw; m < M; m += NGW) {
        const GAS f32x4* xr = (const GAS f32x4*)(x + (size_t)m * D) + F.lane;
        f32x4 v[4]; float s = 0.f;
#pragma unroll
        for (int j = 0; j < 4; ++j) { v[j] = xr[64 * j]; s += (v[j].x * v[j].x + v[j].y * v[j].y) + (v[j].z * v[j].z + v[j].w * v[j].w); }
        s = wave_sum(s);
        GAS unsigned long long* o8 = (GAS unsigned long long*)(xb + (size_t)m * D) + F.lane;
#pragma unroll
        for (int j = 0; j < 4; ++j) o8[64 * j] = (unsigned long long)pk2(v[j].x, v[j].y) | ((unsigned long long)pk2(v[j].z, v[j].w) << 32);
        if (F.lane == 0) { ss[m] = s; ss[M + m] = 0.f; ss[2 * M + m] = 0.f; }
    }
}

namespace att {
constexpr int L_K = 0, L_V = 16384, L_WS = 49152, L_Q = 53248, L_OST = 86016, L_END = L_OST + 65536;
constexpr float THR = 8.0f;
static_assert(L_END <= LDSCTL_OFF, "attention LDS");
__device__ __forceinline__ int crow(int r, int hi) { return (r & 3) + 8 * (r >> 2) + 4 * hi; }
typedef __bf16 bf16x2_t __attribute__((ext_vector_type(2))); typedef float f32x2_t __attribute__((ext_vector_type(2)));
__device__ __forceinline__ unsigned cvtpk(float lo, float hi) { f32x2_t v = {lo, hi}; bf16x2_t b = __builtin_convertvector(v, bf16x2_t); return __builtin_bit_cast(unsigned, b); }
typedef short v4i16_t __attribute__((ext_vector_type(4)));
__device__ __forceinline__ s16x4 vtr(LAS const unsigned char* p) { return __builtin_bit_cast(s16x4, __builtin_amdgcn_ds_read_tr16_b64_v4i16((LAS v4i16_t*)p)); }
#define MX3(a, b, c) __builtin_fmaxf(__builtin_fmaxf((a), (b)), (c))
#define EX2(v) __builtin_amdgcn_exp2f(v)

__device__ __forceinline__ void attn_pass(f32x16 (&o)[4], float& lrun, int mc, int h, size_t rowbase, int q0, const bf16* Qg, const bf16* Kg, const bf16* Vg, LAS unsigned char* shm,
                                          int tid, int lane, int r32, int hi, int wid) {
    const float sl2 = LOG2E * EX2(-2.0f * (float)(h + 1));
    LAS float* wsf = (LAS float*)(shm + L_WS) + wid * 128;
    LAS unsigned char* Qf = shm + L_Q + wid * 4096;
    const int NT = (q0 + 256) / 64;
    const unsigned char* kbase_u = (const unsigned char*)(Kg + rowbase * 512 + h * 128 + mc * 64 + wid * 8);
    unsigned koff = (unsigned)lane * 1024u; asm volatile("" : "+v"(koff));
    const int vp0 = wid * 2, vp1 = wid * 2 + 1;
    const unsigned char* vbase0_u = (const unsigned char*)(Vg + (rowbase + 16 * (vp0 & 3)) * 512 + h * 128 + (vp0 >> 2) * 32);
    const unsigned char* vbase1_u = (const unsigned char*)(Vg + (rowbase + 16 * (vp1 & 3)) * 512 + h * 128 + (vp1 >> 2) * 32);
    unsigned voff = (unsigned)(lane >> 2) * 1024u + (unsigned)(lane & 3) * 16u; asm volatile("" : "+v"(voff));
#define DMA_K(t, slot) __builtin_amdgcn_global_load_lds((const unsigned*)(kbase_u + (size_t)(t) * 65536 + koff), (LAS unsigned*)(shm + L_K + (slot) * 8192 + wid * 1024), 16, 0, 0)
#define DMA_V(t, slot) do { const size_t go_ = (size_t)(t) * 65536; LAS unsigned char* sb_ = shm + L_V + (slot) * 16384; \
        __builtin_amdgcn_global_load_lds((const unsigned*)(vbase0_u + go_ + voff), (LAS unsigned*)(sb_ + vp0 * 1024), 16, 0, 0); \
        __builtin_amdgcn_global_load_lds((const unsigned*)(vbase1_u + go_ + voff), (LAS unsigned*)(sb_ + vp1 * 1024), 16, 0, 0); } while (0)
    __syncthreads();
    DMA_K(NT - 1, 0);
    {
        const bf16* qp = Qg + (rowbase + q0 + wid * 32 + r32) * 512 + h * 128 + mc * 64 + hi * 8;
#pragma unroll
        for (int d0 = 0; d0 < 4; ++d0) *(LAS u32x4*)(Qf + d0 * 1024 + lane * 16) = *(const GAS u32x4*)(qp + d0 * 16);
    }
#pragma unroll
    for (int d = 0; d < 4; ++d)
#pragma unroll
        for (int r = 0; r < 16; ++r) o[d][r] = 0.f;
    float mhat = 0.f; lrun = 0.f;
    const int irel = wid * 32 + r32;
    f32x16 cb;
#pragma unroll
    for (int r = 0; r < 16; ++r) cb[r] = sl2 * (float)(crow(r, hi) - irel);
    const LAS unsigned char* vbl = (const LAS unsigned char*)shm + L_V + ((lane >> 4) & 1) * 32 + (lane & 3) * 8 + (4 * hi + ((lane & 15) >> 2)) * 64;
    const LAS unsigned char* kbl = (const LAS unsigned char*)shm + L_K + hi * 1024 + r32 * 16;
    f32x16 pc0, pc1;
    bool resc = false;
#define SBAR() __builtin_amdgcn_sched_barrier(0)
#define QK_TILE(sn0, sn1, t, ks, FILL) do { const float at_ = sl2 * (float)(64 * (t) - q0) - mhat, at1_ = at_ + 32.0f * sl2; \
        _Pragma("unroll") for (int r = 0; r < 16; ++r) { sn0[r] = cb[r] + at_; sn1[r] = cb[r] + at1_; } \
        const LAS unsigned char* kb_ = kbl + (ks) * 8192; \
        bf16x8 qn_ = *(LAS const bf16x8*)(Qf + lane * 16), b0n_ = *(LAS const bf16x8*)(kb_), b1n_ = *(LAS const bf16x8*)(kb_ + 512); \
        SBAR(); \
        _Pragma("unroll") for (int d0 = 0; d0 < 4; ++d0) { \
            const bf16x8 qf_ = qn_, b0_ = b0n_, b1_ = b1n_; \
            if (d0 < 3) { qn_ = *(LAS const bf16x8*)(Qf + (d0 + 1) * 1024 + lane * 16); b0n_ = *(LAS const bf16x8*)(kb_ + (d0 + 1) * 2048); b1n_ = *(LAS const bf16x8*)(kb_ + (d0 + 1) * 2048 + 512); } \
            sn0 = __builtin_amdgcn_mfma_f32_32x32x16_bf16(b0_, qf_, sn0, 0, 0, 0); \
            sn1 = __builtin_amdgcn_mfma_f32_32x32x16_bf16(b1_, qf_, sn1, 0, 0, 0); \
            FILL(d0); SBAR(); } } while (0)
#define NOFILL(d0) do {} while (0)
#define DECIDE(sn0, sn1, t) do { const int jb_ = (t) - (NT - 4); \
        if (jb_ >= 0) { const int kb0_ = 64 * jb_ + 4 * hi; \
            _Pragma("unroll") for (int r = 0; r < 16; ++r) { const int kv_ = kb0_ + (r & 3) + 8 * (r >> 2); if (kv_ > irel) sn0[r] = -INFINITY; if (kv_ + 32 > irel) sn1[r] = -INFINITY; } } \
        float ra_ = MX3(sn0[0], sn0[1], sn1[0]), rb_ = MX3(sn0[2], sn0[3], sn1[1]); ra_ = MX3(ra_, sn1[2], sn1[3]); \
        _Pragma("unroll") for (int r = 4; r < 16; r += 4) { ra_ = MX3(ra_, sn0[r], sn0[r + 1]); rb_ = MX3(rb_, sn0[r + 2], sn0[r + 3]); ra_ = MX3(ra_, sn1[r], sn1[r + 1]); rb_ = MX3(rb_, sn1[r + 2], sn1[r + 3]); } \
        float rm_ = __builtin_fmaxf(ra_, rb_); rm_ = __builtin_fmaxf(rm_, __shfl_xor(rm_, 32)); \
        resc = false; \
        if (__any(rm_ > THR)) { const float dl_ = __builtin_fmaxf(rm_, 0.f); mhat += dl_; \
            _Pragma("unroll") for (int r = 0; r < 16; ++r) { sn0[r] -= dl_; sn1[r] -= dl_; } \
            const float f_ = EX2(-dl_); lrun *= f_; if (hi == 0) wsf[r32] = f_; resc = true; } } while (0)
#define RESCALE_O() do { if (resc) { LDS_WAIT(); asm volatile("" ::: "memory"); \
        _Pragma("unroll") for (int r = 0; r < 16; ++r) { const float fr_ = wsf[crow(r, hi)]; _Pragma("unroll") for (int d = 0; d < 4; ++d) o[d][r] *= fr_; } \
        LDS_WAIT(); asm volatile("" ::: "memory"); } } while (0)
    asm volatile("s_waitcnt vmcnt(0)" ::: "memory");
    __syncthreads();
    DMA_K(NT - 2, 1); DMA_V(NT - 1, 0);
    QK_TILE(pc0, pc1, NT - 1, 0, NOFILL);
    DECIDE(pc0, pc1, NT - 1);
#pragma unroll
    for (int r = 0; r < 16; ++r) { pc0[r] = EX2(pc0[r]); pc1[r] = EX2(pc1[r]); }
    for (int i = 1; i < NT; ++i) {
        const int t = NT - 1 - i;
        asm volatile("s_waitcnt vmcnt(0)" ::: "memory");
        __syncthreads();
        if (i + 1 < NT) DMA_K(t - 1, (i + 1) & 1);
        DMA_V(t, i & 1);
        f32x16 sn0, sn1; u32x4 pw[4]; float s0 = 0.f, s1 = 0.f;
#define PFILL(d0) do { if ((d0) < 2) { _Pragma("unroll") for (int r = 0; r < 8; ++r) s0 += pc0[8 * (d0) + r]; \
                pw[d0] = (u32x4){cvtpk(pc0[8 * (d0)], pc0[8 * (d0) + 1]), cvtpk(pc0[8 * (d0) + 2], pc0[8 * (d0) + 3]), cvtpk(pc0[8 * (d0) + 4], pc0[8 * (d0) + 5]), cvtpk(pc0[8 * (d0) + 6], pc0[8 * (d0) + 7])}; asm volatile("" : "+v"(pw[d0]), "+v"(s0)); } \
            else { _Pragma("unroll") for (int r = 0; r < 8; ++r) s1 += pc1[8 * ((d0) - 2) + r]; \
                pw[d0] = (u32x4){cvtpk(pc1[8 * ((d0) - 2)], pc1[8 * ((d0) - 2) + 1]), cvtpk(pc1[8 * ((d0) - 2) + 2], pc1[8 * ((d0) - 2) + 3]), cvtpk(pc1[8 * ((d0) - 2) + 4], pc1[8 * ((d0) - 2) + 5]), cvtpk(pc1[8 * ((d0) - 2) + 6], pc1[8 * ((d0) - 2) + 7])}; asm volatile("" : "+v"(pw[d0]), "+v"(s1)); } } while (0)
        QK_TILE(sn0, sn1, t, i & 1, PFILL);
#undef PFILL
        lrun += s0 + s1;
        DECIDE(sn0, sn1, t);
        const LAS unsigned char* vb = vbl + ((i - 1) & 1) * 16384;
#define VFRAG(idx) ((idx) & 3) * 4096 + ((idx) >> 2) * 1024
        s16x4 vl0 = vtr(vb + VFRAG(0)), vh0 = vtr(vb + VFRAG(0) + 512), vl1, vh1;
        SBAR();
#pragma unroll
        for (int idx = 0; idx < 16; ++idx) {
            const int d0 = idx & 3, ks = idx >> 2;
            if (idx + 1 < 16) { vl1 = vtr(vb + VFRAG(idx + 1)); vh1 = vtr(vb + VFRAG(idx + 1) + 512); }
            const bf16x8 vf = (bf16x8){vl0[0], vl0[1], vl0[2], vl0[3], vh0[0], vh0[1], vh0[2], vh0[3]};
            o[d0] = __builtin_amdgcn_mfma_f32_32x32x16_bf16(__builtin_bit_cast(bf16x8, pw[ks]), vf, o[d0], 0, 0, 0);
            if (idx < 8) { sn0[2 * idx] = EX2(sn0[2 * idx]); sn0[2 * idx + 1] = EX2(sn0[2 * idx + 1]); }
            else { sn1[2 * idx - 16] = EX2(sn1[2 * idx - 16]); sn1[2 * idx - 15] = EX2(sn1[2 * idx - 15]); }
            if (idx < 8) asm volatile("" : "+v"(sn0)); else asm volatile("" : "+v"(sn1));
            vl0 = vl1; vh0 = vh1;
            SBAR();
        }
        RESCALE_O();
        pc0 = sn0; pc1 = sn1;
    }
    asm volatile("s_waitcnt vmcnt(0)" ::: "memory");
    __syncthreads();
    {
        float s0 = 0.f, s1 = 0.f;
#pragma unroll
        for (int r = 0; r < 16; ++r) { s0 += pc0[r]; s1 += pc1[r]; }
        lrun += s0 + s1;
        u32x4 pw[4];
        pw[0] = (u32x4){cvtpk(pc0[0], pc0[1]), cvtpk(pc0[2], pc0[3]), cvtpk(pc0[4], pc0[5]), cvtpk(pc0[6], pc0[7])};
        pw[1] = (u32x4){cvtpk(pc0[8], pc0[9]), cvtpk(pc0[10], pc0[11]), cvtpk(pc0[12], pc0[13]), cvtpk(pc0[14], pc0[15])};
        pw[2] = (u32x4){cvtpk(pc1[0], pc1[1]), cvtpk(pc1[2], pc1[3]), cvtpk(pc1[4], pc1[5]), cvtpk(pc1[6], pc1[7])};
        pw[3] = (u32x4){cvtpk(pc1[8], pc1[9]), cvtpk(pc1[10], pc1[11]), cvtpk(pc1[12], pc1[13]), cvtpk(pc1[14], pc1[15])};
        const LAS unsigned char* vb = vbl + ((NT - 1) & 1) * 16384;
        s16x4 vl0 = vtr(vb + VFRAG(0)), vh0 = vtr(vb + VFRAG(0) + 512), vl1, vh1;
        SBAR();
#pragma unroll
        for (int idx = 0; idx < 16; ++idx) {
            const int d0 = idx & 3, ks = idx >> 2;
            if (idx + 1 < 16) { vl1 = vtr(vb + VFRAG(idx + 1)); vh1 = vtr(vb + VFRAG(idx + 1) + 512); }
            const bf16x8 vf = (bf16x8){vl0[0], vl0[1], vl0[2], vl0[3], vh0[0], vh0[1], vh0[2], vh0[3]};
            o[d0] = __builtin_amdgcn_mfma_f32_32x32x16_bf16(__builtin_bit_cast(bf16x8, pw[ks]), vf, o[d0], 0, 0, 0);
            vl0 = vl1; vh0 = vh1;
            SBAR();
        }
    }
#undef VFRAG
#undef SBAR
#undef NOFILL
#undef DMA_K
#undef DMA_V
#undef QK_TILE
#undef DECIDE
#undef RESCALE_O
}

__device__ __forceinline__ void attn_unit(int b, int h, int qb, const bf16* Qg, const bf16* Kg, const bf16* Vg, bf16* MIX, const float* subln, float lam, LAS unsigned char* shm) {
    const int tid = threadIdx.x, lane = tid & 63, r32 = lane & 31, hi = lane >> 5; const int wid = __builtin_amdgcn_readfirstlane(tid >> 6);
    const size_t rowbase = (size_t)b * SEQ; const int q0 = qb * 256;
    LAS float* wsf = (LAS float*)(shm + L_WS) + wid * 128;
    LAS unsigned char* ost = shm + L_OST + wid * 8192;
    f32x16 o[4]; float lrun;
    attn_pass(o, lrun, 0, h, rowbase, q0, Qg, Kg, Vg, shm, tid, lane, r32, hi, wid);
    lrun += __shfl_xor(lrun, 32);
    if (hi == 0) wsf[r32] = 1.0f / lrun;
    LDS_WAIT(); asm volatile("" ::: "memory");
    {
        float f[16];
#pragma unroll
        for (int r = 0; r < 16; ++r) f[r] = wsf[crow(r, hi)];
#pragma unroll
        for (int d = 0; d < 4; ++d) {
            u32x4 w0, w1;
            w0 = (u32x4){cvtpk(o[d][0] * f[0], o[d][1] * f[1]), cvtpk(o[d][2] * f[2], o[d][3] * f[3]), cvtpk(o[d][4] * f[4], o[d][5] * f[5]), cvtpk(o[d][6] * f[6], o[d][7] * f[7])};
            w1 = (u32x4){cvtpk(o[d][8] * f[8], o[d][9] * f[9]), cvtpk(o[d][10] * f[10], o[d][11] * f[11]), cvtpk(o[d][12] * f[12], o[d][13] * f[13]), cvtpk(o[d][14] * f[14], o[d][15] * f[15])};
            *(LAS u32x4*)(ost + (2 * d) * 1024 + lane * 16) = w0; *(LAS u32x4*)(ost + (2 * d + 1) * 1024 + lane * 16) = w1;
        }
    }
    LDS_WAIT(); asm volatile("" ::: "memory");
    attn_pass(o, lrun, 1, h, rowbase, q0, Qg, Kg, Vg, shm, tid, lane, r32, hi, wid);
    lrun += __shfl_xor(lrun, 32);
    if (hi == 0) wsf[r32] = lam / lrun;
    LDS_WAIT(); asm volatile("" ::: "memory");
    float g[4];
#pragma unroll
    for (int d = 0; d < 4; ++d) g[d] = subln[32 * d + r32] * (1.0f - LAM_INIT);
    int lane_off = h * 128 + r32 + 4 * hi * 1024; asm volatile("" : "+v"(lane_off));
    bf16* op = MIX + (rowbase + q0 + wid * 32) * 1024 + lane_off;
    {
        float f1[16];
#pragma unroll
        for (int r = 0; r < 16; ++r) f1[r] = wsf[crow(r, hi)];
#pragma unroll
        for (int d = 0; d < 4; ++d) {
            const u32x4 wa = *(LAS const u32x4*)(ost + (2 * d) * 1024 + lane * 16), wb = *(LAS const u32x4*)(ost + (2 * d + 1) * 1024 + lane * 16);
#pragma unroll
            for (int r = 0; r < 16; ++r) {
                const unsigned w = (r < 8 ? wa : wb)[(r >> 1) & 3];
                const float o0v = (r & 1) ? __uint_as_float(w & 0xffff0000u) : __uint_as_float(w << 16);
                o[d][r] = o0v - o[d][r] * f1[r];
            }
        }
    }
#pragma unroll
    for (int r = 0; r < 16; ++r) {
        const int cr0 = (r & 3) + 8 * (r >> 2);
        float s = (o[0][r] * o[0][r] + o[1][r] * o[1][r]) + (o[2][r] * o[2][r] + o[3][r] * o[3][r]);
        s += __shfl_xor(s, 1); s += __shfl_xor(s, 2); s += __shfl_xor(s, 4); s += __shfl_xor(s, 8); s += __shfl_xor(s, 16);
        const float rn = __builtin_amdgcn_rsqf(s * (1.0f / 128.0f) + EPS);
#pragma unroll
        for (int d = 0; d < 4; ++d) op[cr0 * 1024 + 32 * d] = (bf16)f2bf(o[d][r] * rn * g[d]);
    }
    LDS_WAIT(); asm volatile("" ::: "memory");
}
#undef MX3
#undef EX2
}

__device__ __forceinline__ void conv_phase(Frame& F, const bf16* U, const bf16* GB, const float* cw, const float* cn, bf16* MIX) {
    const int gw = F.vcu * NWAVES + F.wave, NGW = F.G * NWAVES; const int ch0 = F.lane * 8;
    float w0[8], w1[8], w2[8], gn[8];
#pragma unroll
    for (int i = 0; i < 8; ++i) { w0[i] = cw[ch0 + i]; w1[i] = cw[512 + ch0 + i]; w2[i] = cw[1024 + ch0 + i]; gn[i] = cn[ch0 + i]; }
    for (int g = gw; g < M / 16; g += NGW) {
        const int t0 = 16 * g;
        float um2[8], um1[8];
        if ((t0 & (SEQ - 1)) == 0) {
#pragma unroll
            for (int i = 0; i < 8; ++i) { um2[i] = 0.f; um1[i] = 0.f; }
        } else {
            const v4u a = *(const GAS v4u*)(U + (size_t)(t0 - 2) * 512 + ch0), b = *(const GAS v4u*)(U + (size_t)(t0 - 1) * 512 + ch0);
#pragma unroll
            for (int i = 0; i < 4; ++i) { um2[2 * i] = __uint_as_float(a[i] << 16); um2[2 * i + 1] = __uint_as_float(a[i] & 0xffff0000u); um1[2 * i] = __uint_as_float(b[i] << 16); um1[2 * i + 1] = __uint_as_float(b[i] & 0xffff0000u); }
        }
        for (int t = t0; t < t0 + 16; ++t) {
            const v4u a = *(const GAS v4u*)(U + (size_t)t * 512 + ch0), b = *(const GAS v4u*)(GB + (size_t)t * 512 + ch0);
            float ut[8], gb[8], c[8]; float s = 0.f;
#pragma unroll
            for (int i = 0; i < 4; ++i) { ut[2 * i] = __uint_as_float(a[i] << 16); ut[2 * i + 1] = __uint_as_float(a[i] & 0xffff0000u); gb[2 * i] = __uint_as_float(b[i] << 16); gb[2 * i + 1] = __uint_as_float(b[i] & 0xffff0000u); }
#pragma unroll
            for (int i = 0; i < 8; ++i) { c[i] = gb[i] * (w0[i] * um2[i] + w1[i] * um1[i] + w2[i] * ut[i]); s += c[i] * c[i]; um2[i] = um1[i]; um1[i] = ut[i]; }
            s += __shfl_xor(s, 1); s += __shfl_xor(s, 2); s += __shfl_xor(s, 4);
            const float rn = __builtin_amdgcn_rsqf(s * (1.0f / 64.0f) + EPS);
            v4u o;
#pragma unroll
            for (int i = 0; i < 4; ++i) o[i] = pk2(c[2 * i] * rn * gn[2 * i], c[2 * i + 1] * rn * gn[2 * i + 1]);
            *(GAS v4u*)(MIX + (size_t)t * 1024 + 512 + ch0) = o;
        }
    }
}

__device__ __forceinline__ void combine_phase(Frame& F, const bf16* OB, const float* subln, float lam, bf16* MIX) {
    const int gw = F.vcu * NWAVES + F.wave, NGW = F.G * NWAVES; const int hh = F.lane >> 4, d0 = 8 * (F.lane & 15);
    float gn[8];
#pragma unroll
    for (int i = 0; i < 8; ++i) gn[i] = subln[d0 + i] * (1.0f - LAM_INIT);
    for (int t = gw; t < M; t += NGW) {
        const v4u a = *(const GAS v4u*)(OB + (size_t)t * 1024 + hh * 256 + d0), b = *(const GAS v4u*)(OB + (size_t)t * 1024 + hh * 256 + 128 + d0);
        float c[8]; float s = 0.f;
#pragma unroll
        for (int i = 0; i < 4; ++i) { c[2 * i] = __uint_as_float(a[i] << 16) - lam * __uint_as_float(b[i] << 16); c[2 * i + 1] = __uint_as_float(a[i] & 0xffff0000u) - lam * __uint_as_float(b[i] & 0xffff0000u); }
#pragma unroll
        for (int i = 0; i < 8; ++i) s += c[i] * c[i];
        s += __shfl_xor(s, 1); s += __shfl_xor(s, 2); s += __shfl_xor(s, 4); s += __shfl_xor(s, 8);
        const float rn = __builtin_amdgcn_rsqf(s * (1.0f / 128.0f) + EPS);
        v4u o;
#pragma unroll
        for (int i = 0; i < 4; ++i) o[i] = pk2(c[2 * i] * rn * gn[2 * i], c[2 * i + 1] * rn * gn[2 * i + 1]);
        *(GAS v4u*)(MIX + (size_t)t * 1024 + hh * 128 + d0) = o;
    }
}

__device__ __forceinline__ void final_norm_phase(Frame& F, const bf16* xb, float* out, const float* gain) {
    const int gw = F.vcu * NWAVES + F.wave, NGW = F.G * NWAVES;
    f32x4 gv[4];
#pragma unroll
    for (int j = 0; j < 4; ++j) gv[j] = *((const GAS f32x4*)gain + 4 * F.lane + j);
    for (int m = gw; m < M; m += NGW) {
        const GAS v4u* xr = (const GAS v4u*)(xb + (size_t)m * D) + 2 * F.lane;
        const v4u a = xr[0], b = xr[1];
        f32x4 v[4]; float s = 0.f;
        v[0] = (f32x4){__uint_as_float(a.x << 16), __uint_as_float(a.x & 0xffff0000u), __uint_as_float(a.y << 16), __uint_as_float(a.y & 0xffff0000u)};
        v[1] = (f32x4){__uint_as_float(a.z << 16), __uint_as_float(a.z & 0xffff0000u), __uint_as_float(a.w << 16), __uint_as_float(a.w & 0xffff0000u)};
        v[2] = (f32x4){__uint_as_float(b.x << 16), __uint_as_float(b.x & 0xffff0000u), __uint_as_float(b.y << 16), __uint_as_float(b.y & 0xffff0000u)};
        v[3] = (f32x4){__uint_as_float(b.z << 16), __uint_as_float(b.z & 0xffff0000u), __uint_as_float(b.w << 16), __uint_as_float(b.w & 0xffff0000u)};
#pragma unroll
        for (int j = 0; j < 4; ++j) s += (v[j].x * v[j].x + v[j].y * v[j].y) + (v[j].z * v[j].z + v[j].w * v[j].w);
        s = wave_sum(s);
        const float r = __builtin_amdgcn_rsqf(s * (1.0f / D) + EPS);
        GAS f32x4* orow = (GAS f32x4*)(out + (size_t)m * D) + 4 * F.lane;
#pragma unroll
        for (int j = 0; j < 4; ++j) orow[j] = v[j] * r * gv[j];
    }
}

constexpr int N_PHASES = 9;
__global__ void __launch_bounds__(NWAVES * 64, 2) fwd_kernel(Args args) {
    extern __shared__ __attribute__((aligned(16))) unsigned char lds[];
    Frame F;
    F.lds = (LAS unsigned char*)lds;
    F.MISC = (volatile LAS unsigned*)(F.lds + MISC_OFF);
    F.tid = threadIdx.x; F.lane = F.tid & 63; F.wave = __builtin_amdgcn_readfirstlane(F.tid >> 6);
    F.G = gridDim.x; { const int bx = blockIdx.x; F.vcu = (F.G % 8 == 0) ? (bx % 8) * (F.G / 8) + bx / 8 : bx; }
    unsigned char* ws = args.ws;
    F.ctl = (gu32*)(ws + WS_CTL);
    for (int u = F.tid; u < (LDS_BYTES - LDSCTL_OFF) / 4; u += NWAVES * 64) ((LAS unsigned*)(F.lds + LDSCTL_OFF))[u] = 0u;
    __syncthreads();
    const int lo = args.ph_lo, hi = args.ph_hi;
    const bool one_launch = (hi - lo) > 1;
    XcdBarrier bar; bar.bar = (unsigned*)(F.ctl + CW_BAR); bar.x = 0; bar.st = nullptr;
    if (one_launch) bar = xcd_barrier_post((unsigned*)(F.ctl + CW_BAR), F.MISC + 8);
#ifndef PHASE_MASK
#define PHASE_MASK 0x1ff
#endif
#define IN(k) (((PHASE_MASK >> (k)) & 1) && lo <= (k) && (k) < hi)
#define SEAM(k) do { if (IN(k) && IN((k) + 1)) xcd_barrier(bar); } while (0)

    float* ss = (float*)(ws + WS_SS);
    bf16* XB = (bf16*)(ws + WS_XB); bf16* HB = (bf16*)(ws + WS_H); bf16* MIX = (bf16*)(ws + WS_MIX);
    bf16 *QB_ = (bf16*)(ws + WS_Q), *KB_ = (bf16*)(ws + WS_K), *VB_ = (bf16*)(ws + WS_V), *GBB = (bf16*)(ws + WS_GB), *UB = (bf16*)(ws + WS_U), *OBB = (bf16*)(ws + WS_O);

#ifndef DUP_PHASE
#define DUP_PHASE -1
#endif
#define REPS(k) for (int rep = 0; rep < ((DUP_PHASE == (k)) ? 2 : 1); ++rep)
#ifdef PROBE_PH_A
    gu64* tsw = (gu64*)(F.ctl + 2048);
#define STAMP(k) do { if (blockIdx.x == 0 && F.tid == 0) __hip_atomic_store(tsw + (k), rt(), RLX_AGENT); } while (0)
#else
#define STAMP(k) do {} while (0)
#endif
    STAMP(0);
    if (IN(0)) { p0_prologue(F, args); } SEAM(0); STAMP(1);
    if (IN(1)) REPS(1) {
        pg8::Gemm g{XB, (const bf16*)(ws + WS_WGU1), M, 2 * FF, D}; pg8::StaticOrder S; S.init(M, 2 * FF, F.G, (int)blockIdx.x);
        pg8::EpiSwiGLU E{HB, FF, ss, 1.0f / D};
        pg8::gemm_phase<pg8::EpiSwiGLU, pg8::StaticOrder, PG8_ALIGN, PG8_SP2>(F.lds + RING_OFF, g, S, E);
    } SEAM(1); STAMP(2);
    if (IN(2)) REPS(2) {
        pg8::Gemm g{HB, (const bf16*)(ws + WS_WD1), M, D, FF}; pg8::StaticOrder S; S.init(M, D, F.G, (int)blockIdx.x);
        pg8::EpiResB<true> E{args.in[0], XB, rep ? ss + 3 * M : ss + M, 0.5f};
        pg8::gemm_phase<pg8::EpiResB<true>, pg8::StaticOrder, PG8_ALIGN, PG8_SP2>(F.lds + RING_OFF, g, S, E);
    } SEAM(2); STAMP(3);
    if (IN(3)) REPS(3) {
        pg8::Gemm g{XB, (const bf16*)(ws + WS_WIN), M, NIN, D}; pg8::StaticOrder S; S.init(M, NIN, F.G, (int)blockIdx.x);
        pg8::EpiIn E{QB_, KB_, VB_, GBB, UB, ss + M, args.in[7], args.in[8], 0.125f * LOG2E};
        pg8::gemm_phase<pg8::EpiIn, pg8::StaticOrder, PG8_ALIGN, PG8_SP2>(F.lds + RING_OFF, g, S, E);
    } SEAM(3); STAMP(4);
    if (IN(4)) REPS(4) {
        conv_phase(F, UB, GBB, args.in[14], args.in[15], MIX);
        float lam;
        { const float a = args.in[9][F.lane] * args.in[10][F.lane], b2 = args.in[11][F.lane] * args.in[12][F.lane];
          lam = expf(wave_sum(a)) - expf(wave_sum(b2)) + LAM_INIT; }
        const int nun = BATCH * NH * 16;
        for (int i = 0; ; ++i) {
            const int L = i * F.G + F.vcu; if (L >= nun) break;
            const int round = L / 256, w = L % 256, bh = w >> 3, s = w & 7; const int qb = (round & 1) ? 15 - s : s;
            att::attn_unit(bh >> 2, bh & 3, qb, QB_, KB_, VB_, MIX, args.in[13], lam, F.lds + RING_OFF);
        }
    } SEAM(4); STAMP(5);
    if (IN(5)) REPS(5) {
        pg8::Gemm g{MIX, (const bf16*)(ws + WS_WOUT), M, D, D}; pg8::StaticOrder S; S.init(M, D, F.G, (int)blockIdx.x);
        pg8::EpiResB<false> E{XB, rep ? (bf16*)(ws + WS_H) : XB, rep ? ss + 3 * M : ss + 2 * M, 1.0f};
        pg8::gemm_phase<pg8::EpiResB<false>, pg8::StaticOrder, PG8_ALIGN, PG8_SP2>(F.lds + RING_OFF, g, S, E);
    } SEAM(5); STAMP(6);
    if (IN(6)) {
        pg8::Gemm g{XB, (const bf16*)(ws + WS_WGU2), M, 2 * FF, D}; pg8::StaticOrder S; S.init(M, 2 * FF, F.G, (int)blockIdx.x);
        pg8::EpiSwiGLU E{HB, FF, ss + 2 * M, 1.0f / D};
        pg8::gemm_phase<pg8::EpiSwiGLU, pg8::StaticOrder, PG8_ALIGN, PG8_SP2>(F.lds + RING_OFF, g, S, E);
    } SEAM(6); STAMP(7);
    if (IN(7)) {
        pg8::Gemm g{HB, (const bf16*)(ws + WS_WD2), M, D, FF}; pg8::StaticOrder S; S.init(M, D, F.G, (int)blockIdx.x);
        pg8::EpiResB<false> E{XB, XB, nullptr, 0.5f};
        pg8::gemm_phase<pg8::EpiResB<false>, pg8::StaticOrder, PG8_ALIGN, PG8_SP2>(F.lds + RING_OFF, g, S, E);
    } SEAM(7); STAMP(8);
    if (IN(8)) final_norm_phase(F, XB, args.out, args.in[21]);
#ifdef PROBE_PH_A
    STAMP(9);
    __syncthreads();
    if (blockIdx.x == 0 && F.wave == 0) {
        asm volatile("s_waitcnt vmcnt(0)" ::: "memory");
        const float ta = (float)(__hip_atomic_load(tsw + PROBE_PH_A + 1, RLX_AGENT) - __hip_atomic_load(tsw + PROBE_PH_A, RLX_AGENT)) * 0.01f;
        const float tb = (float)(__hip_atomic_load(tsw + PROBE_PH_B + 1, RLX_AGENT) - __hip_atomic_load(tsw + PROBE_PH_B, RLX_AGENT)) * 0.01f;
        if (F.lane == 0) args.out[0] += ta;
        for (int j = 1; j < 16; ++j) args.out[F.lane + 64 * j] += tb * 0.01f;
    }
#endif
#undef IN
#undef SEAM
}

#ifndef MK_N_LAUNCHES
#define MK_N_LAUNCHES 1
#endif
extern "C" void kernel_launch(void* const* d_in, const int* in_sizes, int n_in, void* d_out, int out_size, void* d_ws, size_t ws_size, hipStream_t stream) {
    static int grid = 0;
    if (grid == 0) {
        if (n_in != 22 || in_sizes[0] != M * D || out_size != M * D || ws_size < WS_END) { fprintf(stderr, "kernel_launch: unexpected shapes (n_in %d, in0 %d, out %d, ws %zu); nothing launched\n", n_in, n_in > 0 ? in_sizes[0] : -1, out_size, ws_size); grid = -1; return; }
        int dev = 0, cus = 0;
        if (hipGetDevice(&dev) != hipSuccess || hipDeviceGetAttribute(&cus, hipDeviceAttributeMultiprocessorCount, dev) != hipSuccess) { grid = -1; return; }
        if (hipFuncSetAttribute((const void*)fwd_kernel, hipFuncAttributeMaxDynamicSharedMemorySize, LDS_BYTES) != hipSuccess) { fprintf(stderr, "kernel_launch: hipFuncSetAttribute failed\n"); grid = -1; return; }
        (void)hipGetLastError();
        grid = cus;
    }
    if (grid < 0) return;
    if (hipMemsetAsync((char*)d_ws + WS_CTL, 0, CTL_ZERO_BYTES, stream) != hipSuccess) return;
    Args a{};
    for (int i = 0; i < 22; ++i) a.in[i] = (const float*)d_in[i];
    a.out = (float*)d_out; a.ws = (unsigned char*)d_ws;
    if (MK_N_LAUNCHES == 1) { a.ph_lo = 0; a.ph_hi = N_PHASES; hipLaunchKernelGGL(fwd_kernel, dim3(grid), dim3(NWAVES * 64), LDS_BYTES, stream, a); }
    else for (int p = 0; p < N_PHASES; ++p) { a.ph_lo = p; a.ph_hi = p + 1; hipLaunchKernelGGL(fwd_kernel, dim3(grid), dim3(NWAVES * 64), LDS_BYTES, stream, a); }
}
```

```cpp
#include <hip/hip_runtime.h>
#include <cstdio>
#include <cstdint>
namespace pg8 {
#define PG8_LAS __attribute__((address_space(3)))
typedef unsigned short bf16_t;
typedef short bf16x8 __attribute__((ext_vector_type(8)));
typedef float f32x4 __attribute__((ext_vector_type(4)));
typedef unsigned u32x4 __attribute__((ext_vector_type(4)));
constexpr int BM = 256, BK = 64, HALF = 128, HTB = HALF * BK * 2  , STAGE_BYTES = 8 * HTB, NXCD = 8, WGM = 8;

__host__ __device__ __forceinline__ int lds_byte(int r, int c) { const int st = (r >> 4) * 2 + (c >> 5), rr = r & 15, cc = c & 31, ob = rr * 64 + cc * 2; return st * 1024 + (ob ^ (((ob >> 9) & 1) << 5)); }
__host__ __device__ __forceinline__ void stage_rc(int b, int& R, int& C) { const int st = b / 1024, sb = b % 1024, swz = sb ^ (((sb >> 9) & 1) << 5); R = (st >> 1) * 16 + swz / 64; C = (st & 1) * 32 + (swz % 64) / 2; }
__host__ __device__ __forceinline__ int perm32(int rho) { const int n = rho >> 4, i = rho & 15; return 8 * (i >> 2) + 4 * n + (i & 3); }

struct Unit { int pm, pn; };
struct Gemm { const bf16_t* A; const bf16_t* Bt; int M, N, K; int pm_mask = -1, pn_mask = -1; };

struct StaticOrder {
    int nM, nN, nwg, G, c, rev;
    __host__ __device__ void init(int M, int N, int G_, int c_, int rev_ = 0) { nM = M / BM; nN = N / BM; nwg = nM * nN; G = G_; c = c_; rev = (rev_ && nwg % G_ == 0) ? 1 : 0; }
    __host__ __device__ bool next(int i, Unit& u) const {
        if (rev) { const int nr = nwg / G; if (i >= nr) return false; i = nr - 1 - i; }
        const long L = (long)i * G + c; if (L >= nwg) return false;
        int wgid = (int)L; { const int q = nwg / NXCD, r = nwg % NXCD, xcd = wgid % NXCD, off = wgid / NXCD; wgid = (xcd < r ? xcd * (q + 1) : r * (q + 1) + (xcd - r) * q) + off; }
        const int nig = WGM * nN, gid = wgid / nig, fm = gid * WGM, gsz = (nM - fm) < WGM ? (nM - fm) : WGM;
        u.pm = fm + ((wgid % nig) % gsz); u.pn = (wgid % nig) / gsz; return true;
    }
    __device__ __forceinline__ void a_ready(const Unit&) const {}
    __device__ __forceinline__ void done(const Unit&) const {}
};

__device__ __forceinline__ unsigned cvt_pk_bf16(float lo, float hi) { unsigned r; asm volatile("v_cvt_pk_bf16_f32 %0, %1, %2" : "=v"(r) : "v"(lo), "v"(hi)); return r; }
typedef float f32x2 __attribute__((ext_vector_type(2)));
typedef unsigned u32x2 __attribute__((ext_vector_type(2)));
constexpr float NORM_EPS = 1e-6f;
__device__ __forceinline__ float silu_mul(float g, float u) {
    const float e = __builtin_amdgcn_exp2f(g * -1.4426950408889634f);
    return g * u * __builtin_amdgcn_rcpf(1.0f + e);
}
struct EpiSwiGLU {
    static constexpr bool PERM = true, AFTER_DRAIN = false, DUPABLE = true;
    bf16_t* Hout; int ldh; const float* ss; float inv_k;
    __device__ __forceinline__ void operator()(const f32x4 (&acc)[2][2][4][2], const Unit& u, int wr, int wc, int fr, int fq) const {
        const int row0 = u.pm * BM + wr * 64 + fr, col0 = u.pn * HALF + wc * 32 + 8 * fq;
#pragma unroll
        for (int ai = 0; ai < 2; ++ai)
#pragma unroll
            for (int m = 0; m < 4; ++m) {
                const int row = row0 + ai * HALF + m * 16;
                const float rs = __builtin_amdgcn_rsqf(ss[row] * inv_k + NORM_EPS);
                const f32x4 g0 = acc[ai][0][m][0] * rs, g1 = acc[ai][0][m][1] * rs, u0 = acc[ai][1][m][0] * rs, u1 = acc[ai][1][m][1] * rs;
                u32x4 w;
                w.x = cvt_pk_bf16(silu_mul(g0[0], u0[0]), silu_mul(g0[1], u0[1]));
                w.y = cvt_pk_bf16(silu_mul(g0[2], u0[2]), silu_mul(g0[3], u0[3]));
                w.z = cvt_pk_bf16(silu_mul(g1[0], u1[0]), silu_mul(g1[1], u1[1]));
                w.w = cvt_pk_bf16(silu_mul(g1[2], u1[2]), silu_mul(g1[3], u1[3]));
                *(u32x4*)(Hout + (size_t)row * ldh + col0) = w;
            }
    }
};
template <bool RES_F32> struct EpiResB {
    static constexpr bool PERM = true, AFTER_DRAIN = false, DUPABLE = false;
    const void* res; bf16_t* out; float* ssacc; float scale;
    __device__ __forceinline__ void operator()(const f32x4 (&acc)[2][2][4][2], const Unit& u, int wr, int wc, int fr, int fq) const {
        const int row0 = u.pm * BM + wr * 64 + fr, col0 = u.pn * BM + wc * 32 + 8 * fq;
#pragma unroll
        for (int ai = 0; ai < 2; ++ai) {
            float srow[4];
            if constexpr (RES_F32) {
                const float* rp = (const float*)res;
#pragma unroll
                for (int mh = 0; mh < 2; ++mh) {
                    f32x4 rv[2][2][2];
#pragma unroll
                    for (int mm = 0; mm < 2; ++mm)
#pragma unroll
                        for (int bj = 0; bj < 2; ++bj)
#pragma unroll
                            for (int n = 0; n < 2; ++n) rv[mm][bj][n] = *(const f32x4*)(rp + (size_t)(row0 + ai * HALF + (2 * mh + mm) * 16) * 1024 + col0 + bj * HALF + 4 * n);
#pragma unroll
                    for (int mm = 0; mm < 2; ++mm) {
                        const int m = 2 * mh + mm; const size_t off = (size_t)(row0 + ai * HALF + m * 16) * 1024 + col0; float s = 0.f;
#pragma unroll
                        for (int bj = 0; bj < 2; ++bj) {
                            const f32x4 a = rv[mm][bj][0] + acc[ai][bj][m][0] * scale, b = rv[mm][bj][1] + acc[ai][bj][m][1] * scale;
                            s += (a[0] * a[0] + a[1] * a[1]) + (a[2] * a[2] + a[3] * a[3]) + (b[0] * b[0] + b[1] * b[1]) + (b[2] * b[2] + b[3] * b[3]);
                            u32x4 w; w.x = cvt_pk_bf16(a[0], a[1]); w.y = cvt_pk_bf16(a[2], a[3]); w.z = cvt_pk_bf16(b[0], b[1]); w.w = cvt_pk_bf16(b[2], b[3]);
                            *(u32x4*)(out + off + bj * HALF) = w;
                        }
                        s += __shfl_xor(s, 16); s += __shfl_xor(s, 32); srow[m] = s;
                    }
                    asm volatile("" ::: "memory");
                }
            } else {
                const bf16_t* rp = (const bf16_t*)res;
                u32x4 rv[4][2];
#pragma unroll
                for (int m = 0; m < 4; ++m)
#pragma unroll
                    for (int bj = 0; bj < 2; ++bj) rv[m][bj] = *(const u32x4*)(rp + (size_t)(row0 + ai * HALF + m * 16) * 1024 + col0 + bj * HALF);
#pragma unroll
                for (int m = 0; m < 4; ++m) {
                    const size_t off = (size_t)(row0 + ai * HALF + m * 16) * 1024 + col0; float s = 0.f;
#pragma unroll
                    for (int bj = 0; bj < 2; ++bj) {
                        const u32x4 r = rv[m][bj];
                        const f32x4 ra = {__uint_as_float(r.x << 16), __uint_as_float(r.x & 0xffff0000u), __uint_as_float(r.y << 16), __uint_as_float(r.y & 0xffff0000u)};
                        const f32x4 rb = {__uint_as_float(r.z << 16), __uint_as_float(r.z & 0xffff0000u), __uint_as_float(r.w << 16), __uint_as_float(r.w & 0xffff0000u)};
                        const f32x4 a = ra + acc[ai][bj][m][0] * scale, b = rb + acc[ai][bj][m][1] * scale;
                        s += (a[0] * a[0] + a[1] * a[1]) + (a[2] * a[2] + a[3] * a[3]) + (b[0] * b[0] + b[1] * b[1]) + (b[2] * b[2] + b[3] * b[3]);
                        u32x4 w; w.x = cvt_pk_bf16(a[0], a[1]); w.y = cvt_pk_bf16(a[2], a[3]); w.z = cvt_pk_bf16(b[0], b[1]); w.w = cvt_pk_bf16(b[2], b[3]);
                        *(u32x4*)(out + off + bj * HALF) = w;
                    }
                    s += __shfl_xor(s, 16); s += __shfl_xor(s, 32); srow[m] = s;
                }
                asm volatile("" ::: "memory");
            }
            if (ssacc) {
                const float v = fq == 0 ? srow[0] : fq == 1 ? srow[1] : fq == 2 ? srow[2] : srow[3];
                atomicAdd(ssacc + u.pm * BM + ai * HALF + wr * 64 + fq * 16 + fr, v);
            }
        }
    }
};
struct EpiIn {
    static constexpr bool PERM = true, AFTER_DRAIN = false, DUPABLE = false;
    bf16_t *Q, *K, *V, *GB, *U;
    const float* ss; const float* qg; const float* kg; float qscale;
    __device__ __forceinline__ void operator()(const f32x4 (&acc)[2][2][4][2], const Unit& u, int wr, int wc, int fr, int fq) const {
        const int row0 = u.pm * BM + wr * 64 + fr; const int pn = u.pn;
        if (pn < 4) {
            bf16_t* dst = (pn < 2 ? Q : K) + (size_t)(64 * (4 * (pn & 1) + wc)) + 8 * fq;
            const float* gp = (pn < 2 ? qg : kg) + 8 * fq; const float sc = pn < 2 ? qscale : 1.0f;
            f32x4 gv[2][2];
#pragma unroll
            for (int bj = 0; bj < 2; ++bj)
#pragma unroll
                for (int n = 0; n < 2; ++n) gv[bj][n] = *(const f32x4*)(gp + 32 * bj + 4 * n) * sc;
#pragma unroll
            for (int ai = 0; ai < 2; ++ai)
#pragma unroll
                for (int m = 0; m < 4; ++m) {
                    const int row = row0 + ai * HALF + m * 16;
                    const float rs = __builtin_amdgcn_rsqf(ss[row] * (1.0f / 1024.0f) + NORM_EPS);
                    f32x4 t[2][2]; float s = 0.f;
#pragma unroll
                    for (int bj = 0; bj < 2; ++bj)
#pragma unroll
                        for (int n = 0; n < 2; ++n) { t[bj][n] = acc[ai][bj][m][n] * rs; const f32x4 x = t[bj][n]; s += (x[0] * x[0] + x[1] * x[1]) + (x[2] * x[2] + x[3] * x[3]); }
                    s += __shfl_xor(s, 16); s += __shfl_xor(s, 32);
                    const float rn = __builtin_amdgcn_rsqf(s * (1.0f / 64.0f) + NORM_EPS);
#pragma unroll
                    for (int bj = 0; bj < 2; ++bj) {
                        const f32x4 a = t[bj][0] * rn * gv[bj][0], b = t[bj][1] * rn * gv[bj][1];
                        u32x4 w; w.x = cvt_pk_bf16(a[0], a[1]); w.y = cvt_pk_bf16(a[2], a[3]); w.z = cvt_pk_bf16(b[0], b[1]); w.w = cvt_pk_bf16(b[2], b[3]);
                        *(u32x4*)(dst + (size_t)row * 512 + 32 * bj) = w;
                    }
                }
        } else if (pn < 8) {
            bf16_t* dst = (pn < 6 ? V : GB) + (size_t)(256 * (pn & 1) + wc * 32 + 8 * fq);
#pragma unroll
            for (int ai = 0; ai < 2; ++ai)
#pragma unroll
                for (int m = 0; m < 4; ++m) {
                    const int row = row0 + ai * HALF + m * 16;
                    const float rs = __builtin_amdgcn_rsqf(ss[row] * (1.0f / 1024.0f) + NORM_EPS);
#pragma unroll
                    for (int bj = 0; bj < 2; ++bj) {
                        const f32x4 a = acc[ai][bj][m][0] * rs, b = acc[ai][bj][m][1] * rs;
                        u32x4 w; w.x = cvt_pk_bf16(a[0], a[1]); w.y = cvt_pk_bf16(a[2], a[3]); w.z = cvt_pk_bf16(b[0], b[1]); w.w = cvt_pk_bf16(b[2], b[3]);
                        *(u32x4*)(dst + (size_t)row * 512 + HALF * bj) = w;
                    }
                }
        } else {
            bf16_t* dst = U + (size_t)(128 * (pn - 8) + wc * 32 + 8 * fq);
#pragma unroll
            for (int ai = 0; ai < 2; ++ai)
#pragma unroll
                for (int m = 0; m < 4; ++m) {
                    const int row = row0 + ai * HALF + m * 16;
                    const float rs = __builtin_amdgcn_rsqf(ss[row] * (1.0f / 1024.0f) + NORM_EPS); const float rs2 = rs * rs;
                    const f32x4 a = acc[ai][0][m][0] * acc[ai][1][m][0] * rs2, b = acc[ai][0][m][1] * acc[ai][1][m][1] * rs2;
                    u32x4 w; w.x = cvt_pk_bf16(a[0], a[1]); w.y = cvt_pk_bf16(a[2], a[3]); w.z = cvt_pk_bf16(b[0], b[1]); w.w = cvt_pk_bf16(b[2], b[3]);
                    *(u32x4*)(dst + (size_t)row * 512) = w;
                }
        }
    }
};

template <class Epi, class Sched, bool ALIGN_EPI = false, bool SP2 = false>
__device__ __forceinline__ void gemm_phase(PG8_LAS unsigned char* lds, const Gemm g, const Sched& S, const Epi& E) {
    const int tid = threadIdx.x, wid = __builtin_amdgcn_readfirstlane(tid >> 6), lane = tid & 63, wr = wid >> 2, wc = wid & 3, fr = lane & 15, fq = lane >> 4;
    const int K = g.K, nt = K / BK;
    unsigned voffA[2], voffB[2];
#pragma unroll
    for (int i = 0; i < 2; ++i) { int R, C; stage_rc(tid * 16 + i * 8192, R, C); const int Rb = Epi::PERM ? ((R & ~31) + perm32(R & 31)) : R;
        voffA[i] = (unsigned)(R * K + C) * 2u; voffB[i] = (unsigned)(Rb * K + C) * 2u; }
    const size_t kstep = (size_t)(BK * 2);
    const size_t hstep = (size_t)HALF * K * 2;
    const size_t tstep = 2 * hstep;
    const unsigned ldsw = (unsigned)wid * 1024u;
    const int aoff = lds_byte(wr * 64 + fr, fq * 8), boff = lds_byte(wc * 32 + fr, fq * 8);
#define PG8_SA(b, h) (((b) * 2 + (h)) * HTB)
#define PG8_SB(b, h) ((4 + (b) * 2 + (h)) * HTB)
#define PG8_STAGE(bufoff, gbase, voff) do { _Pragma("unroll") for (int _i = 0; _i < 2; ++_i) \
        __builtin_amdgcn_global_load_lds((const unsigned*)((const char*)(gbase) + (voff)[_i]), (PG8_LAS unsigned*)(lds + (bufoff) + ldsw + _i * 8192), 16, 0, 0); } while (0)
#define PG8_LDA(dst, b, h) do { _Pragma("unroll") for (int m = 0; m < 4; ++m) _Pragma("unroll") for (int k = 0; k < 2; ++k) dst[m][k] = *(const PG8_LAS bf16x8*)(lds + PG8_SA(b, h) + aoff + m * 2048 + k * 1024); } while (0)
#define PG8_LDB(dst, b, h) do { _Pragma("unroll") for (int n = 0; n < 2; ++n) _Pragma("unroll") for (int k = 0; k < 2; ++k) dst[n][k] = *(const PG8_LAS bf16x8*)(lds + PG8_SB(b, h) + boff + n * 2048 + k * 1024); } while (0)
#define PG8_MMA(ai, bj, At, Bt) do { __builtin_amdgcn_s_setprio(1); _Pragma("unroll") for (int m = 0; m < 4; ++m) _Pragma("unroll") for (int n = 0; n < 2; ++n) _Pragma("unroll") for (int k = 0; k < 2; ++k) \
        acc[ai][bj][m][n] = __builtin_amdgcn_mfma_f32_16x16x32_bf16(Bt[n][k], At[m][k], acc[ai][bj][m][n], 0, 0, 0); __builtin_amdgcn_s_setprio(0); } while (0)
#define PG8_WAIT_V(n) asm volatile("s_waitcnt vmcnt(" #n ")" ::: "memory")
#define PG8_WAIT_L(n) asm volatile("s_waitcnt lgkmcnt(" #n ")" ::: "memory")
#define PG8_BAR __builtin_amdgcn_s_barrier()
#define PG8_SCHED __builtin_amdgcn_sched_barrier(0)
    Unit cur, nxt; int ui = 0;
    if (!S.next(0, cur)) return;
    f32x4 acc[2][2][4][2];
#pragma unroll
    for (int a = 0; a < 2; ++a)
#pragma unroll
        for (int b = 0; b < 2; ++b)
#pragma unroll
            for (int m = 0; m < 4; ++m)
#pragma unroll
                for (int n = 0; n < 2; ++n) acc[a][b][m][n] = (f32x4){0.f, 0.f, 0.f, 0.f};
    bf16x8 At[4][2], B0[2][2], B1[2][2];
    const char* cA = (const char*)g.A + (size_t)(cur.pm & g.pm_mask) * tstep; const char* cB = (const char*)g.Bt + (size_t)(cur.pn & g.pn_mask) * tstep;
    S.a_ready(cur);
    if constexpr (SP2) {
        PG8_STAGE(PG8_SB(0, 0), cB, voffB); PG8_STAGE(PG8_SB(0, 1), cB + hstep, voffB); PG8_STAGE(PG8_SA(0, 0), cA, voffA); PG8_STAGE(PG8_SA(0, 1), cA + hstep, voffA);
        if (wr == 1) PG8_BAR;
        PG8_WAIT_V(2); PG8_BAR;
        PG8_STAGE(PG8_SB(1, 0), cB + kstep, voffB); PG8_STAGE(PG8_SA(1, 0), cA + kstep, voffA); PG8_STAGE(PG8_SB(1, 1), cB + hstep + kstep, voffB);
        PG8_WAIT_V(6); PG8_BAR;
    } else {
        PG8_STAGE(PG8_SB(0, 0), cB, voffB); PG8_STAGE(PG8_SA(0, 0), cA, voffA); PG8_STAGE(PG8_SB(0, 1), cB + hstep, voffB); PG8_STAGE(PG8_SA(0, 1), cA + hstep, voffA);
        if (wr == 1) PG8_BAR;
        PG8_WAIT_V(4); PG8_BAR;
        PG8_STAGE(PG8_SB(1, 0), cB + kstep, voffB); PG8_STAGE(PG8_SA(1, 0), cA + kstep, voffA); PG8_STAGE(PG8_SB(1, 1), cB + hstep + kstep, voffB);
        PG8_WAIT_V(6); PG8_BAR;
    }
    for (;;) {
        const bool has_next = S.next(ui + 1, nxt);
        const char* nA = has_next ? (const char*)g.A + (size_t)(nxt.pm & g.pm_mask) * tstep : cA; const char* nB = has_next ? (const char*)g.Bt + (size_t)(nxt.pn & g.pn_mask) * tstep : cB;
        for (int t = 0; t < nt; t += 2) {
            const bool last = (t == nt - 2);
            const char* a1 = cA + (size_t)(t + 1) * kstep;
            const char* a2 = last ? nA : cA + (size_t)(t + 2) * kstep; const char* b2 = last ? nB : cB + (size_t)(t + 2) * kstep;
            const char* a3 = a2 + kstep; const char* b3 = b2 + kstep;
            if (last && has_next) S.a_ready(nxt);
            if constexpr (SP2) {
            PG8_LDB(B0, 0, 0); PG8_LDB(B1, 0, 1); PG8_SCHED; PG8_LDA(At, 0, 0); PG8_STAGE(PG8_SA(1, 1), a1 + hstep, voffA);
            PG8_WAIT_V(8); PG8_WAIT_L(0); PG8_BAR; PG8_MMA(0, 0, At, B0); PG8_MMA(0, 1, At, B1); PG8_BAR; PG8_SCHED;
            PG8_LDA(At, 0, 1); PG8_STAGE(PG8_SB(0, 0), b2, voffB); PG8_STAGE(PG8_SB(0, 1), b2 + hstep, voffB); PG8_STAGE(PG8_SA(0, 0), a2, voffA);
            PG8_WAIT_V(8); PG8_WAIT_L(0); PG8_BAR; PG8_MMA(1, 0, At, B0); PG8_MMA(1, 1, At, B1); PG8_BAR; PG8_SCHED;
            PG8_LDB(B0, 1, 0); PG8_LDB(B1, 1, 1); PG8_SCHED; PG8_LDA(At, 1, 0); PG8_STAGE(PG8_SA(0, 1), a2 + hstep, voffA);
            PG8_WAIT_V(8); PG8_WAIT_L(0); PG8_BAR; PG8_MMA(0, 0, At, B0); PG8_MMA(0, 1, At, B1); PG8_BAR; PG8_SCHED;
            PG8_LDA(At, 1, 1); PG8_STAGE(PG8_SB(1, 0), b3, voffB); PG8_STAGE(PG8_SB(1, 1), b3 + hstep, voffB); PG8_STAGE(PG8_SA(1, 0), a3, voffA);
            PG8_WAIT_V(8); PG8_WAIT_L(0); PG8_BAR; PG8_MMA(1, 0, At, B0); PG8_MMA(1, 1, At, B1); PG8_BAR; PG8_SCHED;
            } else {
            PG8_LDB(B0, 0, 0); PG8_SCHED; PG8_LDA(At, 0, 0); PG8_STAGE(PG8_SA(1, 1), a1 + hstep, voffA);
            PG8_WAIT_L(8); PG8_BAR; PG8_WAIT_L(0); PG8_MMA(0, 0, At, B0); PG8_BAR; PG8_SCHED;
            PG8_LDB(B1, 0, 1); PG8_STAGE(PG8_SB(0, 0), b2, voffB);
            PG8_BAR; PG8_WAIT_L(0); PG8_MMA(0, 1, At, B1); PG8_BAR;
            PG8_LDA(At, 0, 1); PG8_STAGE(PG8_SA(0, 0), a2, voffA);
            PG8_BAR; PG8_WAIT_L(0); PG8_MMA(1, 0, At, B0); PG8_BAR; PG8_SCHED;
            PG8_STAGE(PG8_SB(0, 1), b2 + hstep, voffB);
            PG8_WAIT_V(6); PG8_BAR; PG8_MMA(1, 1, At, B1); PG8_BAR;
            PG8_LDB(B0, 1, 0); PG8_SCHED; PG8_LDA(At, 1, 0); PG8_STAGE(PG8_SA(0, 1), a2 + hstep, voffA);
            PG8_WAIT_L(8); PG8_BAR; PG8_WAIT_L(0); PG8_MMA(0, 0, At, B0); PG8_BAR; PG8_SCHED;
            PG8_LDB(B1, 1, 1); PG8_STAGE(PG8_SB(1, 0), b3, voffB);
            PG8_BAR; PG8_WAIT_L(0); PG8_MMA(0, 1, At, B1); PG8_BAR;
            PG8_LDA(At, 1, 1); PG8_STAGE(PG8_SA(1, 0), a3, voffA);
            PG8_BAR; PG8_WAIT_L(0); PG8_MMA(1, 0, At, B0); PG8_BAR; PG8_SCHED;
            PG8_STAGE(PG8_SB(1, 1), b3 + hstep, voffB);
            PG8_WAIT_V(6); PG8_BAR; PG8_MMA(1, 1, At, B1); PG8_BAR;
            }
        }
        if constexpr (ALIGN_EPI) { if (wr == 0) PG8_BAR; }
        if constexpr (!Epi::AFTER_DRAIN) { E(acc, cur, wr, wc, fr, fq);
#ifdef DUP_EPI
            if constexpr (Epi::DUPABLE) { asm volatile("" ::: "memory"); E(acc, cur, wr, wc, fr, fq); }
#endif
            S.done(cur); }
        if (!has_next) break;
#pragma unroll
        for (int a = 0; a < 2; ++a)
#pragma unroll
            for (int b = 0; b < 2; ++b)
#pragma unroll
                for (int m = 0; m < 4; ++m)
#pragma unroll
                    for (int n = 0; n < 2; ++n) acc[a][b][m][n] = (f32x4){0.f, 0.f, 0.f, 0.f};
        cur = nxt; cA = nA; cB = nB; ++ui;
        if constexpr (ALIGN_EPI) { if (wr == 1) PG8_BAR; }
    }
    PG8_WAIT_V(0);
    if constexpr (!ALIGN_EPI) { if (wr == 0) PG8_BAR; }
    PG8_BAR;
    if constexpr (Epi::AFTER_DRAIN) { E.fused(acc, cur, wr, wc, fr, fq, lds, wid, lane); S.done(cur); }
#undef PG8_SA
#undef PG8_SB
#undef PG8_STAGE
#undef PG8_LDA
#undef PG8_LDB
#undef PG8_MMA
#undef PG8_WAIT_V
#undef PG8_WAIT_L
#undef PG8_BAR
#undef PG8_SCHED
}
}

#ifndef PG8_SP2
#define PG8_SP2 true
#endif
#ifndef PG8_ALIGN
#define PG8_ALIGN true
#endif
#define GAS __attribute__((address_space(1)))
#define LAS __attribute__((address_space(3)))
typedef unsigned short bf16;
typedef unsigned v4u __attribute__((ext_vector_type(4)));
typedef float f32x4 __attribute__((ext_vector_type(4)));
typedef short bf16x8 __attribute__((ext_vector_type(8)));
typedef GAS unsigned gu32;
typedef GAS unsigned long long gu64;
#define RLX_AGENT __ATOMIC_RELAXED, __HIP_MEMORY_SCOPE_AGENT
#define LDS_WAIT() asm volatile("s_waitcnt lgkmcnt(0)" ::: "memory")
#define VM_WAIT() asm volatile("s_waitcnt vmcnt(0)" ::: "memory")
__device__ __forceinline__ unsigned long long rt() { return __builtin_amdgcn_s_memrealtime(); }
__device__ __forceinline__ unsigned f2bf(float f) { unsigned u = __builtin_bit_cast(unsigned, f); return (u + 0x7fffu + ((u >> 16) & 1u)) >> 16; }
__device__ __forceinline__ unsigned pk2(float lo, float hi) { return f2bf(lo) | (f2bf(hi) << 16); }

#define XB_TMO      128
#define XB_XCNT(j)  (256  + 64 * (j))
#define XB_XSUB(j)  (1280 + 64 * (j))
#define XB_XGEN(j)  (2304 + 64 * (j))
#define XB_TOP      3328
#define XB_TOPGEN   3392
#define XCD_BAR_WORDS 3456
#define XB_SPIN_CAP (1u << 18)

__device__ __forceinline__ unsigned xb_ld(unsigned* p)              { return __hip_atomic_load(p, __ATOMIC_RELAXED, __HIP_MEMORY_SCOPE_AGENT); }
__device__ __forceinline__ unsigned xb_add(unsigned* p, unsigned v) { return __hip_atomic_fetch_add(p, v, __ATOMIC_RELAXED, __HIP_MEMORY_SCOPE_AGENT); }
__device__ __forceinline__ unsigned xb_xcc_id() { return (unsigned)__builtin_amdgcn_s_getreg((3 << 11) | 20) & 0xFu; }
#define XB_SPIN(cond, bar) do { unsigned _sp = 0; while (cond) { __builtin_amdgcn_s_sleep(1); \
    if ((++_sp & 255u) == 0u) { if (xb_ld(&(bar)[XB_TMO])) break; if (_sp > XB_SPIN_CAP) { atomicAdd(&(bar)[XB_TMO], 1u); break; } } } } while (0)

struct XcdBarrier {
    unsigned* bar; unsigned x;
    volatile LAS unsigned* st;
};

__device__ __forceinline__ XcdBarrier xcd_barrier_post(unsigned* bar, volatile LAS unsigned* st) {
    XcdBarrier b; b.bar = bar; b.x = xb_xcc_id(); b.st = st;
    if (threadIdx.x == 0) (void)xb_add(&bar[XB_XCNT(b.x)], 1u);
    return b;
}
__device__ __forceinline__ void xcd_barrier_complete(unsigned* bar, unsigned x, unsigned& nloc, unsigned& nx) {
    const unsigned G = gridDim.x * gridDim.y * gridDim.z;
    unsigned sum, cnt, mine, sp = 0u;
    for (;;) {
        sum = 0u; cnt = 0u; mine = 0u;
#pragma unroll
        for (unsigned j = 0; j < 16; ++j) { const unsigned c = xb_ld(&bar[XB_XCNT(j)]); sum += c; cnt += (c > 0u) ? 1u : 0u; mine = (j == x) ? c : mine; }
        if (sum == G) break;
        __builtin_amdgcn_s_sleep(1);
        if ((++sp & 255u) == 0u) { if (xb_ld(&bar[XB_TMO])) break; if (sp > XB_SPIN_CAP) { atomicAdd(&bar[XB_TMO], 1u); break; } }
    }
    nloc = mine > 0u ? mine : 1u; nx = cnt > 0u ? cnt : 1u;
}

__device__ __forceinline__ void xcd_barrier(const XcdBarrier& b) {
    asm volatile("s_waitcnt vmcnt(0)" ::: "memory");
    __syncthreads();
    if (threadIdx.x == 0) {
        unsigned* bar = b.bar;
        __builtin_amdgcn_s_waitcnt(0);
        unsigned nloc = b.st[0], nx = b.st[1];
        if (nloc == 0u) { xcd_barrier_complete(bar, b.x, nloc, nx); b.st[0] = nloc; b.st[1] = nx; }
        const unsigned old = xb_add(&bar[XB_XSUB(b.x)], 1u);
        const unsigned gen = old / nloc;
        if (old + 1u == (gen + 1u) * nloc) {
            __builtin_amdgcn_fence(__ATOMIC_RELEASE, "agent");
            asm volatile("s_waitcnt vmcnt(0)" ::: "memory");
            const unsigned og = xb_add(&bar[XB_TOP], 1u);
            const unsigned tg = og / nx;
            if (og + 1u == (tg + 1u) * nx) xb_add(&bar[XB_TOPGEN], 1u);
            else XB_SPIN(xb_ld(&bar[XB_TOPGEN]) == tg, bar);
            __builtin_amdgcn_fence(__ATOMIC_ACQUIRE, "agent");
            xb_add(&bar[XB_XGEN(b.x)], 1u);
            asm volatile("s_waitcnt vmcnt(0)" ::: "memory");
        } else {
            XB_SPIN(xb_ld(&bar[XB_XGEN(b.x)]) == gen, bar);
            __builtin_amdgcn_fence(__ATOMIC_ACQUIRE, "agent");
            asm volatile("s_waitcnt vmcnt(0)" ::: "memory");
        }
    }
    __syncthreads();
}
#ifndef DUP_PHASE
#define DUP_PHASE -1
#endif

constexpr int NWAVES = 8;
constexpr int BATCH = 8, SEQ = 4096, D = 1024, FF = 2816, NIN = 3072, NH = 4;
constexpr int M = BATCH * SEQ;
constexpr float EPS = 1e-6f;
constexpr float LAM_INIT = 0.2f;
constexpr float LOG2E = 1.4426950408889634f;

constexpr size_t MiB = 1u << 20;
constexpr size_t WS_CTL = 0, CTL_ZERO_BYTES = 1 * MiB;
constexpr size_t WS_SS = 1 * MiB;
constexpr size_t WS_WGU1 = 2 * MiB, WS_WD1 = 13 * MiB, WS_WIN = 19 * MiB, WS_WOUT = 25 * MiB, WS_WGU2 = 27 * MiB, WS_WD2 = 38 * MiB;
constexpr size_t WS_XB = 48 * MiB;
constexpr size_t WS_H = 112 * MiB;
constexpr size_t WS_Q = WS_H, WS_K = WS_H + 32 * MiB, WS_V = WS_H + 64 * MiB, WS_GB = WS_H + 96 * MiB, WS_U = WS_H + 128 * MiB;
constexpr size_t WS_MIX = 288 * MiB;
constexpr size_t WS_O = 352 * MiB;
constexpr size_t WS_END = 416 * MiB;
static_assert(WS_WD2 + (size_t)D * FF * 2 <= WS_XB && WS_U + (size_t)M * 512 * 2 <= WS_H + (size_t)M * FF * 2 && WS_H + (size_t)M * FF * 2 <= WS_MIX, "d_ws map");
constexpr int CW_TMO = 0, CW_CODE = 1, CW_BAR = 4096;

constexpr int RING_OFF = 0, RING_BYTES = 131072;
constexpr int LDS_BYTES = 163840;
constexpr int LDSCTL_OFF = LDS_BYTES - 512, MISC_OFF = LDSCTL_OFF + 320;
static_assert(MISC_OFF + 128 <= LDS_BYTES && RING_BYTES <= LDSCTL_OFF, "LDS map");

typedef unsigned u32x4 __attribute__((ext_vector_type(4)));
typedef float f32x16 __attribute__((ext_vector_type(16)));
typedef short s16x4 __attribute__((ext_vector_type(4)));

struct Frame {
    LAS unsigned char* lds;
    volatile LAS unsigned* MISC;
    gu32* ctl;
    int tid, lane, wave, vcu, G;
};

__device__ __forceinline__ float wave_sum(float v) {
#pragma unroll
    for (int o = 1; o < 64; o <<= 1) v += __shfl_xor(v, o);
    return v;
}

__device__ __forceinline__ void transpose_item(const float* W, int srcN, int s0, int k0, const float* gain, bf16* WT, int K, int n0, LAS float* scr, int lane) {
#pragma unroll 8
    for (int i = 0; i < 32; ++i) { const int kk = 2 * i + (lane >> 5); float v = W[(size_t)(k0 + kk) * srcN + s0 + (lane & 31)]; if (gain) v *= gain[k0 + kk]; scr[kk * 33 + (lane & 31)] = v; }
    LDS_WAIT(); asm volatile("" ::: "memory");
    const int c = lane & 7;
#pragma unroll
    for (int j = 0; j < 4; ++j) { const int n = (lane >> 3) + 8 * j; const LAS float* s = scr + (8 * c) * 33 + n;
        v4u o; o.x = pk2(s[0 * 33], s[1 * 33]); o.y = pk2(s[2 * 33], s[3 * 33]); o.z = pk2(s[4 * 33], s[5 * 33]); o.w = pk2(s[6 * 33], s[7 * 33]);
        *(GAS v4u*)(WT + (size_t)(n0 + n) * K + k0 + 8 * c) = o; }
    LDS_WAIT(); asm volatile("" ::: "memory");
}
struct Args { const float* in[22]; float* out; unsigned char* ws; int ph_lo, ph_hi; };

__device__ __forceinline__ void p0_prologue(Frame& F, const Args& A) {
    LAS float* scr = (LAS float*)(F.lds + RING_OFF + F.wave * 16384);
    const int gw = F.vcu * NWAVES + F.wave, NGW = F.G * NWAVES;
    unsigned char* ws = A.ws;
    constexpr int I_GU = (D / 64) * (2 * FF / 32), I_DN = (FF / 64) * (D / 32), I_IN = (D / 64) * (NIN / 32), I_OUT = (D / 64) * (D / 32);
    constexpr int NITEMS = 2 * I_GU + 2 * I_DN + I_IN + I_OUT;
    for (int it = gw; it < NITEMS; it += NGW) {
        int r = it;
        if (r < 2 * I_GU) {
            const int l = r >= I_GU; if (l) r -= I_GU;
            constexpr int nblk = 2 * FF / 32; const int kb = r / nblk, nb = r % nblk, n0 = 32 * nb;
            const int pn = n0 >> 8, half = (n0 >> 7) & 1, j = n0 & 127;
            const float* W = A.in[l ? (half ? 19 : 18) : (half ? 3 : 2)];
            transpose_item(W, FF, 128 * pn + j, 64 * kb, A.in[l ? 17 : 1], (bf16*)(ws + (l ? WS_WGU2 : WS_WGU1)), D, n0, scr, F.lane);
            continue;
        }
        r -= 2 * I_GU;
        if (r < 2 * I_DN) {
            const int l = r >= I_DN; if (l) r -= I_DN;
            constexpr int nblk = D / 32; const int kb = r / nblk, nb = r % nblk;
            transpose_item(A.in[l ? 20 : 4], D, 32 * nb, 64 * kb, nullptr, (bf16*)(ws + (l ? WS_WD2 : WS_WD1)), FF, 32 * nb, scr, F.lane);
            continue;
        }
        r -= 2 * I_DN;
        if (r < I_IN) {
            constexpr int nblk = NIN / 32; const int kb = r / nblk, nb = r % nblk, n0 = 32 * nb;
            const int pn = n0 >> 8, half = (n0 >> 7) & 1, j = n0 & 127;
            int s0;
            if (pn < 4) s0 = (pn >> 1) * 512 + 64 * (4 * (pn & 1) + (j >> 5)) + 32 * half;
            else if (pn < 8) s0 = n0;
            else s0 = (half ? 2560 : 2048) + 128 * (pn - 8) + j;
            transpose_item(A.in[6], NIN, s0, 64 * kb, A.in[5], (bf16*)(ws + WS_WIN), D, n0, scr, F.lane);
            continue;
        }
        r -= I_IN;
        { constexpr int nblk = D / 32; const int kb = r / nblk, nb = r % nblk;
          transpose_item(A.in[16], D, 32 * nb, 64 * kb, nullptr, (bf16*)(ws + WS_WOUT), D, 32 * nb, scr, F.lane); }
    }
    const float* x = A.in[0]; bf16* xb = (bf16*)(ws + WS_XB); float* ss = (float*)(ws + WS_SS);
    for (int m = gw; m < M; m += NGW) {
        const GAS f32x4* xr = (const GAS f32x4*)(x + (size_t)m * D) + F.lane;
        f32x4 v[4]; float s = 0.f;
#pragma unroll
        for (int j = 0; j < 4; ++j) { v[j] = xr[64 * j]; s += (v[j].x * v[j].x + v[j].y * v[j].y) + (v[j].z * v[j].z + v[j].w * v[j].w); }
        s = wave_sum(s);
        GAS unsigned long long* o8 = (GAS unsigned long long*)(xb + (size_t)m * D) + F.lane;
#pragma unroll
        for (int j = 0; j < 4; ++j) o8[64 * j] = (unsigned long long)pk2(v[j].x, v[j].y) | ((unsigned long long)pk2(v[j].z, v[j].w) << 32);
        if (F.lane == 0) { ss[m] = s; ss[M + m] = 0.f; ss[2 * M + m] = 0.f; }
    }
}

namespace att {
constexpr int L_K = 0, L_V = 16384, L_WS = 49152, L_Q = 53248, L_OST = 86016, L_END = L_OST + 65536;
constexpr float THR = 8.0f;
static_assert(L_END <= LDSCTL_OFF, "attention LDS");
__device__ __forceinline__ int crow(int r, int hi) { return (r & 3) + 8 * (r >> 2) + 4 * hi; }
typedef __bf16 bf16x2_t __attribute__((ext_vector_type(2))); typedef float f32x2_t __attribute__((ext_vector_type(2)));
__device__ __forceinline__ unsigned cvtpk(float lo, float hi) { f32x2_t v = {lo, hi}; bf16x2_t b = __builtin_convertvector(v, bf16x2_t); return __builtin_bit_cast(unsigned, b); }
typedef short v4i16_t __attribute__((ext_vector_type(4)));
__device__ __forceinline__ s16x4 vtr(LAS const unsigned char* p) { return __builtin_bit_cast(s16x4, __builtin_amdgcn_ds_read_tr16_b64_v4i16((LAS v4i16_t*)p)); }
#define MX3(a, b, c) __builtin_fmaxf(__builtin_fmaxf((a), (b)), (c))
#define EX2(v) __builtin_amdgcn_exp2f(v)
__device__ __forceinline__ void glds16(const void* gsrc, unsigned lds_dst) { unsigned keep;
    asm volatile("s_mov_b32 %0, m0\n\ts_mov_b32 m0, %2\n\ts_nop 0\n\tglobal_load_lds_dwordx4 %1, off\n\ts_mov_b32 m0, %0" : "=&s"(keep) : "v"(gsrc), "s"(lds_dst) : "memory"); }

template <bool FAST, int ABL> __device__ __forceinline__ void attn_pass(f32x16 (&o)[4], f32x16& osum, int mc, int h, size_t rowbase, int q0, const bf16* Qg, const bf16* Kg, const bf16* Vg,
                                                                         LAS unsigned char* shm, int lane, int r32, int hi, int wid) {
    const float sl2 = LOG2E * EX2(-2.0f * (float)(h + 1));
    LAS float* wsf = (LAS float*)(shm + L_WS) + wid * 128;
    LAS unsigned char* Qf = shm + L_Q + wid * 4096;
    const int NT = (q0 + 256) / 64;
    const int half = wid >> 2;
    const unsigned lds0 = (unsigned)(unsigned long)shm;
    const unsigned char* kbase_u = (const unsigned char*)(Kg + rowbase * 512 + h * 128 + mc * 64 + wid * 8);
    unsigned koff = (unsigned)lane * 1024u; asm volatile("" : "+v"(koff));
    const int vp0 = wid * 2, vp1 = wid * 2 + 1;
    const unsigned char* vbase0_u = (const unsigned char*)(Vg + (rowbase + 16 * (vp0 & 3)) * 512 + h * 128 + (vp0 >> 2) * 32);
    const unsigned char* vbase1_u = (const unsigned char*)(Vg + (rowbase + 16 * (vp1 & 3)) * 512 + h * 128 + (vp1 >> 2) * 32);
    unsigned voff = (unsigned)(lane >> 2) * 1024u + (unsigned)(lane & 3) * 16u; asm volatile("" : "+v"(voff));
#define DMA_K(j, slot) if constexpr (!(ABL & 8)) glds16(kbase_u + (size_t)(NT - 1 - (j)) * 65536 + koff, (unsigned)__builtin_amdgcn_readfirstlane((int)(lds0 + L_K + (slot) * 8192 + wid * 1024)))
#define DMA_V(j, slot) if constexpr (!(ABL & 8)) do { const size_t go_ = (size_t)(NT - 1 - (j)) * 65536; const unsigned sb_ = lds0 + L_V + (slot) * 16384; \
        glds16(vbase0_u + go_ + voff, (unsigned)__builtin_amdgcn_readfirstlane((int)(sb_ + vp0 * 1024))); \
        glds16(vbase1_u + go_ + voff, (unsigned)__builtin_amdgcn_readfirstlane((int)(sb_ + vp1 * 1024))); } while (0)
#define WAIT_BAR(N) do { if constexpr (ABL & 128) asm volatile("s_waitcnt vmcnt(" #N ") lgkmcnt(0)" ::: "memory"); else asm volatile("s_waitcnt vmcnt(" #N ") lgkmcnt(0)\n\ts_barrier" ::: "memory"); } while (0)
    WAIT_BAR(0);
    DMA_K(0, 0); DMA_V(0, 0);
    {
        const bf16* qp = Qg + (rowbase + q0 + wid * 32 + r32) * 512 + h * 128 + mc * 64 + hi * 8;
#pragma unroll
        for (int d0 = 0; d0 < 4; ++d0) *(LAS u32x4*)(Qf + d0 * 1024 + lane * 16) = *(const GAS u32x4*)(qp + d0 * 16);
    }
#pragma unroll
    for (int d = 0; d < 4; ++d)
#pragma unroll
        for (int r = 0; r < 16; ++r) o[d][r] = 0.f;
#pragma unroll
    for (int r = 0; r < 16; ++r) osum[r] = 0.f;
    float mhat = 0.f;
    const int irel = wid * 32 + r32;
    f32x16 cb;
#pragma unroll
    for (int r = 0; r < 16; ++r) cb[r] = sl2 * (float)(crow(r, hi) - irel);
    const LAS unsigned char* vbl = (const LAS unsigned char*)shm + L_V + ((lane >> 4) & 1) * 32 + (lane & 3) * 8 + (4 * hi + ((lane & 15) >> 2)) * 64;
    const LAS unsigned char* kbl = (const LAS unsigned char*)shm + L_K + hi * 1024 + r32 * 16;
    const bf16x8 ones = (bf16x8){0x3F80, 0x3F80, 0x3F80, 0x3F80, 0x3F80, 0x3F80, 0x3F80, 0x3F80};
    f32x16 p0, p1;
    {   const float at_ = sl2 * (float)(64 * (NT - 1) - q0), at1_ = at_ + 32.0f * sl2;
#pragma unroll
        for (int r = 0; r < 16; ++r) { p0[r] = cb[r] + at_; p1[r] = cb[r] + at1_; } }
    WAIT_BAR(0);
#define P0_BODY(j) do { const int t_ = NT - 1 - (j); \
        const LAS unsigned char* kb_ = kbl + ((j) & 1) * 8192; \
        if constexpr (!(ABL & 4)) _Pragma("unroll") for (int d0 = 0; d0 < 4; ++d0) { \
            const bf16x8 qf_ = *(LAS const bf16x8*)(Qf + d0 * 1024 + lane * 16); \
            const bf16x8 b0_ = *(LAS const bf16x8*)(kb_ + d0 * 2048), b1_ = *(LAS const bf16x8*)(kb_ + d0 * 2048 + 512); \
            p0 = __builtin_amdgcn_mfma_f32_32x32x16_bf16(b0_, qf_, p0, 0, 0, 0); \
            p1 = __builtin_amdgcn_mfma_f32_32x32x16_bf16(b1_, qf_, p1, 0, 0, 0); } \
        const int jb_ = t_ - (NT - 4); \
        if (jb_ >= 0) { const int kb0_ = 64 * jb_ + 4 * hi; \
            _Pragma("unroll") for (int r = 0; r < 16; ++r) { const int kv_ = kb0_ + (r & 3) + 8 * (r >> 2); if (kv_ > irel) p0[r] = -INFINITY; if (kv_ + 32 > irel) p1[r] = -INFINITY; } } \
        if constexpr (!FAST) { \
            float ra_ = MX3(p0[0], p0[1], p1[0]), rb_ = MX3(p0[2], p0[3], p1[1]); ra_ = MX3(ra_, p1[2], p1[3]); \
            _Pragma("unroll") for (int r = 4; r < 16; r += 4) { ra_ = MX3(ra_, p0[r], p0[r + 1]); rb_ = MX3(rb_, p0[r + 2], p0[r + 3]); ra_ = MX3(ra_, p1[r], p1[r + 1]); rb_ = MX3(rb_, p1[r + 2], p1[r + 3]); } \
            float rm_ = __builtin_fmaxf(ra_, rb_); rm_ = __builtin_fmaxf(rm_, __shfl_xor(rm_, 32)); \
            if (__any(rm_ > THR)) {     \
                const float dl_ = __builtin_fmaxf(rm_, 0.f); mhat += dl_; \
                _Pragma("unroll") for (int r = 0; r < 16; ++r) { p0[r] -= dl_; p1[r] -= dl_; } \
                const float f_ = EX2(-dl_); \
                if (hi == 0) wsf[r32] = f_; \
                asm volatile("s_waitcnt lgkmcnt(0)" ::: "memory"); \
                _Pragma("unroll") for (int r = 0; r < 16; ++r) { const float fr_ = wsf[crow(r, hi)]; osum[r] *= fr_; _Pragma("unroll") for (int d = 0; d < 4; ++d) o[d][r] *= fr_; } \
                asm volatile("s_waitcnt lgkmcnt(0)" ::: "memory"); } } \
        if constexpr (!(ABL & 2)) { _Pragma("unroll") for (int r = 0; r < 16; ++r) { p0[r] = EX2(p0[r]); p1[r] = EX2(p1[r]); } } \
        asm volatile("" : "+v"(p0), "+v"(p1)); } while (0)
#define P1_BODY(j) do { const int t_ = NT - 1 - (j); \
        u32x4 pw_[4]; \
        pw_[0] = (u32x4){cvtpk(p0[0], p0[1]), cvtpk(p0[2], p0[3]), cvtpk(p0[4], p0[5]), cvtpk(p0[6], p0[7])}; \
        pw_[1] = (u32x4){cvtpk(p0[8], p0[9]), cvtpk(p0[10], p0[11]), cvtpk(p0[12], p0[13]), cvtpk(p0[14], p0[15])}; \
        pw_[2] = (u32x4){cvtpk(p1[0], p1[1]), cvtpk(p1[2], p1[3]), cvtpk(p1[4], p1[5]), cvtpk(p1[6], p1[7])}; \
        pw_[3] = (u32x4){cvtpk(p1[8], p1[9]), cvtpk(p1[10], p1[11]), cvtpk(p1[12], p1[13]), cvtpk(p1[14], p1[15])}; \
        asm volatile("" :: "v"(pw_[0]), "v"(pw_[1]), "v"(pw_[2]), "v"(pw_[3])); \
        const LAS unsigned char* vb_ = vbl + ((j) & 1) * 16384; \
        if constexpr (!(ABL & 1)) _Pragma("unroll") for (int ks = 0; ks < 4; ++ks) { \
            _Pragma("unroll") for (int d0 = 0; d0 < 4; ++d0) { \
                const s16x4 lo_ = vtr(vb_ + d0 * 4096 + ks * 1024), h8_ = vtr(vb_ + d0 * 4096 + ks * 1024 + 512); \
                const bf16x8 vf_ = (bf16x8){lo_[0], lo_[1], lo_[2], lo_[3], h8_[0], h8_[1], h8_[2], h8_[3]}; \
                o[d0] = __builtin_amdgcn_mfma_f32_32x32x16_bf16(__builtin_bit_cast(bf16x8, pw_[ks]), vf_, o[d0], 0, 0, 0); } \
            osum = __builtin_amdgcn_mfma_f32_32x32x16_bf16(__builtin_bit_cast(bf16x8, pw_[ks]), ones, osum, 0, 0, 0); \
            __builtin_amdgcn_sched_barrier(0); }     \
        const float at_ = sl2 * (float)(64 * (t_ - 1) - q0) - mhat, at1_ = at_ + 32.0f * sl2; \
        _Pragma("unroll") for (int r = 0; r < 16; ++r) { p0[r] = cb[r] + at_; p1[r] = cb[r] + at1_; } } while (0)
    if (half == 0) {
        for (int j = 0; j < NT; ++j) {
            const bool more = j + 1 < NT;
            if (more) DMA_K(j + 1, (j + 1) & 1);
            P0_BODY(j);
            if (more) WAIT_BAR(1); else WAIT_BAR(0);
            if (more) DMA_V(j + 1, (j + 1) & 1);
            P1_BODY(j);
            if (more) WAIT_BAR(2); else WAIT_BAR(0);
        }
        WAIT_BAR(0);
    } else {
        DMA_K(1, 1);
        WAIT_BAR(1);
        for (int j = 0; j < NT; ++j) {
            if (j + 1 < NT) DMA_V(j + 1, (j + 1) & 1);
            P0_BODY(j);
            if (j + 1 < NT) WAIT_BAR(2); else WAIT_BAR(0);
            if (j + 2 < NT) DMA_K(j + 2, j & 1);
            P1_BODY(j);
            if (j + 2 < NT) WAIT_BAR(1); else WAIT_BAR(0);
        }
    }
#undef P0_BODY
#undef P1_BODY
#undef DMA_K
#undef DMA_V
#undef WAIT_BAR
}

template <bool FAST, int ABL> __device__ __forceinline__ void attn_unit(int b, int h, int qb, const bf16* Qg, const bf16* Kg, const bf16* Vg, bf16* MIX, const float* subln, float lam, LAS unsigned char* shm) {
    int tid = threadIdx.x; asm volatile("" : "+v"(tid));
    const int lane = tid & 63, r32 = lane & 31, hi = lane >> 5; const int wid = __builtin_amdgcn_readfirstlane(tid >> 6);
    const size_t rowbase = (size_t)b * SEQ; const int q0 = qb * 256;
    LAS unsigned char* ost = shm + L_OST + wid * 8192;
    f32x16 o[4], osum;
    attn_pass<FAST, ABL>(o, osum, 0, h, rowbase, q0, Qg, Kg, Vg, shm, lane, r32, hi, wid);
    {
        float f[16];
#pragma unroll
        for (int r = 0; r < 16; ++r) f[r] = __builtin_amdgcn_rcpf(osum[r]);
#pragma unroll
        for (int d = 0; d < 4; ++d) {
            u32x4 w0, w1;
            w0 = (u32x4){cvtpk(o[d][0] * f[0], o[d][1] * f[1]), cvtpk(o[d][2] * f[2], o[d][3] * f[3]), cvtpk(o[d][4] * f[4], o[d][5] * f[5]), cvtpk(o[d][6] * f[6], o[d][7] * f[7])};
            w1 = (u32x4){cvtpk(o[d][8] * f[8], o[d][9] * f[9]), cvtpk(o[d][10] * f[10], o[d][11] * f[11]), cvtpk(o[d][12] * f[12], o[d][13] * f[13]), cvtpk(o[d][14] * f[14], o[d][15] * f[15])};
            *(LAS u32x4*)(ost + (2 * d) * 1024 + lane * 16) = w0; *(LAS u32x4*)(ost + (2 * d + 1) * 1024 + lane * 16) = w1;
        }
    }
    LDS_WAIT(); asm volatile("" ::: "memory");
    attn_pass<FAST, ABL>(o, osum, 1, h, rowbase, q0, Qg, Kg, Vg, shm, lane, r32, hi, wid);
    {
        float f1[16];
#pragma unroll
        for (int r = 0; r < 16; ++r) f1[r] = lam * __builtin_amdgcn_rcpf(osum[r]);
#pragma unroll
        for (int d = 0; d < 4; ++d) {
            const u32x4 wa = *(LAS const u32x4*)(ost + (2 * d) * 1024 + lane * 16), wb = *(LAS const u32x4*)(ost + (2 * d + 1) * 1024 + lane * 16);
#pragma unroll
            for (int r = 0; r < 16; ++r) {
                const unsigned w = (r < 8 ? wa : wb)[(r >> 1) & 3];
                const float o0v = (r & 1) ? __uint_as_float(w & 0xffff0000u) : __uint_as_float(w << 16);
                o[d][r] = o0v - o[d][r] * f1[r];
            }
        }
    }
    LDS_WAIT(); asm volatile("" ::: "memory");
    float g[4];
#pragma unroll
    for (int d = 0; d < 4; ++d) g[d] = subln[32 * d + r32] * (1.0f - LAM_INIT);
    {
        LAS unsigned short* orow = (LAS unsigned short*)ost + (4 * hi) * 128 + r32;
#pragma unroll
        for (int r = 0; r < 16; ++r) {
            const int cr0 = (r & 3) + 8 * (r >> 2);
            float s = (o[0][r] * o[0][r] + o[1][r] * o[1][r]) + (o[2][r] * o[2][r] + o[3][r] * o[3][r]);
            s += __shfl_xor(s, 1); s += __shfl_xor(s, 2); s += __shfl_xor(s, 4); s += __shfl_xor(s, 8); s += __shfl_xor(s, 16);
            const float rn = __builtin_amdgcn_rsqf(s * (1.0f / 128.0f) + EPS);
#pragma unroll
            for (int d = 0; d < 4; ++d) orow[cr0 * 128 + 32 * d] = (unsigned short)f2bf(o[d][r] * rn * g[d]);
        }
    }
    LDS_WAIT(); asm volatile("" ::: "memory");
    {
        bf16* op = MIX + (rowbase + q0 + wid * 32 + (lane >> 4)) * 1024 + h * 128 + (lane & 15) * 8;
#pragma unroll
        for (int i = 0; i < 8; ++i) { const u32x4 v = *(LAS const u32x4*)(ost + i * 1024 + lane * 16); *(GAS u32x4*)(op + (size_t)i * 4 * 1024) = v; }
    }
    LDS_WAIT(); asm volatile("" ::: "memory");
}
#undef MX3
#undef EX2
}

__device__ __forceinline__ void conv_phase(Frame& F, const bf16* U, const bf16* GB, const float* cw, const float* cn, bf16* MIX) {
    const int gw = F.vcu * NWAVES + F.wave, NGW = F.G * NWAVES; const int ch0 = F.lane * 8;
    float w0[8], w1[8], w2[8], gn[8];
#pragma unroll
    for (int i = 0; i < 8; ++i) { w0[i] = cw[ch0 + i]; w1[i] = cw[512 + ch0 + i]; w2[i] = cw[1024 + ch0 + i]; gn[i] = cn[ch0 + i]; }
    for (int g = gw; g < M / 16; g += NGW) {
        const int t0 = 16 * g;
        float um2[8], um1[8];
        if ((t0 & (SEQ - 1)) == 0) {
#pragma unroll
            for (int i = 0; i < 8; ++i) { um2[i] = 0.f; um1[i] = 0.f; }
        } else {
            const v4u a = *(const GAS v4u*)(U + (size_t)(t0 - 2) * 512 + ch0), b = *(const GAS v4u*)(U + (size_t)(t0 - 1) * 512 + ch0);
#pragma unroll
            for (int i = 0; i < 4; ++i) { um2[2 * i] = __uint_as_float(a[i] << 16); um2[2 * i + 1] = __uint_as_float(a[i] & 0xffff0000u); um1[2 * i] = __uint_as_float(b[i] << 16); um1[2 * i + 1] = __uint_as_float(b[i] & 0xffff0000u); }
        }
        for (int tb = t0; tb < t0 + 16; tb += 8) {
            v4u ua[8], ga[8];
#pragma unroll
            for (int i = 0; i < 8; ++i) { ua[i] = *(const GAS v4u*)(U + (size_t)(tb + i) * 512 + ch0); ga[i] = *(const GAS v4u*)(GB + (size_t)(tb + i) * 512 + ch0); }
#pragma unroll
            for (int j = 0; j < 8; ++j) {
                const v4u a = ua[j], b = ga[j];
                float ut[8], gb[8], c[8]; float s = 0.f;
#pragma unroll
                for (int i = 0; i < 4; ++i) { ut[2 * i] = __uint_as_float(a[i] << 16); ut[2 * i + 1] = __uint_as_float(a[i] & 0xffff0000u); gb[2 * i] = __uint_as_float(b[i] << 16); gb[2 * i + 1] = __uint_as_float(b[i] & 0xffff0000u); }
#pragma unroll
                for (int i = 0; i < 8; ++i) { c[i] = gb[i] * (w0[i] * um2[i] + w1[i] * um1[i] + w2[i] * ut[i]); s += c[i] * c[i]; um2[i] = um1[i]; um1[i] = ut[i]; }
                s += __shfl_xor(s, 1); s += __shfl_xor(s, 2); s += __shfl_xor(s, 4);
                const float rn = __builtin_amdgcn_rsqf(s * (1.0f / 64.0f) + EPS);
                v4u o;
#pragma unroll
                for (int i = 0; i < 4; ++i) o[i] = pk2(c[2 * i] * rn * gn[2 * i], c[2 * i + 1] * rn * gn[2 * i + 1]);
                *(GAS v4u*)(MIX + (size_t)(tb + j) * 1024 + 512 + ch0) = o;
            }
        }
    }
}

__device__ __forceinline__ void final_norm_phase(Frame& F, const bf16* xb, float* out, const float* gain) {
    const int gw = F.vcu * NWAVES + F.wave, NGW = F.G * NWAVES;
    f32x4 gv[4];
#pragma unroll
    for (int j = 0; j < 4; ++j) gv[j] = *((const GAS f32x4*)gain + 4 * F.lane + j);
    for (int m = gw; m < M; m += NGW) {
        const GAS v4u* xr = (const GAS v4u*)(xb + (size_t)m * D) + 2 * F.lane;
        const v4u a = xr[0], b = xr[1];
        f32x4 v[4]; float s = 0.f;
        v[0] = (f32x4){__uint_as_float(a.x << 16), __uint_as_float(a.x & 0xffff0000u), __uint_as_float(a.y << 16), __uint_as_float(a.y & 0xffff0000u)};
        v[1] = (f32x4){__uint_as_float(a.z << 16), __uint_as_float(a.z & 0xffff0000u), __uint_as_float(a.w << 16), __uint_as_float(a.w & 0xffff0000u)};
        v[2] = (f32x4){__uint_as_float(b.x << 16), __uint_as_float(b.x & 0xffff0000u), __uint_as_float(b.y << 16), __uint_as_float(b.y & 0xffff0000u)};
        v[3] = (f32x4){__uint_as_float(b.z << 16), __uint_as_float(b.z & 0xffff0000u), __uint_as_float(b.w << 16), __uint_as_float(b.w & 0xffff0000u)};
#pragma unroll
        for (int j = 0; j < 4; ++j) s += (v[j].x * v[j].x + v[j].y * v[j].y) + (v[j].z * v[j].z + v[j].w * v[j].w);
        s = wave_sum(s);
        const float r = __builtin_amdgcn_rsqf(s * (1.0f / D) + EPS);
        GAS f32x4* orow = (GAS f32x4*)(out + (size_t)m * D) + 4 * F.lane;
#pragma unroll
        for (int j = 0; j < 4; ++j) orow[j] = v[j] * r * gv[j];
    }
}

constexpr int N_PHASES = 9;
__global__ void __launch_bounds__(NWAVES * 64, 2) fwd_kernel(Args args) {
    extern __shared__ __attribute__((aligned(16))) unsigned char lds[];
    Frame F;
    F.lds = (LAS unsigned char*)lds;
    F.MISC = (volatile LAS unsigned*)(F.lds + MISC_OFF);
    F.tid = threadIdx.x; F.lane = F.tid & 63; F.wave = __builtin_amdgcn_readfirstlane(F.tid >> 6);
    F.G = gridDim.x; { const int bx = blockIdx.x; F.vcu = (F.G % 8 == 0) ? (bx % 8) * (F.G / 8) + bx / 8 : bx; }
    unsigned char* ws = args.ws;
    F.ctl = (gu32*)(ws + WS_CTL);
    for (int u = F.tid; u < (LDS_BYTES - LDSCTL_OFF) / 4; u += NWAVES * 64) ((LAS unsigned*)(F.lds + LDSCTL_OFF))[u] = 0u;
    __syncthreads();
    const int lo = args.ph_lo, hi = args.ph_hi;
    const bool one_launch = (hi - lo) > 1;
    XcdBarrier bar; bar.bar = (unsigned*)(F.ctl + CW_BAR); bar.x = 0; bar.st = nullptr;
    if (one_launch) bar = xcd_barrier_post((unsigned*)(F.ctl + CW_BAR), F.MISC + 8);
#ifndef PHASE_MASK
#define PHASE_MASK 0x1ff
#endif
#define IN(k) (((PHASE_MASK >> (k)) & 1) && lo <= (k) && (k) < hi)
#define SEAM(k) do { if (IN(k) && IN((k) + 1)) xcd_barrier(bar); } while (0)

    float* ss = (float*)(ws + WS_SS);
    bf16* XB = (bf16*)(ws + WS_XB); bf16* HB = (bf16*)(ws + WS_H); bf16* MIX = (bf16*)(ws + WS_MIX);
    bf16 *QB_ = (bf16*)(ws + WS_Q), *KB_ = (bf16*)(ws + WS_K), *VB_ = (bf16*)(ws + WS_V), *GBB = (bf16*)(ws + WS_GB), *UB = (bf16*)(ws + WS_U), *OBB = (bf16*)(ws + WS_O);

#define REPS(k) for (int rep = 0; rep < ((DUP_PHASE == (k)) ? 2 : 1); ++rep)
#ifdef PROBE_PH_A
    gu64* tsw = (gu64*)(F.ctl + 2048);
#define STAMP(k) do { if (blockIdx.x == 0 && F.tid == 0) __hip_atomic_store(tsw + (k), rt(), RLX_AGENT); } while (0)
#else
#define STAMP(k) do {} while (0)
#endif
    STAMP(0);
    if (IN(0)) { p0_prologue(F, args); } SEAM(0); STAMP(1);
    if (IN(1)) REPS(1) {
        pg8::Gemm g{XB, (const bf16*)(ws + WS_WGU1), M, 2 * FF, D}; pg8::StaticOrder S; S.init(M, 2 * FF, F.G, (int)blockIdx.x);
        pg8::EpiSwiGLU E{HB, FF, ss, 1.0f / D};
        pg8::gemm_phase<pg8::EpiSwiGLU, pg8::StaticOrder, PG8_ALIGN, PG8_SP2>(F.lds + RING_OFF, g, S, E);
    } SEAM(1); STAMP(2);
    if (IN(2)) {
        pg8::Gemm g{HB, (const bf16*)(ws + WS_WD1), M, D, FF}; pg8::StaticOrder S; S.init(M, D, F.G, (int)blockIdx.x, 1);
        { pg8::EpiResB<false> E{XB, XB, ss + M, 0.5f};
          pg8::gemm_phase<pg8::EpiResB<false>, pg8::StaticOrder, PG8_ALIGN, PG8_SP2>(F.lds + RING_OFF, g, S, E); }
#if DUP_PHASE == 2
        { pg8::EpiResB<false> E{XB, (bf16*)(ws + WS_O), ss + 3 * M, 0.5f};
#ifdef DUP_AMASK
          g.pm_mask = DUP_AMASK;
#endif
#ifdef DUP_BMASK
          g.pn_mask = DUP_BMASK;
#endif
          pg8::gemm_phase<pg8::EpiResB<false>, pg8::StaticOrder, PG8_ALIGN, PG8_SP2>(F.lds + RING_OFF, g, S, E); }
#endif
    } SEAM(2); STAMP(3);
    if (IN(3)) {
        pg8::Gemm g{XB, (const bf16*)(ws + WS_WIN), M, NIN, D}; pg8::StaticOrder S; S.init(M, NIN, F.G, (int)blockIdx.x);
        pg8::EpiIn E{QB_, KB_, VB_, GBB, UB, ss + M, args.in[7], args.in[8], 0.125f * LOG2E};
        pg8::gemm_phase<pg8::EpiIn, pg8::StaticOrder, PG8_ALIGN, PG8_SP2>(F.lds + RING_OFF, g, S, E);
#if DUP_PHASE == 3
        pg8::gemm_phase<pg8::EpiIn, pg8::StaticOrder, PG8_ALIGN, PG8_SP2>(F.lds + RING_OFF, g, S, E);
#endif
    } SEAM(3); STAMP(4);
    if (IN(4)) REPS(4) {
#ifdef ABL_MASK
        if (!rep)
#endif
        conv_phase(F, UB, GBB, args.in[14], args.in[15], MIX);
        float lam;
        { const float a = args.in[9][F.lane] * args.in[10][F.lane], b2 = args.in[11][F.lane] * args.in[12][F.lane];
          lam = expf(wave_sum(a)) - expf(wave_sum(b2)) + LAM_INIT; }
        float mq = fabsf(args.in[7][F.lane]), mk = fabsf(args.in[8][F.lane]);
#pragma unroll
        for (int o_ = 1; o_ < 64; o_ <<= 1) { mq = fmaxf(mq, __shfl_xor(mq, o_)); mk = fmaxf(mk, __shfl_xor(mk, o_)); }
        const bool fast = __builtin_amdgcn_readfirstlane((int)(8.0f * LOG2E * mq * mk <= 30.0f)) != 0;
        const int nun = BATCH * NH * 16;
#ifdef ABL_MASK
        if (rep) {
            for (int i = 0; ; ++i) {
                const int L = i * F.G + F.vcu; if (L >= nun) break;
                const int round = L / 256, w = L % 256, bh = w >> 3, s = w & 7; const int qb = (round & 1) ? 15 - s : s;
                att::attn_unit<true, ABL_MASK>(bh >> 2, bh & 3, qb, QB_, KB_, VB_, (bf16*)(ws + WS_O), args.in[13], lam, F.lds + RING_OFF);
            }
        } else
#endif
        if (fast) {
            for (int i = 0; ; ++i) {
                const int L = i * F.G + F.vcu; if (L >= nun) break;
                const int round = L / 256, w = L % 256, bh = w >> 3, s = w & 7; const int qb = (round & 1) ? 15 - s : s;
                att::attn_unit<true, 0>(bh >> 2, bh & 3, qb, QB_, KB_, VB_, MIX, args.in[13], lam, F.lds + RING_OFF);
            }
        }
#ifndef ABL_MASK
        else {
            for (int i = 0; ; ++i) {
                const int L = i * F.G + F.vcu; if (L >= nun) break;
                const int round = L / 256, w = L % 256, bh = w >> 3, s = w & 7; const int qb = (round & 1) ? 15 - s : s;
                att::attn_unit<false, 0>(bh >> 2, bh & 3, qb, QB_, KB_, VB_, MIX, args.in[13], lam, F.lds + RING_OFF);
            }
        }
#endif
    } SEAM(4); STAMP(5);
    if (IN(5)) {
        pg8::Gemm g{MIX, (const bf16*)(ws + WS_WOUT), M, D, D}; pg8::StaticOrder S; S.init(M, D, F.G, (int)blockIdx.x);
        { pg8::EpiResB<false> E{XB, XB, ss + 2 * M, 1.0f};
          pg8::gemm_phase<pg8::EpiResB<false>, pg8::StaticOrder, PG8_ALIGN, PG8_SP2>(F.lds + RING_OFF, g, S, E); }
#if DUP_PHASE == 5
        { pg8::EpiResB<false> E{XB, (bf16*)(ws + WS_O), ss + 3 * M, 1.0f};
          pg8::gemm_phase<pg8::EpiResB<false>, pg8::StaticOrder, PG8_ALIGN, PG8_SP2>(F.lds + RING_OFF, g, S, E); }
#endif
    } SEAM(5); STAMP(6);
    if (IN(6)) {
        pg8::Gemm g{XB, (const bf16*)(ws + WS_WGU2), M, 2 * FF, D}; pg8::StaticOrder S; S.init(M, 2 * FF, F.G, (int)blockIdx.x);
        pg8::EpiSwiGLU E{HB, FF, ss + 2 * M, 1.0f / D};
        pg8::gemm_phase<pg8::EpiSwiGLU, pg8::StaticOrder, PG8_ALIGN, PG8_SP2>(F.lds + RING_OFF, g, S, E);
    } SEAM(6); STAMP(7);
    if (IN(7)) {
        pg8::Gemm g{HB, (const bf16*)(ws + WS_WD2), M, D, FF}; pg8::StaticOrder S; S.init(M, D, F.G, (int)blockIdx.x, 1);
        pg8::EpiResB<false> E{XB, XB, nullptr, 0.5f};
        pg8::gemm_phase<pg8::EpiResB<false>, pg8::StaticOrder, PG8_ALIGN, PG8_SP2>(F.lds + RING_OFF, g, S, E);
    } SEAM(7); STAMP(8);
    if (IN(8)) final_norm_phase(F, XB, args.out, args.in[21]);
#ifdef PROBE_PH_A
    STAMP(9);
    __syncthreads();
    if (blockIdx.x == 0 && F.wave == 0) {
        asm volatile("s_waitcnt vmcnt(0)" ::: "memory");
        const float ta = (float)(__hip_atomic_load(tsw + PROBE_PH_A + 1, RLX_AGENT) - __hip_atomic_load(tsw + PROBE_PH_A, RLX_AGENT)) * 0.01f;
        const float tb = (float)(__hip_atomic_load(tsw + PROBE_PH_B + 1, RLX_AGENT) - __hip_atomic_load(tsw + PROBE_PH_B, RLX_AGENT)) * 0.01f;
        if (F.lane == 0) args.out[0] += ta;
        for (int j = 1; j < 16; ++j) args.out[F.lane + 64 * j] += tb * 0.01f;
    }
#endif
#undef IN
#undef SEAM
}

#ifndef MK_N_LAUNCHES
#define MK_N_LAUNCHES 1
#endif
extern "C" void kernel_launch(void* const* d_in, const int* in_sizes, int n_in, void* d_out, int out_size, void* d_ws, size_t ws_size, hipStream_t stream) {
    static int grid = 0;
    if (grid == 0) {
        if (n_in != 22 || in_sizes[0] != M * D || out_size != M * D || ws_size < WS_END) { fprintf(stderr, "kernel_launch: unexpected shapes (n_in %d, in0 %d, out %d, ws %zu); nothing launched\n", n_in, n_in > 0 ? in_sizes[0] : -1, out_size, ws_size); grid = -1; return; }
        int dev = 0, cus = 0;
        if (hipGetDevice(&dev) != hipSuccess || hipDeviceGetAttribute(&cus, hipDeviceAttributeMultiprocessorCount, dev) != hipSuccess) { grid = -1; return; }
        if (hipFuncSetAttribute((const void*)fwd_kernel, hipFuncAttributeMaxDynamicSharedMemorySize, LDS_BYTES) != hipSuccess) { fprintf(stderr, "kernel_launch: hipFuncSetAttribute failed\n"); grid = -1; return; }
        (void)hipGetLastError();
        grid = cus;
    }
    if (grid < 0) return;
    if (hipMemsetAsync((char*)d_ws + WS_CTL, 0, CTL_ZERO_BYTES, stream) != hipSuccess) return;
    Args a{};
    for (int i = 0; i < 22; ++i) a.in[i] = (const float*)d_in[i];
    a.out = (float*)d_out; a.ws = (unsigned char*)d_ws;
    if (MK_N_LAUNCHES == 1) { a.ph_lo = 0; a.ph_hi = N_PHASES; hipLaunchKernelGGL(fwd_kernel, dim3(grid), dim3(NWAVES * 64), LDS_BYTES, stream, a); }
    else for (int p = 0; p < N_PHASES; ++p) { a.ph_lo = p; a.ph_hi = p + 1; hipLaunchKernelGGL(fwd_kernel, dim3(grid), dim3(NWAVES * 64), LDS_BYTES, stream, a); }
}
```

```cpp
#include <hip/hip_runtime.h>
#include <cstdio>
#include <cstdint>
namespace pg8 {
#define PG8_LAS __attribute__((address_space(3)))
typedef unsigned short bf16_t;
typedef short bf16x8 __attribute__((ext_vector_type(8)));
typedef float f32x4 __attribute__((ext_vector_type(4)));
typedef unsigned u32x4 __attribute__((ext_vector_type(4)));
constexpr int BM = 256, BK = 64, HALF = 128, HTB = HALF * BK * 2  , STAGE_BYTES = 8 * HTB, NXCD = 8, WGM = 8;

__host__ __device__ __forceinline__ int lds_byte(int r, int c) { const int st = (r >> 4) * 2 + (c >> 5), rr = r & 15, cc = c & 31, ob = rr * 64 + cc * 2; return st * 1024 + (ob ^ (((ob >> 9) & 1) << 5)); }
__host__ __device__ __forceinline__ void stage_rc(int b, int& R, int& C) { const int st = b / 1024, sb = b % 1024, swz = sb ^ (((sb >> 9) & 1) << 5); R = (st >> 1) * 16 + swz / 64; C = (st & 1) * 32 + (swz % 64) / 2; }
__host__ __device__ __forceinline__ int perm32(int rho) { const int n = rho >> 4, i = rho & 15; return 8 * (i >> 2) + 4 * n + (i & 3); }

struct Unit { int pm, pn; };
struct Gemm { const bf16_t* A; const bf16_t* Bt; int M, N, K; int pm_mask = -1, pn_mask = -1; };

struct StaticOrder {
    int nM, nN, nwg, G, c, rev;
    __host__ __device__ void init(int M, int N, int G_, int c_, int rev_ = 0) { nM = M / BM; nN = N / BM; nwg = nM * nN; G = G_; c = c_; rev = (rev_ && nwg % G_ == 0) ? 1 : 0; }
    __host__ __device__ bool next(int i, Unit& u) const {
        if (rev) { const int nr = nwg / G; if (i >= nr) return false; i = nr - 1 - i; }
        const long L = (long)i * G + c; if (L >= nwg) return false;
        int wgid = (int)L; { const int q = nwg / NXCD, r = nwg % NXCD, xcd = wgid % NXCD, off = wgid / NXCD; wgid = (xcd < r ? xcd * (q + 1) : r * (q + 1) + (xcd - r) * q) + off; }
        const int nig = WGM * nN, gid = wgid / nig, fm = gid * WGM, gsz = (nM - fm) < WGM ? (nM - fm) : WGM;
        u.pm = fm + ((wgid % nig) % gsz); u.pn = (wgid % nig) / gsz; return true;
    }
    __device__ __forceinline__ void a_ready(const Unit&) const {}
    __device__ __forceinline__ void done(const Unit&) const {}
};

__device__ __forceinline__ unsigned cvt_pk_bf16(float lo, float hi) { unsigned r; asm volatile("v_cvt_pk_bf16_f32 %0, %1, %2" : "=v"(r) : "v"(lo), "v"(hi)); return r; }
typedef float f32x2 __attribute__((ext_vector_type(2)));
typedef unsigned u32x2 __attribute__((ext_vector_type(2)));
constexpr float NORM_EPS = 1e-6f;
__device__ __forceinline__ float silu_mul(float g, float u) {
    const float e = __builtin_amdgcn_exp2f(g * -1.4426950408889634f);
    return g * u * __builtin_amdgcn_rcpf(1.0f + e);
}
struct EpiSwiGLU {
    static constexpr bool PERM = true, AFTER_DRAIN = false, DUPABLE = true;
    bf16_t* Hout; int ldh; const float* ss; float inv_k;
    __device__ __forceinline__ void operator()(const f32x4 (&acc)[2][2][4][2], const Unit& u, int wr, int wc, int fr, int fq) const {
        const int row0 = u.pm * BM + wr * 64 + fr, col0 = u.pn * HALF + wc * 32 + 8 * fq;
#pragma unroll
        for (int ai = 0; ai < 2; ++ai)
#pragma unroll
            for (int m = 0; m < 4; ++m) {
                const int row = row0 + ai * HALF + m * 16;
                const float rs = __builtin_amdgcn_rsqf(ss[row] * inv_k + NORM_EPS);
                const f32x4 g0 = acc[ai][0][m][0] * rs, g1 = acc[ai][0][m][1] * rs, u0 = acc[ai][1][m][0] * rs, u1 = acc[ai][1][m][1] * rs;
                u32x4 w;
                w.x = cvt_pk_bf16(silu_mul(g0[0], u0[0]), silu_mul(g0[1], u0[1]));
                w.y = cvt_pk_bf16(silu_mul(g0[2], u0[2]), silu_mul(g0[3], u0[3]));
                w.z = cvt_pk_bf16(silu_mul(g1[0], u1[0]), silu_mul(g1[1], u1[1]));
                w.w = cvt_pk_bf16(silu_mul(g1[2], u1[2]), silu_mul(g1[3], u1[3]));
                *(u32x4*)(Hout + (size_t)row * ldh + col0) = w;
            }
    }
};
template <bool RES_F32> struct EpiResB {
    static constexpr bool PERM = true, AFTER_DRAIN = false, DUPABLE = false;
    const void* res; bf16_t* out; float* ssacc; float scale;
    __device__ __forceinline__ void operator()(const f32x4 (&acc)[2][2][4][2], const Unit& u, int wr, int wc, int fr, int fq) const {
        const int row0 = u.pm * BM + wr * 64 + fr, col0 = u.pn * BM + wc * 32 + 8 * fq;
#pragma unroll
        for (int ai = 0; ai < 2; ++ai) {
            float srow[4];
            if constexpr (RES_F32) {
                const float* rp = (const float*)res;
#pragma unroll
                for (int mh = 0; mh < 2; ++mh) {
                    f32x4 rv[2][2][2];
#pragma unroll
                    for (int mm = 0; mm < 2; ++mm)
#pragma unroll
                        for (int bj = 0; bj < 2; ++bj)
#pragma unroll
                            for (int n = 0; n < 2; ++n) rv[mm][bj][n] = *(const f32x4*)(rp + (size_t)(row0 + ai * HALF + (2 * mh + mm) * 16) * 1024 + col0 + bj * HALF + 4 * n);
#pragma unroll
                    for (int mm = 0; mm < 2; ++mm) {
                        const int m = 2 * mh + mm; const size_t off = (size_t)(row0 + ai * HALF + m * 16) * 1024 + col0; float s = 0.f;
#pragma unroll
                        for (int bj = 0; bj < 2; ++bj) {
                            const f32x4 a = rv[mm][bj][0] + acc[ai][bj][m][0] * scale, b = rv[mm][bj][1] + acc[ai][bj][m][1] * scale;
                            s += (a[0] * a[0] + a[1] * a[1]) + (a[2] * a[2] + a[3] * a[3]) + (b[0] * b[0] + b[1] * b[1]) + (b[2] * b[2] + b[3] * b[3]);
                            u32x4 w; w.x = cvt_pk_bf16(a[0], a[1]); w.y = cvt_pk_bf16(a[2], a[3]); w.z = cvt_pk_bf16(b[0], b[1]); w.w = cvt_pk_bf16(b[2], b[3]);
                            *(u32x4*)(out + off + bj * HALF) = w;
                        }
                        s += __shfl_xor(s, 16); s += __shfl_xor(s, 32); srow[m] = s;
                    }
                    asm volatile("" ::: "memory");
                }
            } else {
                const bf16_t* rp = (const bf16_t*)res;
                u32x4 rv[4][2];
#pragma unroll
                for (int m = 0; m < 4; ++m)
#pragma unroll
                    for (int bj = 0; bj < 2; ++bj) rv[m][bj] = *(const u32x4*)(rp + (size_t)(row0 + ai * HALF + m * 16) * 1024 + col0 + bj * HALF);
#pragma unroll
                for (int m = 0; m < 4; ++m) {
                    const size_t off = (size_t)(row0 + ai * HALF + m * 16) * 1024 + col0; float s = 0.f;
#pragma unroll
                    for (int bj = 0; bj < 2; ++bj) {
                        const u32x4 r = rv[m][bj];
                        const f32x4 ra = {__uint_as_float(r.x << 16), __uint_as_float(r.x & 0xffff0000u), __uint_as_float(r.y << 16), __uint_as_float(r.y & 0xffff0000u)};
                        const f32x4 rb = {__uint_as_float(r.z << 16), __uint_as_float(r.z & 0xffff0000u), __uint_as_float(r.w << 16), __uint_as_float(r.w & 0xffff0000u)};
                        const f32x4 a = ra + acc[ai][bj][m][0] * scale, b = rb + acc[ai][bj][m][1] * scale;
                        s += (a[0] * a[0] + a[1] * a[1]) + (a[2] * a[2] + a[3] * a[3]) + (b[0] * b[0] + b[1] * b[1]) + (b[2] * b[2] + b[3] * b[3]);
                        u32x4 w; w.x = cvt_pk_bf16(a[0], a[1]); w.y = cvt_pk_bf16(a[2], a[3]); w.z = cvt_pk_bf16(b[0], b[1]); w.w = cvt_pk_bf16(b[2], b[3]);
                        *(u32x4*)(out + off + bj * HALF) = w;
                    }
                    s += __shfl_xor(s, 16); s += __shfl_xor(s, 32); srow[m] = s;
                }
                asm volatile("" ::: "memory");
            }
            if (ssacc) {
                const float v = fq == 0 ? srow[0] : fq == 1 ? srow[1] : fq == 2 ? srow[2] : srow[3];
                atomicAdd(ssacc + u.pm * BM + ai * HALF + wr * 64 + fq * 16 + fr, v);
            }
        }
    }
};
struct EpiIn {
    static constexpr bool PERM = true, AFTER_DRAIN = false, DUPABLE = false;
    bf16_t *Q, *K, *V, *GB, *U;
    const float* ss; const float* qg; const float* kg; float qscale;
    __device__ __forceinline__ void operator()(const f32x4 (&acc)[2][2][4][2], const Unit& u, int wr, int wc, int fr, int fq) const {
        const int row0 = u.pm * BM + wr * 64 + fr; const int pn = u.pn;
        if (pn < 4) {
            bf16_t* dst = (pn < 2 ? Q : K) + (size_t)(64 * (4 * (pn & 1) + wc)) + 8 * fq;
            const float* gp = (pn < 2 ? qg : kg) + 8 * fq; const float sc = pn < 2 ? qscale : 1.0f;
            f32x4 gv[2][2];
#pragma unroll
            for (int bj = 0; bj < 2; ++bj)
#pragma unroll
                for (int n = 0; n < 2; ++n) gv[bj][n] = *(const f32x4*)(gp + 32 * bj + 4 * n) * sc;
#pragma unroll
            for (int ai = 0; ai < 2; ++ai)
#pragma unroll
                for (int m = 0; m < 4; ++m) {
                    const int row = row0 + ai * HALF + m * 16;
                    const float rs = __builtin_amdgcn_rsqf(ss[row] * (1.0f / 1024.0f) + NORM_EPS);
                    f32x4 t[2][2]; float s = 0.f;
#pragma unroll
                    for (int bj = 0; bj < 2; ++bj)
#pragma unroll
                        for (int n = 0; n < 2; ++n) { t[bj][n] = acc[ai][bj][m][n] * rs; const f32x4 x = t[bj][n]; s += (x[0] * x[0] + x[1] * x[1]) + (x[2] * x[2] + x[3] * x[3]); }
                    s += __shfl_xor(s, 16); s += __shfl_xor(s, 32);
                    const float rn = __builtin_amdgcn_rsqf(s * (1.0f / 64.0f) + NORM_EPS);
#pragma unroll
                    for (int bj = 0; bj < 2; ++bj) {
                        const f32x4 a = t[bj][0] * rn * gv[bj][0], b = t[bj][1] * rn * gv[bj][1];
                        u32x4 w; w.x = cvt_pk_bf16(a[0], a[1]); w.y = cvt_pk_bf16(a[2], a[3]); w.z = cvt_pk_bf16(b[0], b[1]); w.w = cvt_pk_bf16(b[2], b[3]);
                        *(u32x4*)(dst + (size_t)row * 512 + 32 * bj) = w;
                    }
                }
        } else if (pn < 8) {
            bf16_t* dst = (pn < 6 ? V : GB) + (size_t)(256 * (pn & 1) + wc * 32 + 8 * fq);
#pragma unroll
            for (int ai = 0; ai < 2; ++ai)
#pragma unroll
                for (int m = 0; m < 4; ++m) {
                    const int row = row0 + ai * HALF + m * 16;
                    const float rs = __builtin_amdgcn_rsqf(ss[row] * (1.0f / 1024.0f) + NORM_EPS);
#pragma unroll
                    for (int bj = 0; bj < 2; ++bj) {
                        const f32x4 a = acc[ai][bj][m][0] * rs, b = acc[ai][bj][m][1] * rs;
                        u32x4 w; w.x = cvt_pk_bf16(a[0], a[1]); w.y = cvt_pk_bf16(a[2], a[3]); w.z = cvt_pk_bf16(b[0], b[1]); w.w = cvt_pk_bf16(b[2], b[3]);
                        *(u32x4*)(dst + (size_t)row * 512 + HALF * bj) = w;
                    }
                }
        } else {
            bf16_t* dst = U + (size_t)(128 * (pn - 8) + wc * 32 + 8 * fq);
#pragma unroll
            for (int ai = 0; ai < 2; ++ai)
#pragma unroll
                for (int m = 0; m < 4; ++m) {
                    const int row = row0 + ai * HALF + m * 16;
                    const float rs = __builtin_amdgcn_rsqf(ss[row] * (1.0f / 1024.0f) + NORM_EPS); const float rs2 = rs * rs;
                    const f32x4 a = acc[ai][0][m][0] * acc[ai][1][m][0] * rs2, b = acc[ai][0][m][1] * acc[ai][1][m][1] * rs2;
                    u32x4 w; w.x = cvt_pk_bf16(a[0], a[1]); w.y = cvt_pk_bf16(a[2], a[3]); w.z = cvt_pk_bf16(b[0], b[1]); w.w = cvt_pk_bf16(b[2], b[3]);
                    *(u32x4*)(dst + (size_t)row * 512) = w;
                }
        }
    }
};

template <class Epi, class Sched, bool ALIGN_EPI = false, bool SP2 = false>
__device__ __forceinline__ void gemm_phase(PG8_LAS unsigned char* lds, const Gemm g, const Sched& S, const Epi& E) {
    const int tid = threadIdx.x, wid = __builtin_amdgcn_readfirstlane(tid >> 6), lane = tid & 63, wr = wid >> 2, wc = wid & 3, fr = lane & 15, fq = lane >> 4;
    const int K = g.K, nt = K / BK;
    unsigned voffA[2], voffB[2];
#pragma unroll
    for (int i = 0; i < 2; ++i) { int R, C; stage_rc(tid * 16 + i * 8192, R, C); const int Rb = Epi::PERM ? ((R & ~31) + perm32(R & 31)) : R;
        voffA[i] = (unsigned)(R * K + C) * 2u; voffB[i] = (unsigned)(Rb * K + C) * 2u; }
    const size_t kstep = (size_t)(BK * 2);
    const size_t hstep = (size_t)HALF * K * 2;
    const size_t tstep = 2 * hstep;
    const unsigned ldsw = (unsigned)wid * 1024u;
    const int aoff = lds_byte(wr * 64 + fr, fq * 8), boff = lds_byte(wc * 32 + fr, fq * 8);
#define PG8_SA(b, h) (((b) * 2 + (h)) * HTB)
#define PG8_SB(b, h) ((4 + (b) * 2 + (h)) * HTB)
#define PG8_STAGE(bufoff, gbase, voff) do { _Pragma("unroll") for (int _i = 0; _i < 2; ++_i) \
        __builtin_amdgcn_global_load_lds((const unsigned*)((const char*)(gbase) + (voff)[_i]), (PG8_LAS unsigned*)(lds + (bufoff) + ldsw + _i * 8192), 16, 0, 0); } while (0)
#define PG8_LDA(dst, b, h) do { _Pragma("unroll") for (int m = 0; m < 4; ++m) _Pragma("unroll") for (int k = 0; k < 2; ++k) dst[m][k] = *(const PG8_LAS bf16x8*)(lds + PG8_SA(b, h) + aoff + m * 2048 + k * 1024); } while (0)
#define PG8_LDB(dst, b, h) do { _Pragma("unroll") for (int n = 0; n < 2; ++n) _Pragma("unroll") for (int k = 0; k < 2; ++k) dst[n][k] = *(const PG8_LAS bf16x8*)(lds + PG8_SB(b, h) + boff + n * 2048 + k * 1024); } while (0)
#define PG8_MMA(ai, bj, At, Bt) do { __builtin_amdgcn_s_setprio(1); _Pragma("unroll") for (int m = 0; m < 4; ++m) _Pragma("unroll") for (int n = 0; n < 2; ++n) _Pragma("unroll") for (int k = 0; k < 2; ++k) \
        acc[ai][bj][m][n] = __builtin_amdgcn_mfma_f32_16x16x32_bf16(Bt[n][k], At[m][k], acc[ai][bj][m][n], 0, 0, 0); __builtin_amdgcn_s_setprio(0); } while (0)
#define PG8_WAIT_V(n) asm volatile("s_waitcnt vmcnt(" #n ")" ::: "memory")
#define PG8_WAIT_L(n) asm volatile("s_waitcnt lgkmcnt(" #n ")" ::: "memory")
#define PG8_BAR __builtin_amdgcn_s_barrier()
#define PG8_SCHED __builtin_amdgcn_sched_barrier(0)
    Unit cur, nxt; int ui = 0;
    if (!S.next(0, cur)) return;
    f32x4 acc[2][2][4][2];
#pragma unroll
    for (int a = 0; a < 2; ++a)
#pragma unroll
        for (int b = 0; b < 2; ++b)
#pragma unroll
            for (int m = 0; m < 4; ++m)
#pragma unroll
                for (int n = 0; n < 2; ++n) acc[a][b][m][n] = (f32x4){0.f, 0.f, 0.f, 0.f};
    bf16x8 At[4][2], B0[2][2], B1[2][2];
    const char* cA = (const char*)g.A + (size_t)(cur.pm & g.pm_mask) * tstep; const char* cB = (const char*)g.Bt + (size_t)(cur.pn & g.pn_mask) * tstep;
    S.a_ready(cur);
    if constexpr (SP2) {
        PG8_STAGE(PG8_SB(0, 0), cB, voffB); PG8_STAGE(PG8_SB(0, 1), cB + hstep, voffB); PG8_STAGE(PG8_SA(0, 0), cA, voffA); PG8_STAGE(PG8_SA(0, 1), cA + hstep, voffA);
        if (wr == 1) PG8_BAR;
        PG8_WAIT_V(2); PG8_BAR;
        PG8_STAGE(PG8_SB(1, 0), cB + kstep, voffB); PG8_STAGE(PG8_SA(1, 0), cA + kstep, voffA); PG8_STAGE(PG8_SB(1, 1), cB + hstep + kstep, voffB);
        PG8_WAIT_V(6); PG8_BAR;
    } else {
        PG8_STAGE(PG8_SB(0, 0), cB, voffB); PG8_STAGE(PG8_SA(0, 0), cA, voffA); PG8_STAGE(PG8_SB(0, 1), cB + hstep, voffB); PG8_STAGE(PG8_SA(0, 1), cA + hstep, voffA);
        if (wr == 1) PG8_BAR;
        PG8_WAIT_V(4); PG8_BAR;
        PG8_STAGE(PG8_SB(1, 0), cB + kstep, voffB); PG8_STAGE(PG8_SA(1, 0), cA + kstep, voffA); PG8_STAGE(PG8_SB(1, 1), cB + hstep + kstep, voffB);
        PG8_WAIT_V(6); PG8_BAR;
    }
    for (;;) {
        const bool has_next = S.next(ui + 1, nxt);
        const char* nA = has_next ? (const char*)g.A + (size_t)(nxt.pm & g.pm_mask) * tstep : cA; const char* nB = has_next ? (const char*)g.Bt + (size_t)(nxt.pn & g.pn_mask) * tstep : cB;
        for (int t = 0; t < nt; t += 2) {
            const bool last = (t == nt - 2);
            const char* a1 = cA + (size_t)(t + 1) * kstep;
            const char* a2 = last ? nA : cA + (size_t)(t + 2) * kstep; const char* b2 = last ? nB : cB + (size_t)(t + 2) * kstep;
            const char* a3 = a2 + kstep; const char* b3 = b2 + kstep;
            if (last && has_next) S.a_ready(nxt);
            if constexpr (SP2) {
            PG8_LDB(B0, 0, 0); PG8_LDB(B1, 0, 1); PG8_SCHED; PG8_LDA(At, 0, 0); PG8_STAGE(PG8_SA(1, 1), a1 + hstep, voffA);
            PG8_WAIT_V(8); PG8_WAIT_L(0); PG8_BAR; PG8_MMA(0, 0, At, B0); PG8_MMA(0, 1, At, B1); PG8_BAR; PG8_SCHED;
            PG8_LDA(At, 0, 1); PG8_STAGE(PG8_SB(0, 0), b2, voffB); PG8_STAGE(PG8_SB(0, 1), b2 + hstep, voffB); PG8_STAGE(PG8_SA(0, 0), a2, voffA);
            PG8_WAIT_V(8); PG8_WAIT_L(0); PG8_BAR; PG8_MMA(1, 0, At, B0); PG8_MMA(1, 1, At, B1); PG8_BAR; PG8_SCHED;
            PG8_LDB(B0, 1, 0); PG8_LDB(B1, 1, 1); PG8_SCHED; PG8_LDA(At, 1, 0); PG8_STAGE(PG8_SA(0, 1), a2 + hstep, voffA);
            PG8_WAIT_V(8); PG8_WAIT_L(0); PG8_BAR; PG8_MMA(0, 0, At, B0); PG8_MMA(0, 1, At, B1); PG8_BAR; PG8_SCHED;
            PG8_LDA(At, 1, 1); PG8_STAGE(PG8_SB(1, 0), b3, voffB); PG8_STAGE(PG8_SB(1, 1), b3 + hstep, voffB); PG8_STAGE(PG8_SA(1, 0), a3, voffA);
            PG8_WAIT_V(8); PG8_WAIT_L(0); PG8_BAR; PG8_MMA(1, 0, At, B0); PG8_MMA(1, 1, At, B1); PG8_BAR; PG8_SCHED;
            } else {
            PG8_LDB(B0, 0, 0); PG8_SCHED; PG8_LDA(At, 0, 0); PG8_STAGE(PG8_SA(1, 1), a1 + hstep, voffA);
            PG8_WAIT_L(8); PG8_BAR; PG8_WAIT_L(0); PG8_MMA(0, 0, At, B0); PG8_BAR; PG8_SCHED;
            PG8_LDB(B1, 0, 1); PG8_STAGE(PG8_SB(0, 0), b2, voffB);
            PG8_BAR; PG8_WAIT_L(0); PG8_MMA(0, 1, At, B1); PG8_BAR;
            PG8_LDA(At, 0, 1); PG8_STAGE(PG8_SA(0, 0), a2, voffA);
            PG8_BAR; PG8_WAIT_L(0); PG8_MMA(1, 0, At, B0); PG8_BAR; PG8_SCHED;
            PG8_STAGE(PG8_SB(0, 1), b2 + hstep, voffB);
            PG8_WAIT_V(6); PG8_BAR; PG8_MMA(1, 1, At, B1); PG8_BAR;
            PG8_LDB(B0, 1, 0); PG8_SCHED; PG8_LDA(At, 1, 0); PG8_STAGE(PG8_SA(0, 1), a2 + hstep, voffA);
            PG8_WAIT_L(8); PG8_BAR; PG8_WAIT_L(0); PG8_MMA(0, 0, At, B0); PG8_BAR; PG8_SCHED;
            PG8_LDB(B1, 1, 1); PG8_STAGE(PG8_SB(1, 0), b3, voffB);
            PG8_BAR; PG8_WAIT_L(0); PG8_MMA(0, 1, At, B1); PG8_BAR;
            PG8_LDA(At, 1, 1); PG8_STAGE(PG8_SA(1, 0), a3, voffA);
            PG8_BAR; PG8_WAIT_L(0); PG8_MMA(1, 0, At, B0); PG8_BAR; PG8_SCHED;
            PG8_STAGE(PG8_SB(1, 1), b3 + hstep, voffB);
            PG8_WAIT_V(6); PG8_BAR; PG8_MMA(1, 1, At, B1); PG8_BAR;
            }
        }
        if constexpr (ALIGN_EPI) { if (wr == 0) PG8_BAR; }
        if constexpr (!Epi::AFTER_DRAIN) { E(acc, cur, wr, wc, fr, fq);
#ifdef DUP_EPI
            if constexpr (Epi::DUPABLE) { asm volatile("" ::: "memory"); E(acc, cur, wr, wc, fr, fq); }
#endif
            S.done(cur); }
        if (!has_next) break;
#pragma unroll
        for (int a = 0; a < 2; ++a)
#pragma unroll
            for (int b = 0; b < 2; ++b)
#pragma unroll
                for (int m = 0; m < 4; ++m)
#pragma unroll
                    for (int n = 0; n < 2; ++n) acc[a][b][m][n] = (f32x4){0.f, 0.f, 0.f, 0.f};
        cur = nxt; cA = nA; cB = nB; ++ui;
        if constexpr (ALIGN_EPI) { if (wr == 1) PG8_BAR; }
    }
    PG8_WAIT_V(0);
    if constexpr (!ALIGN_EPI) { if (wr == 0) PG8_BAR; }
    PG8_BAR;
    if constexpr (Epi::AFTER_DRAIN) { E.fused(acc, cur, wr, wc, fr, fq, lds, wid, lane); S.done(cur); }
#undef PG8_SA
#undef PG8_SB
#undef PG8_STAGE
#undef PG8_LDA
#undef PG8_LDB
#undef PG8_MMA
#undef PG8_WAIT_V
#undef PG8_WAIT_L
#undef PG8_BAR
#undef PG8_SCHED
}
}

#ifndef PG8_SP2
#define PG8_SP2 true
#endif
#ifndef PG8_ALIGN
#define PG8_ALIGN true
#endif
#define GAS __attribute__((address_space(1)))
#define LAS __attribute__((address_space(3)))
typedef unsigned short bf16;
typedef unsigned v4u __attribute__((ext_vector_type(4)));
typedef float f32x4 __attribute__((ext_vector_type(4)));
typedef short bf16x8 __attribute__((ext_vector_type(8)));
typedef GAS unsigned gu32;
typedef GAS unsigned long long gu64;
#define RLX_AGENT __ATOMIC_RELAXED, __HIP_MEMORY_SCOPE_AGENT
#define LDS_WAIT() asm volatile("s_waitcnt lgkmcnt(0)" ::: "memory")
#define VM_WAIT() asm volatile("s_waitcnt vmcnt(0)" ::: "memory")
__device__ __forceinline__ unsigned long long rt() { return __builtin_amdgcn_s_memrealtime(); }
__device__ __forceinline__ unsigned f2bf(float f) { unsigned u = __builtin_bit_cast(unsigned, f); return (u + 0x7fffu + ((u >> 16) & 1u)) >> 16; }
__device__ __forceinline__ unsigned pk2(float lo, float hi) { return f2bf(lo) | (f2bf(hi) << 16); }

#define XB_TMO      128
#define XB_XCNT(j)  (256  + 64 * (j))
#define XB_XSUB(j)  (1280 + 64 * (j))
#define XB_XGEN(j)  (2304 + 64 * (j))
#define XB_TOP      3328
#define XB_TOPGEN   3392
#define XCD_BAR_WORDS 3456
#define XB_SPIN_CAP (1u << 18)

__device__ __forceinline__ unsigned xb_ld(unsigned* p)              { return __hip_atomic_load(p, __ATOMIC_RELAXED, __HIP_MEMORY_SCOPE_AGENT); }
__device__ __forceinline__ unsigned xb_add(unsigned* p, unsigned v) { return __hip_atomic_fetch_add(p, v, __ATOMIC_RELAXED, __HIP_MEMORY_SCOPE_AGENT); }
__device__ __forceinline__ unsigned xb_xcc_id() { return (unsigned)__builtin_amdgcn_s_getreg((3 << 11) | 20) & 0xFu; }
#define XB_SPIN(cond, bar) do { unsigned _sp = 0; while (cond) { __builtin_amdgcn_s_sleep(1); \
    if ((++_sp & 255u) == 0u) { if (xb_ld(&(bar)[XB_TMO])) break; if (_sp > XB_SPIN_CAP) { atomicAdd(&(bar)[XB_TMO], 1u); break; } } } } while (0)

struct XcdBarrier {
    unsigned* bar; unsigned x;
    volatile LAS unsigned* st;
};

__device__ __forceinline__ XcdBarrier xcd_barrier_post(unsigned* bar, volatile LAS unsigned* st) {
    XcdBarrier b; b.bar = bar; b.x = xb_xcc_id(); b.st = st;
    if (threadIdx.x == 0) (void)xb_add(&bar[XB_XCNT(b.x)], 1u);
    return b;
}
__device__ __forceinline__ void xcd_barrier_complete(unsigned* bar, unsigned x, unsigned& nloc, unsigned& nx) {
    const unsigned G = gridDim.x * gridDim.y * gridDim.z;
    unsigned sum, cnt, mine, sp = 0u;
    for (;;) {
        sum = 0u; cnt = 0u; mine = 0u;
#pragma unroll
        for (unsigned j = 0; j < 16; ++j) { const unsigned c = xb_ld(&bar[XB_XCNT(j)]); sum += c; cnt += (c > 0u) ? 1u : 0u; mine = (j == x) ? c : mine; }
        if (sum == G) break;
        __builtin_amdgcn_s_sleep(1);
        if ((++sp & 255u) == 0u) { if (xb_ld(&bar[XB_TMO])) break; if (sp > XB_SPIN_CAP) { atomicAdd(&bar[XB_TMO], 1u); break; } }
    }
    nloc = mine > 0u ? mine : 1u; nx = cnt > 0u ? cnt : 1u;
}

__device__ __forceinline__ void xcd_barrier(const XcdBarrier& b) {
    asm volatile("s_waitcnt vmcnt(0)" ::: "memory");
    __syncthreads();
    if (threadIdx.x == 0) {
        unsigned* bar = b.bar;
        __builtin_amdgcn_s_waitcnt(0);
        unsigned nloc = b.st[0], nx = b.st[1];
        if (nloc == 0u) { xcd_barrier_complete(bar, b.x, nloc, nx); b.st[0] = nloc; b.st[1] = nx; }
        const unsigned old = xb_add(&bar[XB_XSUB(b.x)], 1u);
        const unsigned gen = old / nloc;
        if (old + 1u == (gen + 1u) * nloc) {
            __builtin_amdgcn_fence(__ATOMIC_RELEASE, "agent");
            asm volatile("s_waitcnt vmcnt(0)" ::: "memory");
            const unsigned og = xb_add(&bar[XB_TOP], 1u);
            const unsigned tg = og / nx;
            if (og + 1u == (tg + 1u) * nx) xb_add(&bar[XB_TOPGEN], 1u);
            else XB_SPIN(xb_ld(&bar[XB_TOPGEN]) == tg, bar);
            __builtin_amdgcn_fence(__ATOMIC_ACQUIRE, "agent");
            xb_add(&bar[XB_XGEN(b.x)], 1u);
            asm volatile("s_waitcnt vmcnt(0)" ::: "memory");
        } else {
            XB_SPIN(xb_ld(&bar[XB_XGEN(b.x)]) == gen, bar);
            __builtin_amdgcn_fence(__ATOMIC_ACQUIRE, "agent");
            asm volatile("s_waitcnt vmcnt(0)" ::: "memory");
        }
    }
    __syncthreads();
}
#ifndef DUP_PHASE
#define DUP_PHASE -1
#endif

constexpr int NWAVES = 8;
constexpr int BATCH = 8, SEQ = 4096, D = 1024, FF = 2816, NIN = 3072, NH = 4;
constexpr int M = BATCH * SEQ;
constexpr float EPS = 1e-6f;
constexpr float LAM_INIT = 0.2f;
constexpr float LOG2E = 1.4426950408889634f;

constexpr size_t MiB = 1u << 20;
constexpr size_t WS_CTL = 0, CTL_ZERO_BYTES = 1 * MiB;
constexpr size_t WS_SS = 1 * MiB;
constexpr size_t WS_WGU1 = 2 * MiB, WS_WD1 = 13 * MiB, WS_WIN = 19 * MiB, WS_WOUT = 25 * MiB, WS_WGU2 = 27 * MiB, WS_WD2 = 38 * MiB;
constexpr size_t WS_XB = 48 * MiB;
constexpr size_t WS_H = 112 * MiB;
constexpr size_t WS_Q = WS_H, WS_K = WS_H + 32 * MiB, WS_V = WS_H + 64 * MiB, WS_GB = WS_H + 96 * MiB, WS_U = WS_H + 128 * MiB;
constexpr size_t WS_MIX = 288 * MiB;
constexpr size_t WS_O = 352 * MiB;
constexpr size_t WS_END = 416 * MiB;
static_assert(WS_WD2 + (size_t)D * FF * 2 <= WS_XB && WS_U + (size_t)M * 512 * 2 <= WS_H + (size_t)M * FF * 2 && WS_H + (size_t)M * FF * 2 <= WS_MIX, "d_ws map");
constexpr int CW_TMO = 0, CW_CODE = 1, CW_BAR = 4096;

constexpr int RING_OFF = 0, RING_BYTES = 131072;
constexpr int LDS_BYTES = 163840;
constexpr int LDSCTL_OFF = LDS_BYTES - 512, MISC_OFF = LDSCTL_OFF + 320;
static_assert(MISC_OFF + 128 <= LDS_BYTES && RING_BYTES <= LDSCTL_OFF, "LDS map");

typedef unsigned u32x4 __attribute__((ext_vector_type(4)));
typedef float f32x16 __attribute__((ext_vector_type(16)));
typedef short s16x4 __attribute__((ext_vector_type(4)));

struct Frame {
    LAS unsigned char* lds;
    volatile LAS unsigned* MISC;
    gu32* ctl;
    int tid, lane, wave, vcu, G;
};

__device__ __forceinline__ float wave_sum(float v) {
#pragma unroll
    for (int o = 1; o < 64; o <<= 1) v += __shfl_xor(v, o);
    return v;
}

__device__ __forceinline__ void transpose_item(const float* W, int srcN, int s0, int k0, const float* gain, bf16* WT, int K, int n0, LAS float* scr, int lane) {
    const int kr = lane >> 3, n4 = (lane & 7) * 4;
    f32x4 v[8]; float gk[8];
#pragma unroll
    for (int i = 0; i < 8; ++i) { v[i] = *(const GAS f32x4*)(W + (size_t)(k0 + 8 * i + kr) * srcN + s0 + n4); gk[i] = gain ? gain[k0 + 8 * i + kr] : 1.0f; }
#pragma unroll
    for (int i = 0; i < 8; ++i) { LAS float* d = scr + (8 * i + kr) * 33 + n4; const f32x4 x = v[i] * gk[i]; d[0] = x.x; d[1] = x.y; d[2] = x.z; d[3] = x.w; }
    LDS_WAIT(); asm volatile("" ::: "memory");
    const int c = lane & 7;
#pragma unroll
    for (int j = 0; j < 4; ++j) { const int n = (lane >> 3) + 8 * j; const LAS float* s = scr + (8 * c) * 33 + n;
        v4u o; o.x = pk2(s[0 * 33], s[1 * 33]); o.y = pk2(s[2 * 33], s[3 * 33]); o.z = pk2(s[4 * 33], s[5 * 33]); o.w = pk2(s[6 * 33], s[7 * 33]);
        *(GAS v4u*)(WT + (size_t)(n0 + n) * K + k0 + 8 * c) = o; }
    LDS_WAIT(); asm volatile("" ::: "memory");
}
struct Args { const float* in[22]; float* out; unsigned char* ws; int ph_lo, ph_hi; };

__device__ __forceinline__ void p0_prologue(Frame& F, const Args& A) {
    LAS float* scr = (LAS float*)(F.lds + RING_OFF + F.wave * 16384);
    const int gw = F.vcu * NWAVES + F.wave, NGW = F.G * NWAVES;
    unsigned char* ws = A.ws;
    constexpr int I_GU = (D / 64) * (2 * FF / 32), I_DN = (FF / 64) * (D / 32), I_IN = (D / 64) * (NIN / 32), I_OUT = (D / 64) * (D / 32);
    constexpr int NITEMS = 2 * I_GU + 2 * I_DN + I_IN + I_OUT;
    for (int it = gw; it < NITEMS; it += NGW) {
        int r = it;
        if (r < 2 * I_GU) {
            const int l = r >= I_GU; if (l) r -= I_GU;
            constexpr int nblk = 2 * FF / 32; const int kb = r / nblk, nb = r % nblk, n0 = 32 * nb;
            const int pn = n0 >> 8, half = (n0 >> 7) & 1, j = n0 & 127;
            const float* W = A.in[l ? (half ? 19 : 18) : (half ? 3 : 2)];
            transpose_item(W, FF, 128 * pn + j, 64 * kb, A.in[l ? 17 : 1], (bf16*)(ws + (l ? WS_WGU2 : WS_WGU1)), D, n0, scr, F.lane);
            continue;
        }
        r -= 2 * I_GU;
        if (r < 2 * I_DN) {
            const int l = r >= I_DN; if (l) r -= I_DN;
            constexpr int nblk = D / 32; const int kb = r / nblk, nb = r % nblk;
            transpose_item(A.in[l ? 20 : 4], D, 32 * nb, 64 * kb, nullptr, (bf16*)(ws + (l ? WS_WD2 : WS_WD1)), FF, 32 * nb, scr, F.lane);
            continue;
        }
        r -= 2 * I_DN;
        if (r < I_IN) {
            constexpr int nblk = NIN / 32; const int kb = r / nblk, nb = r % nblk, n0 = 32 * nb;
            const int pn = n0 >> 8, half = (n0 >> 7) & 1, j = n0 & 127;
            int s0;
            if (pn < 4) s0 = (pn >> 1) * 512 + 64 * (4 * (pn & 1) + (j >> 5)) + 32 * half;
            else if (pn < 8) s0 = n0;
            else s0 = (half ? 2560 : 2048) + 128 * (pn - 8) + j;
            transpose_item(A.in[6], NIN, s0, 64 * kb, A.in[5], (bf16*)(ws + WS_WIN), D, n0, scr, F.lane);
            continue;
        }
        r -= I_IN;
        { constexpr int nblk = D / 32; const int kb = r / nblk, nb = r % nblk;
          transpose_item(A.in[16], D, 32 * nb, 64 * kb, nullptr, (bf16*)(ws + WS_WOUT), D, 32 * nb, scr, F.lane); }
    }
    const float* x = A.in[0]; bf16* xb = (bf16*)(ws + WS_XB); float* ss = (float*)(ws + WS_SS);
    for (int m0 = 4 * gw; m0 < M; m0 += 4 * NGW) {
        f32x4 v[4][4]; float sq[4];
#pragma unroll
        for (int q = 0; q < 4; ++q) { const GAS f32x4* xr = (const GAS f32x4*)(x + (size_t)(m0 + q) * D) + F.lane;
#pragma unroll
            for (int j = 0; j < 4; ++j) v[q][j] = xr[64 * j]; }
#pragma unroll
        for (int q = 0; q < 4; ++q) { float s = 0.f;
#pragma unroll
            for (int j = 0; j < 4; ++j) s += (v[q][j].x * v[q][j].x + v[q][j].y * v[q][j].y) + (v[q][j].z * v[q][j].z + v[q][j].w * v[q][j].w);
            sq[q] = s; }
#pragma unroll
        for (int o_ = 1; o_ < 64; o_ <<= 1) {
#pragma unroll
            for (int q = 0; q < 4; ++q) sq[q] += __shfl_xor(sq[q], o_); }
#pragma unroll
        for (int q = 0; q < 4; ++q) { GAS unsigned long long* o8 = (GAS unsigned long long*)(xb + (size_t)(m0 + q) * D) + F.lane;
#pragma unroll
            for (int j = 0; j < 4; ++j) o8[64 * j] = (unsigned long long)pk2(v[q][j].x, v[q][j].y) | ((unsigned long long)pk2(v[q][j].z, v[q][j].w) << 32); }
        if (F.lane < 4) { const float sv = F.lane == 0 ? sq[0] : F.lane == 1 ? sq[1] : F.lane == 2 ? sq[2] : sq[3]; ss[m0 + F.lane] = sv; ss[M + m0 + F.lane] = 0.f; ss[2 * M + m0 + F.lane] = 0.f; }
    }
}

namespace att {
constexpr int L_K = 0, L_V = 16384, L_WS = 49152, L_Q = 53248, L_OST = 86016, L_END = L_OST + 65536;
constexpr float THR = 8.0f;
static_assert(L_END <= LDSCTL_OFF, "attention LDS");
__device__ __forceinline__ int crow(int r, int hi) { return (r & 3) + 8 * (r >> 2) + 4 * hi; }
typedef __bf16 bf16x2_t __attribute__((ext_vector_type(2))); typedef float f32x2_t __attribute__((ext_vector_type(2)));
__device__ __forceinline__ unsigned cvtpk(float lo, float hi) { f32x2_t v = {lo, hi}; bf16x2_t b = __builtin_convertvector(v, bf16x2_t); return __builtin_bit_cast(unsigned, b); }
typedef short v4i16_t __attribute__((ext_vector_type(4)));
__device__ __forceinline__ s16x4 vtr(LAS const unsigned char* p) { return __builtin_bit_cast(s16x4, __builtin_amdgcn_ds_read_tr16_b64_v4i16((LAS v4i16_t*)p)); }
#define MX3(a, b, c) __builtin_fmaxf(__builtin_fmaxf((a), (b)), (c))
#define EX2(v) __builtin_amdgcn_exp2f(v)
__device__ __forceinline__ void glds16(const void* gsrc, unsigned lds_dst) { unsigned keep;
    asm volatile("s_mov_b32 %0, m0\n\ts_mov_b32 m0, %2\n\ts_nop 0\n\tglobal_load_lds_dwordx4 %1, off\n\ts_mov_b32 m0, %0" : "=&s"(keep) : "v"(gsrc), "s"(lds_dst) : "memory"); }

template <bool FAST, int ABL> __device__ __forceinline__ void attn_pass(f32x16 (&o)[4], f32x16& osum, int mc, int h, size_t rowbase, int q0, const bf16* Qg, const bf16* Kg, const bf16* Vg,
                                                                         LAS unsigned char* shm, int lane, int r32, int hi, int wid) {
    const float sl2 = LOG2E * EX2(-2.0f * (float)(h + 1));
    LAS float* wsf = (LAS float*)(shm + L_WS) + wid * 128;
    LAS unsigned char* Qf = shm + L_Q + wid * 4096;
    const int NT = (q0 + 256) / 64;
    const int half = wid >> 2;
    const unsigned lds0 = (unsigned)(unsigned long)shm;
    const unsigned char* kbase_u = (const unsigned char*)(Kg + rowbase * 512 + h * 128 + mc * 64 + wid * 8);
    unsigned koff = (unsigned)lane * 1024u; asm volatile("" : "+v"(koff));
    const int vp0 = wid * 2, vp1 = wid * 2 + 1;
    const unsigned char* vbase0_u = (const unsigned char*)(Vg + (rowbase + 16 * (vp0 & 3)) * 512 + h * 128 + (vp0 >> 2) * 32);
    const unsigned char* vbase1_u = (const unsigned char*)(Vg + (rowbase + 16 * (vp1 & 3)) * 512 + h * 128 + (vp1 >> 2) * 32);
    unsigned voff = (unsigned)(lane >> 2) * 1024u + (unsigned)(lane & 3) * 16u; asm volatile("" : "+v"(voff));
#define DMA_K(j, slot) if constexpr (!(ABL & 8)) glds16(kbase_u + (size_t)(NT - 1 - (j)) * 65536 + koff, (unsigned)__builtin_amdgcn_readfirstlane((int)(lds0 + L_K + (slot) * 8192 + wid * 1024)))
#define DMA_V(j, slot) if constexpr (!(ABL & 8)) do { const size_t go_ = (size_t)(NT - 1 - (j)) * 65536; const unsigned sb_ = lds0 + L_V + (slot) * 16384; \
        glds16(vbase0_u + go_ + voff, (unsigned)__builtin_amdgcn_readfirstlane((int)(sb_ + vp0 * 1024))); \
        glds16(vbase1_u + go_ + voff, (unsigned)__builtin_amdgcn_readfirstlane((int)(sb_ + vp1 * 1024))); } while (0)
#define WAIT_BAR(N) do { if constexpr (ABL & 128) asm volatile("s_waitcnt vmcnt(" #N ") lgkmcnt(0)" ::: "memory"); else asm volatile("s_waitcnt vmcnt(" #N ") lgkmcnt(0)\n\ts_barrier" ::: "memory"); } while (0)
    WAIT_BAR(0);
    DMA_K(0, 0); DMA_V(0, 0);
    {
        const bf16* qp = Qg + (rowbase + q0 + wid * 32 + r32) * 512 + h * 128 + mc * 64 + hi * 8;
#pragma unroll
        for (int d0 = 0; d0 < 4; ++d0) *(LAS u32x4*)(Qf + d0 * 1024 + lane * 16) = *(const GAS u32x4*)(qp + d0 * 16);
    }
#pragma unroll
    for (int d = 0; d < 4; ++d)
#pragma unroll
        for (int r = 0; r < 16; ++r) o[d][r] = 0.f;
#pragma unroll
    for (int r = 0; r < 16; ++r) osum[r] = 0.f;
    float mhat = 0.f;
    const int irel = wid * 32 + r32;
    f32x16 cb;
#pragma unroll
    for (int r = 0; r < 16; ++r) cb[r] = sl2 * (float)(crow(r, hi) - irel);
    const LAS unsigned char* vbl = (const LAS unsigned char*)shm + L_V + ((lane >> 4) & 1) * 32 + (lane & 3) * 8 + (4 * hi + ((lane & 15) >> 2)) * 64;
    const LAS unsigned char* kbl = (const LAS unsigned char*)shm + L_K + hi * 1024 + r32 * 16;
    const bf16x8 ones = (bf16x8){0x3F80, 0x3F80, 0x3F80, 0x3F80, 0x3F80, 0x3F80, 0x3F80, 0x3F80};
    f32x16 p0, p1;
#define CINIT(t) do { const float at_ = sl2 * (float)(64 * (t) - q0) - mhat, at1_ = at_ + 32.0f * sl2; \
        _Pragma("unroll") for (int r = 0; r < 16; ++r) { p0[r] = cb[r] + at_; p1[r] = cb[r] + at1_; } } while (0)
    CINIT(NT - 1);
    WAIT_BAR(0);
#define P0_BODY(j, DMA) do { const int t_ = NT - 1 - (j); \
        const LAS unsigned char* kb_ = kbl + ((j) & 1) * 8192; \
        if constexpr (!(ABL & 4)) { __builtin_amdgcn_s_setprio(3);     \
          _Pragma("unroll") for (int d0 = 0; d0 < 4; ++d0) { \
            const bf16x8 qf_ = *(LAS const bf16x8*)(Qf + d0 * 1024 + lane * 16); \
            const bf16x8 b0_ = *(LAS const bf16x8*)(kb_ + d0 * 2048), b1_ = *(LAS const bf16x8*)(kb_ + d0 * 2048 + 512); \
            p0 = __builtin_amdgcn_mfma_f32_32x32x16_bf16(b0_, qf_, p0, 0, 0, 0); \
            p1 = __builtin_amdgcn_mfma_f32_32x32x16_bf16(b1_, qf_, p1, 0, 0, 0); } \
          __builtin_amdgcn_s_setprio(0); } \
        DMA; \
        const int jb_ = t_ - (NT - 4); \
        if (jb_ >= 0) { const int kb0_ = 64 * jb_ + 4 * hi; \
            _Pragma("unroll") for (int r = 0; r < 16; ++r) { const int kv_ = kb0_ + (r & 3) + 8 * (r >> 2); if (kv_ > irel) p0[r] = -INFINITY; if (kv_ + 32 > irel) p1[r] = -INFINITY; } } \
        if constexpr (!FAST) { \
            float ra_ = MX3(p0[0], p0[1], p1[0]), rb_ = MX3(p0[2], p0[3], p1[1]); ra_ = MX3(ra_, p1[2], p1[3]); \
            _Pragma("unroll") for (int r = 4; r < 16; r += 4) { ra_ = MX3(ra_, p0[r], p0[r + 1]); rb_ = MX3(rb_, p0[r + 2], p0[r + 3]); ra_ = MX3(ra_, p1[r], p1[r + 1]); rb_ = MX3(rb_, p1[r + 2], p1[r + 3]); } \
            float rm_ = __builtin_fmaxf(ra_, rb_); rm_ = __builtin_fmaxf(rm_, __shfl_xor(rm_, 32)); \
            if (__any(rm_ > THR)) {     \
                const float dl_ = __builtin_fmaxf(rm_, 0.f); mhat += dl_; \
                _Pragma("unroll") for (int r = 0; r < 16; ++r) { p0[r] -= dl_; p1[r] -= dl_; } \
                const float f_ = EX2(-dl_); \
                if (hi == 0) wsf[r32] = f_; \
                asm volatile("s_waitcnt lgkmcnt(0)" ::: "memory"); \
                _Pragma("unroll") for (int r = 0; r < 16; ++r) { const float fr_ = wsf[crow(r, hi)]; osum[r] *= fr_; _Pragma("unroll") for (int d = 0; d < 4; ++d) o[d][r] *= fr_; } \
                asm volatile("s_waitcnt lgkmcnt(0)" ::: "memory"); } } \
        if constexpr (!(ABL & 2)) { _Pragma("unroll") for (int r = 0; r < 16; ++r) { p0[r] = EX2(p0[r]); p1[r] = EX2(p1[r]); } } \
        asm volatile("" : "+v"(p0), "+v"(p1)); } while (0)
#define P1_BODY(j, DMA) do { const int t_ = NT - 1 - (j); \
        u32x4 pw_[4]; \
        pw_[0] = (u32x4){cvtpk(p0[0], p0[1]), cvtpk(p0[2], p0[3]), cvtpk(p0[4], p0[5]), cvtpk(p0[6], p0[7])}; \
        pw_[1] = (u32x4){cvtpk(p0[8], p0[9]), cvtpk(p0[10], p0[11]), cvtpk(p0[12], p0[13]), cvtpk(p0[14], p0[15])}; \
        pw_[2] = (u32x4){cvtpk(p1[0], p1[1]), cvtpk(p1[2], p1[3]), cvtpk(p1[4], p1[5]), cvtpk(p1[6], p1[7])}; \
        pw_[3] = (u32x4){cvtpk(p1[8], p1[9]), cvtpk(p1[10], p1[11]), cvtpk(p1[12], p1[13]), cvtpk(p1[14], p1[15])}; \
        asm volatile("" :: "v"(pw_[0]), "v"(pw_[1]), "v"(pw_[2]), "v"(pw_[3])); \
        const LAS unsigned char* vb_ = vbl + ((j) & 1) * 16384; \
        if constexpr (!(ABL & 1)) _Pragma("unroll") for (int ks = 0; ks < 4; ++ks) { \
            _Pragma("unroll") for (int d0 = 0; d0 < 4; ++d0) { \
                const s16x4 lo_ = vtr(vb_ + d0 * 4096 + ks * 1024), h8_ = vtr(vb_ + d0 * 4096 + ks * 1024 + 512); \
                const bf16x8 vf_ = (bf16x8){lo_[0], lo_[1], lo_[2], lo_[3], h8_[0], h8_[1], h8_[2], h8_[3]}; \
                o[d0] = __builtin_amdgcn_mfma_f32_32x32x16_bf16(__builtin_bit_cast(bf16x8, pw_[ks]), vf_, o[d0], 0, 0, 0); } \
            osum = __builtin_amdgcn_mfma_f32_32x32x16_bf16(__builtin_bit_cast(bf16x8, pw_[ks]), ones, osum, 0, 0, 0); \
            __builtin_amdgcn_sched_barrier(0); \
            if (ks == 0) { DMA; } }     \
        CINIT(t_ - 1); } while (0)
    if (half == 0) {
        for (int j = 0; j < NT; ++j) {
            const bool more = j + 1 < NT;
            P0_BODY(j, if (more) DMA_K(j + 1, (j + 1) & 1));
            if (more) WAIT_BAR(1); else WAIT_BAR(0);
            P1_BODY(j, if (more) DMA_V(j + 1, (j + 1) & 1));
            if (more) WAIT_BAR(2); else WAIT_BAR(0);
        }
        WAIT_BAR(0);
    } else {
        DMA_K(1, 1);
        WAIT_BAR(1);
        for (int j = 0; j < NT; ++j) {
            P0_BODY(j, if (j + 1 < NT) DMA_V(j + 1, (j + 1) & 1));
            if (j + 1 < NT) WAIT_BAR(2); else WAIT_BAR(0);
            P1_BODY(j, if (j + 2 < NT) DMA_K(j + 2, j & 1));
            if (j + 2 < NT) WAIT_BAR(1); else WAIT_BAR(0);
        }
    }
#undef P0_BODY
#undef P1_BODY
#undef CINIT
#undef DMA_K
#undef DMA_V
#undef WAIT_BAR
}

template <bool FAST, int ABL> __device__ __forceinline__ void attn_unit(int b, int h, int qb, const bf16* Qg, const bf16* Kg, const bf16* Vg, bf16* MIX, const float* subln, float lam, LAS unsigned char* shm) {
    int tid = threadIdx.x; asm volatile("" : "+v"(tid));
    const int lane = tid & 63, r32 = lane & 31, hi = lane >> 5; const int wid = __builtin_amdgcn_readfirstlane(tid >> 6);
    const size_t rowbase = (size_t)b * SEQ; const int q0 = qb * 256;
    LAS unsigned char* ost = shm + L_OST + wid * 8192;
    f32x16 o[4], osum;
    attn_pass<FAST, ABL>(o, osum, 0, h, rowbase, q0, Qg, Kg, Vg, shm, lane, r32, hi, wid);
    {
        float f[16];
#pragma unroll
        for (int r = 0; r < 16; ++r) f[r] = __builtin_amdgcn_rcpf(osum[r]);
#pragma unroll
        for (int d = 0; d < 4; ++d) {
            u32x4 w0, w1;
            w0 = (u32x4){cvtpk(o[d][0] * f[0], o[d][1] * f[1]), cvtpk(o[d][2] * f[2], o[d][3] * f[3]), cvtpk(o[d][4] * f[4], o[d][5] * f[5]), cvtpk(o[d][6] * f[6], o[d][7] * f[7])};
            w1 = (u32x4){cvtpk(o[d][8] * f[8], o[d][9] * f[9]), cvtpk(o[d][10] * f[10], o[d][11] * f[11]), cvtpk(o[d][12] * f[12], o[d][13] * f[13]), cvtpk(o[d][14] * f[14], o[d][15] * f[15])};
            *(LAS u32x4*)(ost + (2 * d) * 1024 + lane * 16) = w0; *(LAS u32x4*)(ost + (2 * d + 1) * 1024 + lane * 16) = w1;
        }
    }
    LDS_WAIT(); asm volatile("" ::: "memory");
    attn_pass<FAST, ABL>(o, osum, 1, h, rowbase, q0, Qg, Kg, Vg, shm, lane, r32, hi, wid);
    {
        float f1[16];
#pragma unroll
        for (int r = 0; r < 16; ++r) f1[r] = lam * __builtin_amdgcn_rcpf(osum[r]);
#pragma unroll
        for (int d = 0; d < 4; ++d) {
            const u32x4 wa = *(LAS const u32x4*)(ost + (2 * d) * 1024 + lane * 16), wb = *(LAS const u32x4*)(ost + (2 * d + 1) * 1024 + lane * 16);
#pragma unroll
            for (int r = 0; r < 16; ++r) {
                const unsigned w = (r < 8 ? wa : wb)[(r >> 1) & 3];
                const float o0v = (r & 1) ? __uint_as_float(w & 0xffff0000u) : __uint_as_float(w << 16);
                o[d][r] = o0v - o[d][r] * f1[r];
            }
        }
    }
    LDS_WAIT(); asm volatile("" ::: "memory");
    float g[4];
#pragma unroll
    for (int d = 0; d < 4; ++d) g[d] = subln[32 * d + r32] * (1.0f - LAM_INIT);
    {
        LAS unsigned short* orow = (LAS unsigned short*)ost + (4 * hi) * 128 + r32;
#pragma unroll
        for (int r = 0; r < 16; ++r) {
            const int cr0 = (r & 3) + 8 * (r >> 2);
            float s = (o[0][r] * o[0][r] + o[1][r] * o[1][r]) + (o[2][r] * o[2][r] + o[3][r] * o[3][r]);
            s += __shfl_xor(s, 1); s += __shfl_xor(s, 2); s += __shfl_xor(s, 4); s += __shfl_xor(s, 8); s += __shfl_xor(s, 16);
            const float rn = __builtin_amdgcn_rsqf(s * (1.0f / 128.0f) + EPS);
#pragma unroll
            for (int d = 0; d < 4; ++d) orow[cr0 * 128 + 32 * d] = (unsigned short)f2bf(o[d][r] * rn * g[d]);
        }
    }
    LDS_WAIT(); asm volatile("" ::: "memory");
    {
        bf16* op = MIX + (rowbase + q0 + wid * 32 + (lane >> 4)) * 1024 + h * 128 + (lane & 15) * 8;
#pragma unroll
        for (int i = 0; i < 8; ++i) { const u32x4 v = *(LAS const u32x4*)(ost + i * 1024 + lane * 16); *(GAS u32x4*)(op + (size_t)i * 4 * 1024) = v; }
    }
    LDS_WAIT(); asm volatile("" ::: "memory");
}
#undef MX3
#undef EX2
}

__device__ __forceinline__ void conv_phase(Frame& F, const bf16* U, const bf16* GB, const float* cw, const float* cn, bf16* MIX) {
    const int gw = F.vcu * NWAVES + F.wave, NGW = F.G * NWAVES; const int ch0 = F.lane * 8;
    float w0[8], w1[8], w2[8], gn[8];
#pragma unroll
    for (int i = 0; i < 8; ++i) { w0[i] = cw[ch0 + i]; w1[i] = cw[512 + ch0 + i]; w2[i] = cw[1024 + ch0 + i]; gn[i] = cn[ch0 + i]; }
    for (int g = gw; g < M / 16; g += NGW) {
        const int t0 = 16 * g;
        float um2[8], um1[8];
        if ((t0 & (SEQ - 1)) == 0) {
#pragma unroll
            for (int i = 0; i < 8; ++i) { um2[i] = 0.f; um1[i] = 0.f; }
        } else {
            const v4u a = *(const GAS v4u*)(U + (size_t)(t0 - 2) * 512 + ch0), b = *(const GAS v4u*)(U + (size_t)(t0 - 1) * 512 + ch0);
#pragma unroll
            for (int i = 0; i < 4; ++i) { um2[2 * i] = __uint_as_float(a[i] << 16); um2[2 * i + 1] = __uint_as_float(a[i] & 0xffff0000u); um1[2 * i] = __uint_as_float(b[i] << 16); um1[2 * i + 1] = __uint_as_float(b[i] & 0xffff0000u); }
        }
        for (int tb = t0; tb < t0 + 16; tb += 8) {
            v4u ua[8], ga[8];
#pragma unroll
            for (int i = 0; i < 8; ++i) { ua[i] = *(const GAS v4u*)(U + (size_t)(tb + i) * 512 + ch0); ga[i] = *(const GAS v4u*)(GB + (size_t)(tb + i) * 512 + ch0); }
#pragma unroll
            for (int j = 0; j < 8; ++j) {
                const v4u a = ua[j], b = ga[j];
                float ut[8], gb[8], c[8]; float s = 0.f;
#pragma unroll
                for (int i = 0; i < 4; ++i) { ut[2 * i] = __uint_as_float(a[i] << 16); ut[2 * i + 1] = __uint_as_float(a[i] & 0xffff0000u); gb[2 * i] = __uint_as_float(b[i] << 16); gb[2 * i + 1] = __uint_as_float(b[i] & 0xffff0000u); }
#pragma unroll
                for (int i = 0; i < 8; ++i) { c[i] = gb[i] * (w0[i] * um2[i] + w1[i] * um1[i] + w2[i] * ut[i]); s += c[i] * c[i]; um2[i] = um1[i]; um1[i] = ut[i]; }
                s += __shfl_xor(s, 1); s += __shfl_xor(s, 2); s += __shfl_xor(s, 4);
                const float rn = __builtin_amdgcn_rsqf(s * (1.0f / 64.0f) + EPS);
                v4u o;
#pragma unroll
                for (int i = 0; i < 4; ++i) o[i] = pk2(c[2 * i] * rn * gn[2 * i], c[2 * i + 1] * rn * gn[2 * i + 1]);
                *(GAS v4u*)(MIX + (size_t)(tb + j) * 1024 + 512 + ch0) = o;
            }
        }
    }
}

__device__ __forceinline__ void final_norm_phase(Frame& F, const bf16* xb, float* out, const float* gain) {
    const int gw = F.vcu * NWAVES + F.wave, NGW = F.G * NWAVES;
    f32x4 gv[4];
#pragma unroll
    for (int j = 0; j < 4; ++j) gv[j] = *((const GAS f32x4*)gain + 4 * F.lane + j);
    for (int m0 = 4 * gw; m0 < M; m0 += 4 * NGW) {
        v4u a[4], b[4];
#pragma unroll
        for (int q = 0; q < 4; ++q) { const GAS v4u* xr = (const GAS v4u*)(xb + (size_t)(m0 + q) * D) + 2 * F.lane; a[q] = xr[0]; b[q] = xr[1]; }
        float sq[4];
#pragma unroll
        for (int q = 0; q < 4; ++q) { float s = 0.f;
#pragma unroll
            for (int i = 0; i < 4; ++i) { const float l0 = __uint_as_float(a[q][i] << 16), h0 = __uint_as_float(a[q][i] & 0xffff0000u), l1 = __uint_as_float(b[q][i] << 16), h1 = __uint_as_float(b[q][i] & 0xffff0000u);
                s += (l0 * l0 + h0 * h0) + (l1 * l1 + h1 * h1); }
            sq[q] = s; }
#pragma unroll
        for (int o_ = 1; o_ < 64; o_ <<= 1) {
#pragma unroll
            for (int q = 0; q < 4; ++q) sq[q] += __shfl_xor(sq[q], o_); }
#pragma unroll
        for (int q = 0; q < 4; ++q) {
            const float r = __builtin_amdgcn_rsqf(sq[q] * (1.0f / D) + EPS);
            GAS f32x4* orow = (GAS f32x4*)(out + (size_t)(m0 + q) * D) + 4 * F.lane;
            const v4u aa = a[q], bb = b[q];
            orow[0] = (f32x4){__uint_as_float(aa.x << 16), __uint_as_float(aa.x & 0xffff0000u), __uint_as_float(aa.y << 16), __uint_as_float(aa.y & 0xffff0000u)} * r * gv[0];
            orow[1] = (f32x4){__uint_as_float(aa.z << 16), __uint_as_float(aa.z & 0xffff0000u), __uint_as_float(aa.w << 16), __uint_as_float(aa.w & 0xffff0000u)} * r * gv[1];
            orow[2] = (f32x4){__uint_as_float(bb.x << 16), __uint_as_float(bb.x & 0xffff0000u), __uint_as_float(bb.y << 16), __uint_as_float(bb.y & 0xffff0000u)} * r * gv[2];
            orow[3] = (f32x4){__uint_as_float(bb.z << 16), __uint_as_float(bb.z & 0xffff0000u), __uint_as_float(bb.w << 16), __uint_as_float(bb.w & 0xffff0000u)} * r * gv[3];
        }
    }
}

constexpr int N_PHASES = 9;
__global__ void __launch_bounds__(NWAVES * 64, 2) fwd_kernel(Args args) {
    extern __shared__ __attribute__((aligned(16))) unsigned char lds[];
    Frame F;
    F.lds = (LAS unsigned char*)lds;
    F.MISC = (volatile LAS unsigned*)(F.lds + MISC_OFF);
    F.tid = threadIdx.x; F.lane = F.tid & 63; F.wave = __builtin_amdgcn_readfirstlane(F.tid >> 6);
    F.G = gridDim.x; { const int bx = blockIdx.x; F.vcu = (F.G % 8 == 0) ? (bx % 8) * (F.G / 8) + bx / 8 : bx; }
    unsigned char* ws = args.ws;
    F.ctl = (gu32*)(ws + WS_CTL);
    for (int u = F.tid; u < (LDS_BYTES - LDSCTL_OFF) / 4; u += NWAVES * 64) ((LAS unsigned*)(F.lds + LDSCTL_OFF))[u] = 0u;
    __syncthreads();
    const int lo = args.ph_lo, hi = args.ph_hi;
    const bool one_launch = (hi - lo) > 1;
    XcdBarrier bar; bar.bar = (unsigned*)(F.ctl + CW_BAR); bar.x = 0; bar.st = nullptr;
    if (one_launch) bar = xcd_barrier_post((unsigned*)(F.ctl + CW_BAR), F.MISC + 8);
#ifndef PHASE_MASK
#define PHASE_MASK 0x1ff
#endif
#define IN(k) (((PHASE_MASK >> (k)) & 1) && lo <= (k) && (k) < hi)
#define SEAM(k) do { if (IN(k) && IN((k) + 1)) xcd_barrier(bar); } while (0)

    float* ss = (float*)(ws + WS_SS);
    bf16* XB = (bf16*)(ws + WS_XB); bf16* HB = (bf16*)(ws + WS_H); bf16* MIX = (bf16*)(ws + WS_MIX);
    bf16 *QB_ = (bf16*)(ws + WS_Q), *KB_ = (bf16*)(ws + WS_K), *VB_ = (bf16*)(ws + WS_V), *GBB = (bf16*)(ws + WS_GB), *UB = (bf16*)(ws + WS_U), *OBB = (bf16*)(ws + WS_O);

#define REPS(k) for (int rep = 0; rep < ((DUP_PHASE == (k)) ? 2 : 1); ++rep)
#ifdef PROBE_PH_A
    gu64* tsw = (gu64*)(F.ctl + 2048);
#define STAMP(k) do { if (blockIdx.x == 0 && F.tid == 0) __hip_atomic_store(tsw + (k), rt(), RLX_AGENT); } while (0)
#else
#define STAMP(k) do {} while (0)
#endif
    STAMP(0);
    if (IN(0)) { p0_prologue(F, args);
#if DUP_PHASE == 0
        p0_prologue(F, args);
#endif
    } SEAM(0); STAMP(1);
    if (IN(1)) REPS(1) {
        pg8::Gemm g{XB, (const bf16*)(ws + WS_WGU1), M, 2 * FF, D}; pg8::StaticOrder S; S.init(M, 2 * FF, F.G, (int)blockIdx.x);
        pg8::EpiSwiGLU E{HB, FF, ss, 1.0f / D};
        pg8::gemm_phase<pg8::EpiSwiGLU, pg8::StaticOrder, PG8_ALIGN, PG8_SP2>(F.lds + RING_OFF, g, S, E);
    } SEAM(1); STAMP(2);
    if (IN(2)) {
        pg8::Gemm g{HB, (const bf16*)(ws + WS_WD1), M, D, FF}; pg8::StaticOrder S; S.init(M, D, F.G, (int)blockIdx.x, 1);
        { pg8::EpiResB<false> E{XB, XB, ss + M, 0.5f};
          pg8::gemm_phase<pg8::EpiResB<false>, pg8::StaticOrder, PG8_ALIGN, PG8_SP2>(F.lds + RING_OFF, g, S, E); }
#if DUP_PHASE == 2
        { pg8::EpiResB<false> E{XB, (bf16*)(ws + WS_O), ss + 3 * M, 0.5f};
#ifdef DUP_AMASK
          g.pm_mask = DUP_AMASK;
#endif
#ifdef DUP_BMASK
          g.pn_mask = DUP_BMASK;
#endif
          pg8::gemm_phase<pg8::EpiResB<false>, pg8::StaticOrder, PG8_ALIGN, PG8_SP2>(F.lds + RING_OFF, g, S, E); }
#endif
    } SEAM(2); STAMP(3);
    if (IN(3)) {
        pg8::Gemm g{XB, (const bf16*)(ws + WS_WIN), M, NIN, D}; pg8::StaticOrder S; S.init(M, NIN, F.G, (int)blockIdx.x);
        pg8::EpiIn E{QB_, KB_, VB_, GBB, UB, ss + M, args.in[7], args.in[8], 0.125f * LOG2E};
        pg8::gemm_phase<pg8::EpiIn, pg8::StaticOrder, PG8_ALIGN, PG8_SP2>(F.lds + RING_OFF, g, S, E);
#if DUP_PHASE == 3
        pg8::gemm_phase<pg8::EpiIn, pg8::StaticOrder, PG8_ALIGN, PG8_SP2>(F.lds + RING_OFF, g, S, E);
#endif
    } SEAM(3); STAMP(4);
    if (IN(4)) REPS(4) {
#ifdef ABL_MASK
        if (!rep)
#endif
        conv_phase(F, UB, GBB, args.in[14], args.in[15], MIX);
        float lam;
        { const float a = args.in[9][F.lane] * args.in[10][F.lane], b2 = args.in[11][F.lane] * args.in[12][F.lane];
          lam = expf(wave_sum(a)) - expf(wave_sum(b2)) + LAM_INIT; }
        float mq = fabsf(args.in[7][F.lane]), mk = fabsf(args.in[8][F.lane]);
#pragma unroll
        for (int o_ = 1; o_ < 64; o_ <<= 1) { mq = fmaxf(mq, __shfl_xor(mq, o_)); mk = fmaxf(mk, __shfl_xor(mk, o_)); }
        const bool fast = __builtin_amdgcn_readfirstlane((int)(8.0f * LOG2E * mq * mk <= 30.0f)) != 0;
        const int nun = BATCH * NH * 16;
#ifdef ABL_MASK
        if (rep) {
            for (int i = 0; ; ++i) {
                const int L = i * F.G + F.vcu; if (L >= nun) break;
                const int round = L / 256, w = L % 256, bh = w >> 3, s = w & 7; const int qb = (round & 1) ? 15 - s : s;
                att::attn_unit<true, ABL_MASK>(bh >> 2, bh & 3, qb, QB_, KB_, VB_, (bf16*)(ws + WS_O), args.in[13], lam, F.lds + RING_OFF);
            }
        } else
#endif
        if (fast) {
            for (int i = 0; ; ++i) {
                const int L = i * F.G + F.vcu; if (L >= nun) break;
                const int round = L / 256, w = L % 256, bh = w >> 3, s = w & 7; const int qb = (round & 1) ? 15 - s : s;
                att::attn_unit<true, 0>(bh >> 2, bh & 3, qb, QB_, KB_, VB_, MIX, args.in[13], lam, F.lds + RING_OFF);
            }
        }
#ifndef ABL_MASK
        else {
            for (int i = 0; ; ++i) {
                const int L = i * F.G + F.vcu; if (L >= nun) break;
                const int round = L / 256, w = L % 256, bh = w >> 3, s = w & 7; const int qb = (round & 1) ? 15 - s : s;
                att::attn_unit<false, 0>(bh >> 2, bh & 3, qb, QB_, KB_, VB_, MIX, args.in[13], lam, F.lds + RING_OFF);
            }
        }
#endif
    } SEAM(4); STAMP(5);
    if (IN(5)) {
        pg8::Gemm g{MIX, (const bf16*)(ws + WS_WOUT), M, D, D}; pg8::StaticOrder S; S.init(M, D, F.G, (int)blockIdx.x);
        { pg8::EpiResB<false> E{XB, XB, ss + 2 * M, 1.0f};
          pg8::gemm_phase<pg8::EpiResB<false>, pg8::StaticOrder, PG8_ALIGN, PG8_SP2>(F.lds + RING_OFF, g, S, E); }
#if DUP_PHASE == 5
        { pg8::EpiResB<false> E{XB, (bf16*)(ws + WS_O), ss + 3 * M, 1.0f};
          pg8::gemm_phase<pg8::EpiResB<false>, pg8::StaticOrder, PG8_ALIGN, PG8_SP2>(F.lds + RING_OFF, g, S, E); }
#endif
    } SEAM(5); STAMP(6);
    if (IN(6)) {
        pg8::Gemm g{XB, (const bf16*)(ws + WS_WGU2), M, 2 * FF, D}; pg8::StaticOrder S; S.init(M, 2 * FF, F.G, (int)blockIdx.x);
        pg8::EpiSwiGLU E{HB, FF, ss + 2 * M, 1.0f / D};
        pg8::gemm_phase<pg8::EpiSwiGLU, pg8::StaticOrder, PG8_ALIGN, PG8_SP2>(F.lds + RING_OFF, g, S, E);
    } SEAM(6); STAMP(7);
    if (IN(7)) {
        pg8::Gemm g{HB, (const bf16*)(ws + WS_WD2), M, D, FF}; pg8::StaticOrder S; S.init(M, D, F.G, (int)blockIdx.x, 1);
        pg8::EpiResB<false> E{XB, XB, nullptr, 0.5f};
        pg8::gemm_phase<pg8::EpiResB<false>, pg8::StaticOrder, PG8_ALIGN, PG8_SP2>(F.lds + RING_OFF, g, S, E);
    } SEAM(7); STAMP(8);
    if (IN(8)) { final_norm_phase(F, XB, args.out, args.in[21]);
#if DUP_PHASE == 8
        final_norm_phase(F, XB, args.out, args.in[21]);
#endif
    }
#ifdef PROBE_PH_A
    STAMP(9);
    __syncthreads();
    if (blockIdx.x == 0 && F.wave == 0) {
        asm volatile("s_waitcnt vmcnt(0)" ::: "memory");
        const float ta = (float)(__hip_atomic_load(tsw + PROBE_PH_A + 1, RLX_AGENT) - __hip_atomic_load(tsw + PROBE_PH_A, RLX_AGENT)) * 0.01f;
        const float tb = (float)(__hip_atomic_load(tsw + PROBE_PH_B + 1, RLX_AGENT) - __hip_atomic_load(tsw + PROBE_PH_B, RLX_AGENT)) * 0.01f;
        if (F.lane == 0) args.out[0] += ta;
        for (int j = 1; j < 16; ++j) args.out[F.lane + 64 * j] += tb * 0.01f;
    }
#endif
#undef IN
#undef SEAM
}

#ifndef MK_N_LAUNCHES
#define MK_N_LAUNCHES 1
#endif
extern "C" void kernel_launch(void* const* d_in, const int* in_sizes, int n_in, void* d_out, int out_size, void* d_ws, size_t ws_size, hipStream_t stream) {
    static int grid = 0;
    if (grid == 0) {
        if (n_in != 22 || in_sizes[0] != M * D || out_size != M * D || ws_size < WS_END) { fprintf(stderr, "kernel_launch: unexpected shapes (n_in %d, in0 %d, out %d, ws %zu); nothing launched\n", n_in, n_in > 0 ? in_sizes[0] : -1, out_size, ws_size); grid = -1; return; }
        int dev = 0, cus = 0;
        if (hipGetDevice(&dev) != hipSuccess || hipDeviceGetAttribute(&cus, hipDeviceAttributeMultiprocessorCount, dev) != hipSuccess) { grid = -1; return; }
        if (hipFuncSetAttribute((const void*)fwd_kernel, hipFuncAttributeMaxDynamicSharedMemorySize, LDS_BYTES) != hipSuccess) { fprintf(stderr, "kernel_launch: hipFuncSetAttribute failed\n"); grid = -1; return; }
        (void)hipGetLastError();
        grid = cus;
    }
    if (grid < 0) return;
    if (hipMemsetAsync((char*)d_ws + WS_CTL, 0, CTL_ZERO_BYTES, stream) != hipSuccess) return;
    Args a{};
    for (int i = 0; i < 22; ++i) a.in[i] = (const float*)d_in[i];
    a.out = (float*)d_out; a.ws = (unsigned char*)d_ws;
    if (MK_N_LAUNCHES == 1) { a.ph_lo = 0; a.ph_hi = N_PHASES; hipLaunchKernelGGL(fwd_kernel, dim3(grid), dim3(NWAVES * 64), LDS_BYTES, stream, a); }
    else for (int p = 0; p < N_PHASES; ++p) { a.ph_lo = p; a.ph_hi = p + 1; hipLaunchKernelGGL(fwd_kernel, dim3(grid), dim3(NWAVES * 64), LDS_BYTES, stream, a); }
}
```
